# Optimizing an MI355X kernel written in HIP

```python
import jax, jax.numpy as jnp
from jax import lax
import numpy as np


D_MODEL = 2048
BATCH = 2
SEQ = 4096
DEPTH = 1

HEAD_DIM = 128
MIX_WIDTH = D_MODEL
NSA_HEADS = MIX_WIDTH // 2 // HEAD_DIM
NSA_KV_GROUPS = 2
NSA_HPG = NSA_HEADS // NSA_KV_GROUPS
MOBA_HEADS = MIX_WIDTH // 2 // HEAD_DIM
CMP_LEN = 32
CMP_STRIDE = 16
CMP_HIDDEN = HEAD_DIM
SEL_LEN = 64
SEL_TOPK = 16
WINDOW = 512
MOBA_BLOCK = 256
MOBA_TOPK = 3
D_FF = 4 * D_MODEL
ROPE_THETA = 10000.0
EPS = 1e-6
NSA_Q_CHUNK = 64
MOBA_Q_CHUNK = 16

NSA_Q_W = NSA_HEADS * HEAD_DIM
NSA_KV_W = NSA_KV_GROUPS * HEAD_DIM
NSA_GATE_W = 3 * NSA_HEADS
MOBA_W = MOBA_HEADS * HEAD_DIM
IN_WIDTHS = (NSA_Q_W,) + (NSA_KV_W,) * 6 + (NSA_GATE_W, MOBA_W, MOBA_W, MOBA_W)
IN_COLS = sum(IN_WIDTHS)

kernel_name = 'hymba_nsa_moba_sandwich_adaln_block'


def rms_norm(x, g):
    x32 = x.astype(jnp.float32)
    y = x32 * lax.rsqrt(jnp.mean(x32 * x32, axis=-1, keepdims=True) + EPS)
    return (y * g.astype(jnp.float32)).astype(x.dtype)


def modulate(h, shift, scale):
    return h * (1.0 + scale[:, None, :]) + shift[:, None, :]


def rope_tables(T):
    pos = jnp.arange(T, dtype=jnp.float32)
    inv = ROPE_THETA ** (-jnp.arange(0, HEAD_DIM, 2, dtype=jnp.float32) / HEAD_DIM)
    ang = pos[:, None] * inv[None, :]
    return jnp.cos(ang), jnp.sin(ang)


def apply_rope(x, cos, sin):
    shp = (x.shape[1],) + (1,) * (x.ndim - 3) + (HEAD_DIM // 2,)
    c_ = cos.reshape(shp)
    s_ = sin.reshape(shp)
    x32 = x.astype(jnp.float32)
    x1, x2 = jnp.split(x32, 2, axis=-1)
    return jnp.concatenate([x1 * c_ - x2 * s_, x2 * c_ + x1 * s_], axis=-1).astype(x.dtype)


def masked_softmax(s, mask):
    s = jnp.where(mask, s.astype(jnp.float32), -jnp.inf)
    m = jnp.max(s, axis=-1, keepdims=True)
    m = jnp.where(jnp.isfinite(m), m, 0.0)
    e = jnp.exp(s - m)
    return e / jnp.maximum(jnp.sum(e, axis=-1, keepdims=True), jnp.float32(1e-30))


def compress(x, pos, w1, w2):
    B, T, G, dh = x.shape
    n_cmp = (T - CMP_LEN) // CMP_STRIDE + 1
    idx = np.arange(n_cmp)[:, None] * CMP_STRIDE + np.arange(CMP_LEN)[None, :]
    blocks = x[:, idx] + pos[:, None, :].astype(x.dtype)
    blocks = blocks.transpose(0, 1, 3, 2, 4).reshape(B, n_cmp, G, CMP_LEN * dh)
    return jax.nn.silu(blocks @ w1) @ w2


def nsa_mixer(q, k_cmp, v_cmp, k_sel, v_sel, k_win, v_win, gate_logits,
              cmp_k_pos, cmp_k_w1, cmp_k_w2, cmp_v_pos, cmp_v_w1, cmp_v_w2, cos, sin):
    B, T, _ = q.shape
    G, Hg, dh = NSA_KV_GROUPS, NSA_HPG, HEAD_DIM
    Qc = NSA_Q_CHUNK
    q = apply_rope(q.reshape(B, T, G, Hg, dh), cos, sin) * (dh ** -0.5)
    kv = lambda a: a.reshape(B, T, G, dh)
    k_cmp = apply_rope(kv(k_cmp), cos, sin)
    k_sel = apply_rope(kv(k_sel), cos, sin)
    k_win = apply_rope(kv(k_win), cos, sin)
    v_cmp, v_sel, v_win = kv(v_cmp), kv(v_sel), kv(v_win)
    gates = jax.nn.sigmoid(gate_logits.astype(jnp.float32)).reshape(B, T, G, Hg, 3)

    kc = compress(k_cmp, cmp_k_pos, cmp_k_w1, cmp_k_w2)
    vc = compress(v_cmp, cmp_v_pos, cmp_v_w1, cmp_v_w2)
    n_cmp = kc.shape[1]
    cmp_start = np.arange(n_cmp) * CMP_STRIDE
    cmp_end_np = cmp_start + CMP_LEN
    cmp_end = jnp.asarray(cmp_end_np - 1)

    n_sel = T // SEL_LEN
    k_top = min(SEL_TOPK, n_sel)
    sel_start = np.arange(n_sel) * SEL_LEN
    overlap = np.clip(np.minimum(cmp_end_np[:, None], sel_start[None, :] + SEL_LEN)
                      - np.maximum(cmp_start[:, None], sel_start[None, :]), 0, None)
    sel_map = jnp.asarray((overlap / CMP_LEN).astype(np.float32))
    ks_blk = k_sel.reshape(B, n_sel, SEL_LEN, G, dh).transpose(0, 3, 1, 2, 4)
    vs_blk = v_sel.reshape(B, n_sel, SEL_LEN, G, dh).transpose(0, 3, 1, 2, 4)
    bi = jnp.arange(B)[:, None, None, None]
    gi = jnp.arange(G)[None, :, None, None]

    pad = ((0, 0), (WINDOW, 0), (0, 0), (0, 0))
    kw_pad = jnp.pad(k_win, pad)
    vw_pad = jnp.pad(v_win, pad)

    def chunk(i):
        s0 = i * Qc
        qc = lax.dynamic_slice_in_dim(q, s0, Qc, axis=1)
        gc = lax.dynamic_slice_in_dim(gates, s0, Qc, axis=1)
        tq = s0 + jnp.arange(Qc)
        sc = jnp.einsum('bqghd,bcgd->bghqc', qc, kc)
        p_c = masked_softmax(sc, cmp_end[None, :] <= tq[:, None])
        o_c = jnp.einsum('bghqc,bcgd->bqghd', p_c.astype(vc.dtype), vc)
        imp = jnp.einsum('bghqc,cs->bgqs', p_c, sel_map)
        cb = tq // SEL_LEN
        blk = jnp.arange(n_sel)[None, :]
        causal = blk <= cb[:, None]
        forced = (blk == 0) | (blk == cb[:, None]) | (blk == cb[:, None] - 1)
        score = jnp.where(causal, jnp.where(forced, jnp.inf, imp), -jnp.inf)
        _, idx = lax.top_k(score, k_top)
        ksg = ks_blk[bi, gi, idx]
        vsg = vs_blk[bi, gi, idx]
        kpos = idx[..., None] * SEL_LEN + jnp.arange(SEL_LEN)
        mask_s = (kpos <= tq[:, None, None]).reshape(B, G, 1, Qc, k_top * SEL_LEN)
        ss = jnp.einsum('bqghd,bgqkld->bghqkl', qc, ksg).reshape(B, G, Hg, Qc, k_top * SEL_LEN)
        p_s = masked_softmax(ss, mask_s)
        o_s = jnp.einsum('bghqn,bgqnd->bqghd', p_s.astype(vsg.dtype),
                         vsg.reshape(B, G, Qc, k_top * SEL_LEN, dh))
        kw = lax.dynamic_slice_in_dim(kw_pad, s0, Qc + WINDOW, axis=1)
        vw = lax.dynamic_slice_in_dim(vw_pad, s0, Qc + WINDOW, axis=1)
        kp = s0 - WINDOW + jnp.arange(Qc + WINDOW)
        dist = tq[:, None] - kp[None, :]
        mask_w = (dist >= 0) & (dist < WINDOW) & (kp[None, :] >= 0)
        sw = jnp.einsum('bqghd,bkgd->bghqk', qc, kw)
        p_w = masked_softmax(sw, mask_w)
        o_w = jnp.einsum('bghqk,bkgd->bqghd', p_w.astype(vw.dtype), vw)
        g = gc.astype(o_c.dtype)
        o = g[..., 0:1] * o_c + g[..., 1:2] * o_s + g[..., 2:3] * o_w
        return o.reshape(B, Qc, NSA_HEADS * dh)

    out = lax.map(chunk, jnp.arange(T // Qc))
    return jnp.moveaxis(out, 0, 1).reshape(B, T, NSA_HEADS * dh)


def moba_mixer(q, k, v, cos, sin):
    B, T, _ = q.shape
    H, dh, BLK, Qc = MOBA_HEADS, HEAD_DIM, MOBA_BLOCK, MOBA_Q_CHUNK
    q = apply_rope(q.reshape(B, T, H, dh), cos, sin) * (dh ** -0.5)
    k = apply_rope(k.reshape(B, T, H, dh), cos, sin)
    v = v.reshape(B, T, H, dh)
    nb = -(-T // BLK)
    pad = ((0, 0), (0, nb * BLK - T), (0, 0), (0, 0))
    k_pad = jnp.pad(k, pad)
    v_pad = jnp.pad(v, pad)
    k_blk = k_pad.reshape(B, nb, BLK, H, dh).transpose(0, 3, 1, 2, 4)
    v_blk = v_pad.reshape(B, nb, BLK, H, dh).transpose(0, 3, 1, 2, 4)
    k_mean = jnp.mean(k_blk.astype(jnp.float32), axis=3).astype(k.dtype)
    k_past = min(MOBA_TOPK, nb - 1)
    bi = jnp.arange(B)[:, None, None, None]
    hi = jnp.arange(H)[None, :, None, None]

    def chunk(i):
        s0 = i * Qc
        qc = lax.dynamic_slice_in_dim(q, s0, Qc, axis=1)
        tq = s0 + jnp.arange(Qc)
        cur = s0 // BLK
        ko = lax.dynamic_slice_in_dim(k_pad, cur * BLK, BLK, axis=1)
        vo = lax.dynamic_slice_in_dim(v_pad, cur * BLK, BLK, axis=1)
        opos = cur * BLK + jnp.arange(BLK)
        s_own = jnp.einsum('bqhd,blhd->bhql', qc, ko)
        m_own = jnp.broadcast_to(opos[None, :] <= tq[:, None], (B, H, Qc, BLK))
        if k_past > 0:
            gsc = jnp.einsum('bqhd,bhnd->bhqn', qc, k_mean).astype(jnp.float32)
            gsc = jnp.where(jnp.arange(nb) < cur, gsc, -jnp.inf)
            _, idx = lax.top_k(gsc, k_past)
            kg = k_blk[bi, hi, idx]
            vg = v_blk[bi, hi, idx]
            s_past = jnp.einsum('bqhd,bhqkld->bhqkl', qc, kg).reshape(B, H, Qc, k_past * BLK)
            m_past = jnp.broadcast_to((idx < cur)[..., None],
                                      (B, H, Qc, k_past, BLK)).reshape(B, H, Qc, k_past * BLK)
            p = masked_softmax(jnp.concatenate([s_past, s_own], axis=-1),
                               jnp.concatenate([m_past, m_own], axis=-1))
            p = p.astype(v.dtype)
            o = (jnp.einsum('bhqn,bhqnd->bqhd', p[..., :k_past * BLK],
                            vg.reshape(B, H, Qc, k_past * BLK, dh))
                 + jnp.einsum('bhql,blhd->bqhd', p[..., k_past * BLK:], vo))
        else:
            p = masked_softmax(s_own, m_own).astype(v.dtype)
            o = jnp.einsum('bhql,blhd->bqhd', p, vo)
        return o.reshape(B, Qc, H * dh)

    out = lax.map(chunk, jnp.arange(T // Qc))
    return jnp.moveaxis(out, 0, 1).reshape(B, T, H * dh)


def setup_inputs(seed: int = 0) -> dict:
    key = jax.random.key(seed)
    ks = jax.random.split(key, 18)
    nrm = lambda k, shape, s: jax.random.normal(k, shape, jnp.float32) * s
    L = DEPTH
    return {
        'x': nrm(ks[0], (BATCH, SEQ, D_MODEL), 1.0),
        'c': nrm(ks[1], (BATCH, D_MODEL), 1.0),
        'w_ada': nrm(ks[2], (L, D_MODEL, 6 * D_MODEL), 0.5 * D_MODEL ** -0.5),
        'b_ada': nrm(ks[3], (L, 6 * D_MODEL), 0.01),
        'pre_norm_mix': 1.0 + nrm(ks[4], (L, D_MODEL), 0.05),
        'post_norm_mix': 1.0 + nrm(ks[5], (L, D_MODEL), 0.05),
        'w_in': nrm(ks[6], (L, D_MODEL, IN_COLS), D_MODEL ** -0.5),
        'cmp_k_pos': nrm(ks[7], (L, CMP_LEN, HEAD_DIM), 0.1),
        'cmp_k_w1': nrm(ks[8], (L, CMP_LEN * HEAD_DIM, CMP_HIDDEN), (CMP_LEN * HEAD_DIM) ** -0.5),
        'cmp_k_w2': nrm(ks[9], (L, CMP_HIDDEN, HEAD_DIM), CMP_HIDDEN ** -0.5),
        'cmp_v_pos': nrm(ks[10], (L, CMP_LEN, HEAD_DIM), 0.1),
        'cmp_v_w1': nrm(ks[11], (L, CMP_LEN * HEAD_DIM, CMP_HIDDEN), (CMP_LEN * HEAD_DIM) ** -0.5),
        'cmp_v_w2': nrm(ks[12], (L, CMP_HIDDEN, HEAD_DIM), CMP_HIDDEN ** -0.5),
        'w_o': nrm(ks[13], (L, MIX_WIDTH, D_MODEL), MIX_WIDTH ** -0.5),
        'pre_norm_ffn': 1.0 + nrm(ks[14], (L, D_MODEL), 0.05),
        'post_norm_ffn': 1.0 + nrm(ks[15], (L, D_MODEL), 0.05),
        'w_up': nrm(ks[16], (L, D_MODEL, D_FF), D_MODEL ** -0.5),
        'w_down': nrm(ks[17], (L, D_FF, D_MODEL), D_FF ** -0.5),
    }


def reference(x, c, w_ada, b_ada, pre_norm_mix, post_norm_mix, w_in,
              cmp_k_pos, cmp_k_w1, cmp_k_w2, cmp_v_pos, cmp_v_w1, cmp_v_w2,
              w_o, pre_norm_ffn, post_norm_ffn, w_up, w_down):
    T = x.shape[1]
    cos, sin = rope_tables(T)
    split_at = np.cumsum(IN_WIDTHS)[:-1].tolist()
    for l in range(DEPTH):
        mod = jax.nn.silu(c) @ w_ada[l] + b_ada[l]
        shift_m, scale_m, gate_m, shift_f, scale_f, gate_f = jnp.split(mod, 6, axis=-1)
        h = modulate(rms_norm(x, pre_norm_mix[l]), shift_m, scale_m)
        (q_n, k_c, v_c, k_s, v_s, k_w, v_w, g_n,
         q_m, k_m, v_m) = jnp.split(h @ w_in[l], split_at, axis=-1)
        o_n = nsa_mixer(q_n, k_c, v_c, k_s, v_s, k_w, v_w, g_n,
                        cmp_k_pos[l], cmp_k_w1[l], cmp_k_w2[l],
                        cmp_v_pos[l], cmp_v_w1[l], cmp_v_w2[l], cos, sin)
        o_m = moba_mixer(q_m, k_m, v_m, cos, sin)
        o = jnp.concatenate([o_n, o_m], axis=-1) @ w_o[l]
        x = x + gate_m[:, None, :] * rms_norm(o, post_norm_mix[l])
        h = modulate(rms_norm(x, pre_norm_ffn[l]), shift_f, scale_f)
        f = jnp.square(jax.nn.relu(h @ w_up[l])) @ w_down[l]
        x = x + gate_f[:, None, :] * rms_norm(f, post_norm_ffn[l])
    return x
```

```cpp
#include <hip/hip_runtime.h>
#include <cstdio>
#include <cstdint>
#include <cmath>
#include <cstring>

#ifndef DIAG
#define DIAG 0
#endif
#ifndef DIAG_SELCMP
#define DIAG_SELCMP 1
#endif
#ifndef PROBE_VAR
#define PROBE_VAR 2
#endif
#ifndef REPEAT_PH
#define REPEAT_PH -1
#ifndef T_P2_ITEMS
#define T_P2_ITEMS 6
#endif
#ifndef P0_BAL
#define P0_BAL 1
#endif
#ifndef WGM_P7
#define WGM_P7 2
#endif
#ifndef WGM_P2
#define WGM_P2 4
#endif
#ifndef P34_HANDOFF
#define P34_HANDOFF 1
#endif
#ifndef P78_HANDOFF
#define P78_HANDOFF 1
#endif
#ifndef GV_Q
#define GV_Q 1
#endif
#ifndef P3_SPLITK
#define P3_SPLITK 1
#endif
#ifndef FUSE_P9
#define FUSE_P9 1
#endif
#ifndef FUSE_P6
#define FUSE_P6 1
#endif
#endif
#ifndef MK_N_LAUNCHES
#define MK_N_LAUNCHES 1
#endif

typedef _Float16 h16;
typedef _Float16 h16x2 __attribute__((ext_vector_type(2)));
typedef _Float16 h16x8 __attribute__((ext_vector_type(8)));
typedef float f32x2 __attribute__((ext_vector_type(2)));
typedef float f32x4 __attribute__((ext_vector_type(4)));
typedef float f32x16 __attribute__((ext_vector_type(16)));
typedef unsigned u32x2 __attribute__((ext_vector_type(2)));
typedef unsigned u32x4 __attribute__((ext_vector_type(4)));
typedef short s16x4 __attribute__((ext_vector_type(4)));
typedef short s16x8 __attribute__((ext_vector_type(8)));

#define LAS __attribute__((address_space(3)))
#define GAS __attribute__((address_space(1)))

__device__ __forceinline__ unsigned pk2h(float lo, float hi) { f32x2 v = {lo, hi}; h16x2 h = __builtin_convertvector(v, h16x2); return __builtin_bit_cast(unsigned, h); }

constexpr int BATCH = 2, SEQ = 4096, DM = 2048, M = BATCH * SEQ, DFF = 8192, HD = 128;
constexpr int INCOLS = 5656, NQKV = 5632, NPAD = 5888;
constexpr int C_QN = 0, C_KCMP = 1024, C_VCMP = 1280, C_KSEL = 1536, C_VSEL = 1792, C_KWIN = 2048, C_VWIN = 2304, C_QM = 2560, C_KM = 3584, C_VM = 4608;
constexpr float EPS = 1e-6f;
constexpr float QSCALE = 0.08838834764831845f;
constexpr float LOG2E = 1.4426950408889634f;

constexpr size_t MiB = 1u << 20;
constexpr size_t WS_CTL = 0, CTL_ZERO_BYTES = 1 * MiB;
constexpr size_t WS_MOD = 512 * 1024;
constexpr size_t WS_POSB = 768 * 1024;
constexpr size_t WS_KMEAN = 1 * MiB + 64 * 1024;
constexpr size_t WS_KC = 1 * MiB + 512 * 1024;
constexpr size_t WS_COS = 2 * MiB, WS_SIN = 3 * MiB;
constexpr size_t WS_W1T = 4 * MiB;
constexpr size_t WS_W2T = 6 * MiB;
constexpr size_t WS_GATE = 6 * MiB + 512 * 1024;
constexpr size_t WS_SSQ = 328 * MiB;
constexpr size_t WS_WIN = 8 * MiB;
constexpr size_t WS_WO = 32 * MiB;
constexpr size_t WS_WUP = 40 * MiB;
constexpr size_t WS_WDN = 72 * MiB;
constexpr size_t WS_H = 104 * MiB;
constexpr size_t WS_QKV = 136 * MiB;
constexpr size_t WS_O = 224 * MiB;
constexpr size_t WS_OP = 256 * MiB;
constexpr size_t WS_U = 136 * MiB;
constexpr size_t WS_X1 = 296 * MiB;
constexpr size_t WS_F = 264 * MiB;
constexpr size_t WS_END = 331 * MiB;
constexpr int CW_QUEUE = 64;
constexpr int CW_XCH = 8192;
constexpr int CW_P34 = 16384;
constexpr int CW_P78 = 18432;
constexpr int CW_BAR = 4096;

__device__ __forceinline__ f32x4 unpack4h(u32x2 w) { const unsigned wx = w[0], wy = w[1];
    const h16x2 a = __builtin_bit_cast(h16x2, wx), b = __builtin_bit_cast(h16x2, wy); return (f32x4){(float)a.x, (float)a.y, (float)b.x, (float)b.y}; }

namespace pg8 {
constexpr int BM = 256, BK = 64, HALF = 128, HTB = HALF * BK * 2, STAGE_BYTES = 8 * HTB, NXCD = 8, WGM = 2;
__host__ __device__ __forceinline__ int lds_byte(int r, int c) { const int st = (r >> 4) * 2 + (c >> 5), rr = r & 15, cc = c & 31, ob = rr * 64 + cc * 2; return st * 1024 + (ob ^ (((ob >> 9) & 1) << 5)); }
__host__ __device__ __forceinline__ void stage_rc(int b, int& R, int& C) { const int st = b / 1024, sb = b % 1024, swz = sb ^ (((sb >> 9) & 1) << 5); R = (st >> 1) * 16 + swz / 64; C = (st & 1) * 32 + (swz % 64) / 2; }
__host__ __device__ __forceinline__ int perm32(int rho) { const int n = rho >> 4, i = rho & 15; return 8 * (i >> 2) + 4 * n + (i & 3); }
struct Unit { int pm, pn; };
struct Gemm { const h16* A; const h16* Bt; int M, N, K; };
struct StaticOrder {
    int nM, nN, nwg, G, c, wgm;
    __host__ __device__ void init(int M_, int N_, int G_, int c_, int wgm_ = WGM) { nM = M_ / BM; nN = N_ / BM; nwg = nM * nN; G = G_; c = c_; wgm = wgm_; }
    __host__ __device__ bool next(int i, Unit& u) const {
        const long L = (long)i * G + c; if (L >= nwg) return false;
        int wgid = (int)L; { const int q = nwg / NXCD, r = nwg % NXCD, xcd = wgid % NXCD, off = wgid / NXCD; wgid = (xcd < r ? xcd * (q + 1) : r * (q + 1) + (xcd - r) * q) + off; }
        const int nig = wgm * nN, gid = wgid / nig, fm = gid * wgm, gsz = (nM - fm) < wgm ? (nM - fm) : wgm;
        u.pm = fm + ((wgid % nig) % gsz); u.pn = (wgid % nig) / gsz; return true;
    }
};
template <class Epi, class Sched, bool ALIGN_EPI, bool SP2>
__device__ __forceinline__ void gemm_phase(LAS unsigned char* lds, const Gemm g, const Sched& S, const Epi& E) {
    const int tid = threadIdx.x, wid = __builtin_amdgcn_readfirstlane(tid >> 6), lane = tid & 63, wr = wid >> 2, wc = wid & 3, fr = lane & 15, fq = lane >> 4;
    const int K = g.K, nt = K / BK;
    unsigned voffA[2], voffB[2];
#pragma unroll
    for (int i = 0; i < 2; ++i) { int R, C; stage_rc(tid * 16 + i * 8192, R, C); const int Rb = Epi::PERM ? ((R & ~31) + perm32(R & 31)) : R;
        voffA[i] = (unsigned)(R * K + C) * 2u; voffB[i] = (unsigned)(Rb * K + C) * 2u; }
    const size_t kstep = (size_t)(BK * 2);
    const size_t hstep = (size_t)HALF * K * 2;
    const size_t tstep = 2 * hstep;
    const unsigned ldsw = (unsigned)wid * 1024u;
    const int aoff = lds_byte(wr * 64 + fr, fq * 8), boff = lds_byte(wc * 32 + fr, fq * 8);
#define PG8_SA(b, h) (((b) * 2 + (h)) * HTB)
#define PG8_SB(b, h) ((4 + (b) * 2 + (h)) * HTB)
#define PG8_STAGE(bufoff, gbase, voff) do { _Pragma("unroll") for (int _i = 0; _i < 2; ++_i) \
        __builtin_amdgcn_global_load_lds((const unsigned*)((const char*)(gbase) + (voff)[_i]), (LAS unsigned*)(lds + (bufoff) + ldsw + _i * 8192), 16, 0, 0); } while (0)
#define PG8_LDA(dst, b, h) do { _Pragma("unroll") for (int m = 0; m < 4; ++m) _Pragma("unroll") for (int k = 0; k < 2; ++k) dst[m][k] = *(const LAS h16x8*)(lds + PG8_SA(b, h) + aoff + m * 2048 + k * 1024); } while (0)
#define PG8_LDB(dst, b, h) do { _Pragma("unroll") for (int n = 0; n < 2; ++n) _Pragma("unroll") for (int k = 0; k < 2; ++k) dst[n][k] = *(const LAS h16x8*)(lds + PG8_SB(b, h) + boff + n * 2048 + k * 1024); } while (0)
#define PG8_MMA(ai, bj, At, Bt) do { __builtin_amdgcn_s_setprio(1); _Pragma("unroll") for (int m = 0; m < 4; ++m) _Pragma("unroll") for (int n = 0; n < 2; ++n) _Pragma("unroll") for (int k = 0; k < 2; ++k) \
        acc[ai][bj][m][n] = __builtin_amdgcn_mfma_f32_16x16x32_f16(Bt[n][k], At[m][k], acc[ai][bj][m][n], 0, 0, 0); __builtin_amdgcn_s_setprio(0); } while (0)
#define PG8_WAIT_V(n) asm volatile("s_waitcnt vmcnt(" #n ")" ::: "memory")
#define PG8_WAIT_L(n) asm volatile("s_waitcnt lgkmcnt(" #n ")" ::: "memory")
#define PG8_BAR __builtin_amdgcn_s_barrier()
#define PG8_SCHED __builtin_amdgcn_sched_barrier(0)
    Unit cur, nxt; int ui = 0;
    if (!S.next(0, cur)) return;
    f32x4 acc[2][2][4][2];
#pragma unroll
    for (int a = 0; a < 2; ++a)
#pragma unroll
        for (int b = 0; b < 2; ++b)
#pragma unroll
            for (int m = 0; m < 4; ++m)
#pragma unroll
                for (int n = 0; n < 2; ++n) acc[a][b][m][n] = (f32x4){0.f, 0.f, 0.f, 0.f};
    h16x8 At[4][2], B0[2][2], B1[2][2];
    const char* cA = (const char*)g.A + (size_t)cur.pm * tstep; const char* cB = (const char*)g.Bt + (size_t)cur.pn * tstep;
    if constexpr (SP2) {
        PG8_STAGE(PG8_SB(0, 0), cB, voffB); PG8_STAGE(PG8_SB(0, 1), cB + hstep, voffB); PG8_STAGE(PG8_SA(0, 0), cA, voffA); PG8_STAGE(PG8_SA(0, 1), cA + hstep, voffA);
        if (wr == 1) PG8_BAR;
        PG8_WAIT_V(2); PG8_BAR;
        PG8_STAGE(PG8_SB(1, 0), cB + kstep, voffB); PG8_STAGE(PG8_SA(1, 0), cA + kstep, voffA); PG8_STAGE(PG8_SB(1, 1), cB + hstep + kstep, voffB);
        PG8_WAIT_V(6); PG8_BAR;
    } else {
        PG8_STAGE(PG8_SB(0, 0), cB, voffB); PG8_STAGE(PG8_SA(0, 0), cA, voffA); PG8_STAGE(PG8_SB(0, 1), cB + hstep, voffB); PG8_STAGE(PG8_SA(0, 1), cA + hstep, voffA);
        if (wr == 1) PG8_BAR;
        PG8_WAIT_V(4); PG8_BAR;
        PG8_STAGE(PG8_SB(1, 0), cB + kstep, voffB); PG8_STAGE(PG8_SA(1, 0), cA + kstep, voffA); PG8_STAGE(PG8_SB(1, 1), cB + hstep + kstep, voffB);
        PG8_WAIT_V(6); PG8_BAR;
    }
    for (;;) {
        const bool has_next = S.next(ui + 1, nxt);
        const char* nA = has_next ? (const char*)g.A + (size_t)nxt.pm * tstep : cA; const char* nB = has_next ? (const char*)g.Bt + (size_t)nxt.pn * tstep : cB;
        for (int t = 0; t < nt; t += 2) {
            const bool last = (t == nt - 2);
            const char* a1 = cA + (size_t)(t + 1) * kstep;
            const char* a2 = last ? nA : cA + (size_t)(t + 2) * kstep; const char* b2 = last ? nB : cB + (size_t)(t + 2) * kstep;
            const char* a3 = a2 + kstep; const char* b3 = b2 + kstep;
            if constexpr (SP2) {
            PG8_LDB(B0, 0, 0); PG8_LDB(B1, 0, 1); PG8_SCHED; PG8_LDA(At, 0, 0); PG8_STAGE(PG8_SA(1, 1), a1 + hstep, voffA);
            PG8_WAIT_V(8); PG8_WAIT_L(0); PG8_BAR; PG8_MMA(0, 0, At, B0); PG8_MMA(0, 1, At, B1); PG8_BAR; PG8_SCHED;
            PG8_LDA(At, 0, 1); PG8_STAGE(PG8_SB(0, 0), b2, voffB); PG8_STAGE(PG8_SB(0, 1), b2 + hstep, voffB); PG8_STAGE(PG8_SA(0, 0), a2, voffA);
            PG8_WAIT_V(8); PG8_WAIT_L(0); PG8_BAR; PG8_MMA(1, 0, At, B0); PG8_MMA(1, 1, At, B1); PG8_BAR; PG8_SCHED;
            PG8_LDB(B0, 1, 0); PG8_LDB(B1, 1, 1); PG8_SCHED; PG8_LDA(At, 1, 0); PG8_STAGE(PG8_SA(0, 1), a2 + hstep, voffA);
            PG8_WAIT_V(8); PG8_WAIT_L(0); PG8_BAR; PG8_MMA(0, 0, At, B0); PG8_MMA(0, 1, At, B1); PG8_BAR; PG8_SCHED;
            PG8_LDA(At, 1, 1); PG8_STAGE(PG8_SB(1, 0), b3, voffB); PG8_STAGE(PG8_SB(1, 1), b3 + hstep, voffB); PG8_STAGE(PG8_SA(1, 0), a3, voffA);
            PG8_WAIT_V(8); PG8_WAIT_L(0); PG8_BAR; PG8_MMA(1, 0, At, B0); PG8_MMA(1, 1, At, B1); PG8_BAR; PG8_SCHED;
            } else {
            PG8_LDB(B0, 0, 0); PG8_SCHED; PG8_LDA(At, 0, 0); PG8_STAGE(PG8_SA(1, 1), a1 + hstep, voffA);
            PG8_WAIT_L(8); PG8_BAR; PG8_WAIT_L(0); PG8_MMA(0, 0, At, B0); PG8_BAR; PG8_SCHED;
            PG8_LDB(B1, 0, 1); PG8_STAGE(PG8_SB(0, 0), b2, voffB);
            PG8_BAR; PG8_WAIT_L(0); PG8_MMA(0, 1, At, B1); PG8_BAR;
            PG8_LDA(At, 0, 1); PG8_STAGE(PG8_SA(0, 0), a2, voffA);
            PG8_BAR; PG8_WAIT_L(0); PG8_MMA(1, 0, At, B0); PG8_BAR; PG8_SCHED;
            PG8_STAGE(PG8_SB(0, 1), b2 + hstep, voffB);
            PG8_WAIT_V(6); PG8_BAR; PG8_MMA(1, 1, At, B1); PG8_BAR;
            PG8_LDB(B0, 1, 0); PG8_SCHED; PG8_LDA(At, 1, 0); PG8_STAGE(PG8_SA(0, 1), a2 + hstep, voffA);
            PG8_WAIT_L(8); PG8_BAR; PG8_WAIT_L(0); PG8_MMA(0, 0, At, B0); PG8_BAR; PG8_SCHED;
            PG8_LDB(B1, 1, 1); PG8_STAGE(PG8_SB(1, 0), b3, voffB);
            PG8_BAR; PG8_WAIT_L(0); PG8_MMA(0, 1, At, B1); PG8_BAR;
            PG8_LDA(At, 1, 1); PG8_STAGE(PG8_SA(1, 0), a3, voffA);
            PG8_BAR; PG8_WAIT_L(0); PG8_MMA(1, 0, At, B0); PG8_BAR; PG8_SCHED;
            PG8_STAGE(PG8_SB(1, 1), b3 + hstep, voffB);
            PG8_WAIT_V(6); PG8_BAR; PG8_MMA(1, 1, At, B1); PG8_BAR;
            }
        }
        if constexpr (ALIGN_EPI) { if (wr == 0) PG8_BAR; }
        if constexpr (!Epi::AFTER_DRAIN) E(acc, cur, wr, wc, fr, fq);
        if (!has_next) break;
#pragma unroll
        for (int a = 0; a < 2; ++a)
#pragma unroll
            for (int b = 0; b < 2; ++b)
#pragma unroll
                for (int m = 0; m < 4; ++m)
#pragma unroll
                    for (int n = 0; n < 2; ++n) acc[a][b][m][n] = (f32x4){0.f, 0.f, 0.f, 0.f};
        cur = nxt; cA = nA; cB = nB; ++ui;
        if constexpr (ALIGN_EPI) { if (wr == 1) PG8_BAR; }
    }
    PG8_WAIT_V(0);
    if constexpr (!ALIGN_EPI) { if (wr == 0) PG8_BAR; }
    PG8_BAR;
    if constexpr (Epi::AFTER_DRAIN) E.fused(acc, cur, wr, wc, fr, fq, lds, wid, lane);
#undef PG8_SA
#undef PG8_SB
#undef PG8_STAGE
#undef PG8_LDA
#undef PG8_LDB
#undef PG8_MMA
#undef PG8_WAIT_V
#undef PG8_WAIT_L
#undef PG8_BAR
#undef PG8_SCHED
}

__device__ __forceinline__ bool is_rope_tile(int pn) { return pn < 4 || pn == 4 || pn == 6 || pn == 8 || (pn >= 10 && pn < 18); }
__device__ __forceinline__ bool is_q_tile(int pn) { return pn < 4 || (pn >= 10 && pn < 14); }
struct EpiQKV {
    static constexpr bool PERM = true, AFTER_DRAIN = false;
    h16* QKV; float* G; const float* COS; const float* SIN;
    __device__ __forceinline__ void operator()(const f32x4 (&acc)[2][2][4][2], const Unit& u, int wr, int wc, int fr, int fq) const {
        const int pn = u.pn;
        const int row0 = u.pm * BM + wr * 64 + fr;
        if (pn == 22) {
            if (wc == 0 && fq < 3) {
#pragma unroll
                for (int ai = 0; ai < 2; ++ai)
#pragma unroll
                    for (int m = 0; m < 4; ++m) { const int row = row0 + ai * HALF + m * 16; float* gp = G + (size_t)row * 24 + 8 * fq;
                        f32x4 v0 = acc[ai][0][m][0], v1 = acc[ai][0][m][1];
#pragma unroll
                        for (int e = 0; e < 4; ++e) { v0[e] = 1.f / (1.f + __expf(-v0[e])); v1[e] = 1.f / (1.f + __expf(-v1[e])); }
                        *(f32x4*)gp = v0; *(f32x4*)(gp + 4) = v1; }
            }
            return;
        }
        if (is_rope_tile(pn)) {
            const float sc = is_q_tile(pn) ? QSCALE : 1.f;
            const int a4 = 4 * (4 * wc + fq);
#pragma unroll
            for (int ai = 0; ai < 2; ++ai)
#pragma unroll
                for (int m = 0; m < 4; ++m) { const int row = row0 + ai * HALF + m * 16; const int t = row & (SEQ - 1);
                    const f32x4 c4 = *(const f32x4*)(COS + t * 64 + a4), s4 = *(const f32x4*)(SIN + t * 64 + a4);
                    h16* rowp = QKV + (size_t)row * NQKV + pn * BM + a4;
#pragma unroll
                    for (int bj = 0; bj < 2; ++bj) { const f32x4 x1 = acc[ai][bj][m][0], x2 = acc[ai][bj][m][1];
                        const f32x4 o1 = (x1 * c4 - x2 * s4) * sc, o2 = (x2 * c4 + x1 * s4) * sc;
                        u32x2 w1; w1.x = pk2h(o1[0], o1[1]); w1.y = pk2h(o1[2], o1[3]);
                        u32x2 w2; w2.x = pk2h(o2[0], o2[1]); w2.y = pk2h(o2[2], o2[3]);
                        *(u32x2*)(rowp + bj * HALF) = w1; *(u32x2*)(rowp + bj * HALF + 64) = w2; } }
        } else {
            const int col0 = pn * BM + wc * 32 + 8 * fq;
#pragma unroll
            for (int ai = 0; ai < 2; ++ai)
#pragma unroll
                for (int m = 0; m < 4; ++m) { h16* rowp = QKV + (size_t)(row0 + ai * HALF + m * 16) * NQKV + col0;
#pragma unroll
                    for (int bj = 0; bj < 2; ++bj) { const f32x4 v0 = acc[ai][bj][m][0], v1 = acc[ai][bj][m][1];
                        u32x4 w; w.x = pk2h(v0[0], v0[1]); w.y = pk2h(v0[2], v0[3]); w.z = pk2h(v1[0], v1[1]); w.w = pk2h(v1[2], v1[3]);
                        *(u32x4*)(rowp + bj * HALF) = w; } }
        }
    }
};
struct EpiF16SS {
    static constexpr bool PERM = true, AFTER_DRAIN = false;
    h16* C; int ldc; float* SSQ;
    __device__ __forceinline__ void operator()(const f32x4 (&acc)[2][2][4][2], const Unit& u, int wr, int wc, int fr, int fq) const {
        const int row0 = u.pm * BM + wr * 64 + fr, col0 = u.pn * BM + wc * 32 + 8 * fq;
#pragma unroll
        for (int ai = 0; ai < 2; ++ai)
#pragma unroll
            for (int m = 0; m < 4; ++m) { const int row = row0 + ai * HALF + m * 16; h16* rowp = C + (size_t)row * ldc + col0; float s = 0.f;
#pragma unroll
                for (int bj = 0; bj < 2; ++bj) { const f32x4 v0 = acc[ai][bj][m][0], v1 = acc[ai][bj][m][1];
                    s += ((v0[0] * v0[0] + v0[1] * v0[1]) + (v0[2] * v0[2] + v0[3] * v0[3])) + ((v1[0] * v1[0] + v1[1] * v1[1]) + (v1[2] * v1[2] + v1[3] * v1[3]));
                    u32x4 w; w.x = pk2h(v0[0], v0[1]); w.y = pk2h(v0[2], v0[3]); w.z = pk2h(v1[0], v1[1]); w.w = pk2h(v1[2], v1[3]);
                    *(u32x4*)(rowp + bj * HALF) = w; }
                s += __shfl_xor(s, 16); s += __shfl_xor(s, 32);
                if (fq == 0) SSQ[(size_t)row * 32 + u.pn * 4 + wc] = s; }
    }
};
struct EpiRelu2 {
    static constexpr bool PERM = true, AFTER_DRAIN = false;
    h16* O; int ldc;
    __device__ __forceinline__ void operator()(const f32x4 (&acc)[2][2][4][2], const Unit& u, int wr, int wc, int fr, int fq) const {
        const int row0 = u.pm * BM + wr * 64 + fr, col0 = u.pn * BM + wc * 32 + 8 * fq;
#pragma unroll
        for (int ai = 0; ai < 2; ++ai)
#pragma unroll
            for (int m = 0; m < 4; ++m) { h16* rowp = O + (size_t)(row0 + ai * HALF + m * 16) * ldc + col0;
#pragma unroll
                for (int bj = 0; bj < 2; ++bj) { f32x4 v0 = acc[ai][bj][m][0], v1 = acc[ai][bj][m][1];
#pragma unroll
                    for (int e = 0; e < 4; ++e) { const float a = fmaxf(v0[e], 0.f), b = fmaxf(v1[e], 0.f); v0[e] = a * a; v1[e] = b * b; }
                    u32x4 w; w.x = pk2h(v0[0], v0[1]); w.y = pk2h(v0[2], v0[3]); w.z = pk2h(v1[0], v1[1]); w.w = pk2h(v1[2], v1[3]);
                    { const h16* sp_ = rowp + bj * HALF; asm volatile("global_store_dwordx4 %0, %1, off sc0 sc1\n\ts_nop 2" :: "v"(sp_), "v"(w) : "memory"); } } }
    }
};
__device__ __forceinline__ void row_exchange(const f32x4 (&acc)[2][2][4][2], float* X8, unsigned* cntw, const Unit& u, LAS unsigned char* lds, int wid, int lane, int wr, int wc, int fr, int fq) {
        LAS float* P = (LAS float*)(lds + 4096);
        LAS float* S = (LAS float*)lds;
#pragma unroll
        for (int ai = 0; ai < 2; ++ai)
#pragma unroll
            for (int m = 0; m < 4; ++m) { float s = 0.f;
#pragma unroll
                for (int bj = 0; bj < 2; ++bj) { const f32x4 v0 = acc[ai][bj][m][0], v1 = acc[ai][bj][m][1];
                    s += ((v0[0] * v0[0] + v0[1] * v0[1]) + (v0[2] * v0[2] + v0[3] * v0[3])) + ((v1[0] * v1[0] + v1[1] * v1[1]) + (v1[2] * v1[2] + v1[3] * v1[3])); }
                s += __shfl_xor(s, 16); s += __shfl_xor(s, 32);
                if (fq == 0) P[(ai * HALF + wr * 64 + m * 16 + fr) * 4 + wc] = s; }
        asm volatile("s_waitcnt lgkmcnt(0)" ::: "memory"); __builtin_amdgcn_s_barrier(); asm volatile("" ::: "memory");
        if (lane < 32) { const f32x4 p4 = *(const LAS f32x4*)(P + (wid * 32 + lane) * 4);
            __hip_atomic_store((unsigned*)X8 + (size_t)(u.pm * BM + wid * 32 + lane) * 8 + u.pn, __float_as_uint((p4[0] + p4[1]) + (p4[2] + p4[3])), __ATOMIC_RELAXED, __HIP_MEMORY_SCOPE_AGENT); }
        asm volatile("s_waitcnt vmcnt(0)" ::: "memory");
        if (lane == 0) __hip_atomic_fetch_add(cntw, 1u, __ATOMIC_RELAXED, __HIP_MEMORY_SCOPE_AGENT);
        if (wid == 0) { unsigned sp = 0u;
            while ((unsigned)__builtin_amdgcn_readfirstlane((int)__hip_atomic_load(cntw, __ATOMIC_RELAXED, __HIP_MEMORY_SCOPE_AGENT)) < 64u) { __builtin_amdgcn_s_sleep(1); if (++sp > (1u << 22)) break; }
            __builtin_amdgcn_fence(__ATOMIC_ACQUIRE, "agent"); }
        asm volatile("s_waitcnt vmcnt(0) lgkmcnt(0)" ::: "memory"); __builtin_amdgcn_s_barrier(); asm volatile("" ::: "memory");
        { const float* p = X8 + (size_t)(u.pm * BM + wid * 32 + (lane & 31)) * 8 + (lane >> 5) * 4; f32x4 q0;
            asm volatile("global_load_dwordx4 %0, %1, off sc1\n\ts_waitcnt vmcnt(0)" : "=&v"(q0) : "v"(p) : "memory");
            float ts = (q0[0] + q0[1]) + (q0[2] + q0[3]); ts += __shfl_xor(ts, 32);
            if (lane < 32) S[wid * 32 + lane] = 1.f / sqrtf(ts * (1.f / DM) + EPS); }
        asm volatile("s_waitcnt lgkmcnt(0)" ::: "memory"); __builtin_amdgcn_s_barrier(); asm volatile("" ::: "memory");
}
struct EpiNormOut {
    static constexpr bool PERM = true, AFTER_DRAIN = true;
    const h16* X1; float* OUT; float* SSQ; unsigned* cnt; const float* gpost; const float* gatef;
    __device__ __forceinline__ void fused(const f32x4 (&acc)[2][2][4][2], const Unit& u, int, int, int, int, LAS unsigned char* lds, int, int) const {
        int tid = threadIdx.x; asm volatile("" : "+v"(tid));
        const int wid = __builtin_amdgcn_readfirstlane(tid >> 6), lane = tid & 63, wr = wid >> 2, wc = wid & 3, fr = lane & 15, fq = lane >> 4;
        const int row0 = u.pm * BM + wr * 64 + fr, col0 = u.pn * BM + wc * 32 + 8 * fq;
        row_exchange(acc, SSQ, cnt + 64 * u.pm, u, lds, wid, lane, wr, wc, fr, fq);
        const LAS float* S = (const LAS float*)lds;
        u32x4 xr[2][4][2];
#pragma unroll
        for (int m = 0; m < 4; ++m)
#pragma unroll
            for (int bj = 0; bj < 2; ++bj) xr[0][m][bj] = __builtin_nontemporal_load((const u32x4*)(X1 + ((unsigned)(row0 * DM + col0) + (unsigned)(m * 16 * DM + bj * HALF))));
#pragma unroll
        for (int m = 0; m < 4; ++m)
#pragma unroll
            for (int bj = 0; bj < 2; ++bj) xr[1][m][bj] = __builtin_nontemporal_load((const u32x4*)(X1 + ((unsigned)(row0 * DM + col0) + (unsigned)((HALF + m * 16) * DM + bj * HALF))));
        const float* gfb = gatef + (size_t)(u.pm >> 4) * 6 * DM;
        f32x4 cf[2][2];
#pragma unroll
        for (int bj = 0; bj < 2; ++bj)
#pragma unroll
            for (int n = 0; n < 2; ++n) cf[bj][n] = *(const f32x4*)(gpost + col0 + bj * HALF + 4 * n) * *(const f32x4*)(gfb + col0 + bj * HALF + 4 * n);
        const unsigned eo = (unsigned)(row0 * DM + col0);
#pragma unroll
        for (int ai = 0; ai < 2; ++ai)
#pragma unroll
            for (int m = 0; m < 4; ++m) { const float rstd = S[ai * HALF + wr * 64 + m * 16 + fr]; const unsigned o = eo + (unsigned)((ai * HALF + m * 16) * DM);
#pragma unroll
                for (int bj = 0; bj < 2; ++bj) { u32x4 xw = xr[ai][m][bj]; asm volatile("" : "+v"(xw));
                    const f32x4 x0 = unpack4h((u32x2){xw[0], xw[1]}), x1 = unpack4h((u32x2){xw[2], xw[3]});
                    __builtin_nontemporal_store(x0 + cf[bj][0] * (acc[ai][bj][m][0] * rstd), (f32x4*)(OUT + o + bj * HALF));
                    __builtin_nontemporal_store(x1 + cf[bj][1] * (acc[ai][bj][m][1] * rstd), (f32x4*)(OUT + o + bj * HALF + 4)); }
                asm volatile("" ::: "memory"); }
    }
};
struct EpiNormResNorm {
    static constexpr bool PERM = true, AFTER_DRAIN = true;
    const float* X; h16* X1; h16* H; float* SSQa; float* SSQb; unsigned* cnta; unsigned* cntb; const float* gpost; const float* gpre; const float* mod;
    __device__ __forceinline__ void fused(f32x4 (&acc)[2][2][4][2], const Unit& u, int, int, int, int, LAS unsigned char* lds, int, int) const {
        int tid = threadIdx.x; asm volatile("" : "+v"(tid));
        const int wid = __builtin_amdgcn_readfirstlane(tid >> 6), lane = tid & 63, wr = wid >> 2, wc = wid & 3, fr = lane & 15, fq = lane >> 4;
        const int row0 = u.pm * BM + wr * 64 + fr, col0 = u.pn * BM + wc * 32 + 8 * fq;
        const unsigned eo = (unsigned)(row0 * DM + col0);
        const float* mb = mod + (size_t)(u.pm >> 4) * 6 * DM;
        const LAS float* S = (const LAS float*)lds;
        row_exchange(acc, SSQa, cnta + 64 * u.pm, u, lds, wid, lane, wr, wc, fr, fq);
        { f32x4 cf[2][2];
#pragma unroll
          for (int bj = 0; bj < 2; ++bj)
#pragma unroll
            for (int n = 0; n < 2; ++n) cf[bj][n] = *(const f32x4*)(gpost + col0 + bj * HALF + 4 * n) * *(const f32x4*)(mb + 2 * DM + col0 + bj * HALF + 4 * n);
#pragma unroll
          for (int ai = 0; ai < 2; ++ai) { f32x4 xv[4][2][2];
#pragma unroll
            for (int m = 0; m < 4; ++m)
#pragma unroll
                for (int bj = 0; bj < 2; ++bj)
#pragma unroll
                    for (int n = 0; n < 2; ++n) xv[m][bj][n] = __builtin_nontemporal_load((const f32x4*)(X + (eo + (unsigned)((ai * HALF + m * 16) * DM + bj * HALF + 4 * n))));
#pragma unroll
            for (int m = 0; m < 4; ++m) { const float rstd = S[ai * HALF + wr * 64 + m * 16 + fr]; const unsigned o = eo + (unsigned)((ai * HALF + m * 16) * DM);
#pragma unroll
                for (int bj = 0; bj < 2; ++bj) { f32x4 x0 = xv[m][bj][0], x1 = xv[m][bj][1]; asm volatile("" : "+v"(x0), "+v"(x1));
                    const f32x4 v0 = x0 + cf[bj][0] * (acc[ai][bj][m][0] * rstd), v1 = x1 + cf[bj][1] * (acc[ai][bj][m][1] * rstd);
                    acc[ai][bj][m][0] = v0; acc[ai][bj][m][1] = v1;
                    u32x4 w; w.x = pk2h(v0[0], v0[1]); w.y = pk2h(v0[2], v0[3]); w.z = pk2h(v1[0], v1[1]); w.w = pk2h(v1[2], v1[3]);
                    *(u32x4*)(X1 + o + bj * HALF) = w; }
                asm volatile("" ::: "memory"); } } }
        row_exchange(acc, SSQb, cntb + 64 * u.pm, u, lds, wid, lane, wr, wc, fr, fq);
        { f32x4 ca[2][2], cs[2][2];
#pragma unroll
          for (int bj = 0; bj < 2; ++bj)
#pragma unroll
            for (int n = 0; n < 2; ++n) { const int c = col0 + bj * HALF + 4 * n; ca[bj][n] = *(const f32x4*)(gpre + c) * (*(const f32x4*)(mb + 4 * DM + c) + 1.f); cs[bj][n] = *(const f32x4*)(mb + 3 * DM + c); }
#pragma unroll
          for (int ai = 0; ai < 2; ++ai)
#pragma unroll
            for (int m = 0; m < 4; ++m) { const float rstd = S[ai * HALF + wr * 64 + m * 16 + fr]; const unsigned o = eo + (unsigned)((ai * HALF + m * 16) * DM);
#pragma unroll
                for (int bj = 0; bj < 2; ++bj) { const f32x4 y0 = (acc[ai][bj][m][0] * rstd) * ca[bj][0] + cs[bj][0], y1 = (acc[ai][bj][m][1] * rstd) * ca[bj][1] + cs[bj][1];
                    u32x4 w; w.x = pk2h(y0[0], y0[1]); w.y = pk2h(y0[2], y0[3]); w.z = pk2h(y1[0], y1[1]); w.w = pk2h(y1[2], y1[3]);
                    *(u32x4*)(H + o + bj * HALF) = w; }
                asm volatile("" ::: "memory"); } }
    }
};
}

#define XB_TMO      128
#define XB_XCNT(j)  (256  + 64 * (j))
#define XB_XSUB(j)  (1280 + 64 * (j))
#define XB_XGEN(j)  (2304 + 64 * (j))
#define XB_TOP      3328
#define XB_TOPGEN   3392
#define XCD_BAR_WORDS 3456
#define XB_SPIN_CAP (1u << 20)
__device__ __forceinline__ unsigned xb_ld(unsigned* p)              { return __hip_atomic_load(p, __ATOMIC_RELAXED, __HIP_MEMORY_SCOPE_AGENT); }
__device__ __forceinline__ unsigned xb_add(unsigned* p, unsigned v) { return __hip_atomic_fetch_add(p, v, __ATOMIC_RELAXED, __HIP_MEMORY_SCOPE_AGENT); }
__device__ __forceinline__ unsigned xb_xcc_id() { return (unsigned)__builtin_amdgcn_s_getreg((3 << 11) | 20) & 0xFu; }
#define XB_SPIN(cond, bar) do { unsigned _sp = 0; while (cond) { __builtin_amdgcn_s_sleep(1); \
    if ((++_sp & 255u) == 0u) { if (xb_ld(&(bar)[XB_TMO])) break; if (_sp > XB_SPIN_CAP) { atomicAdd(&(bar)[XB_TMO], 1u); break; } } } } while (0)
struct XcdBarrier { unsigned* bar; unsigned x; volatile LAS unsigned* st; };
__device__ __forceinline__ XcdBarrier xcd_barrier_post(unsigned* bar, volatile LAS unsigned* st) {
    XcdBarrier b; b.bar = bar; b.x = xb_xcc_id(); b.st = st;
    if (threadIdx.x == 0) (void)xb_add(&bar[XB_XCNT(b.x)], 1u);
    return b;
}
__device__ __forceinline__ void xcd_barrier_complete(unsigned* bar, unsigned x, unsigned& nloc, unsigned& nx) {
    const unsigned G = gridDim.x * gridDim.y * gridDim.z;
    unsigned sum, cnt, mine, sp = 0u;
    for (;;) {
        sum = 0u; cnt = 0u; mine = 0u;
#pragma unroll
        for (unsigned j = 0; j < 16; ++j) { const unsigned c = xb_ld(&bar[XB_XCNT(j)]); sum += c; cnt += (c > 0u) ? 1u : 0u; mine = (j == x) ? c : mine; }
        if (sum == G) break;
        __builtin_amdgcn_s_sleep(1);
        if ((++sp & 255u) == 0u) { if (xb_ld(&bar[XB_TMO])) break; if (sp > XB_SPIN_CAP) { atomicAdd(&bar[XB_TMO], 1u); break; } }
    }
    nloc = mine > 0u ? mine : 1u; nx = cnt > 0u ? cnt : 1u;
}
__device__ __forceinline__ void xcd_barrier(const XcdBarrier& b) {
    asm volatile("s_waitcnt vmcnt(0)" ::: "memory");
    __syncthreads();
    if (threadIdx.x == 0) {
        unsigned* bar = b.bar;
        __builtin_amdgcn_s_waitcnt(0);
        unsigned nloc = b.st[0], nx = b.st[1];
        if (nloc == 0u) { xcd_barrier_complete(bar, b.x, nloc, nx); b.st[0] = nloc; b.st[1] = nx; }
        const unsigned old = xb_add(&bar[XB_XSUB(b.x)], 1u);
        const unsigned gen = old / nloc;
        if (old + 1u == (gen + 1u) * nloc) {
            __builtin_amdgcn_fence(__ATOMIC_RELEASE, "agent");
            asm volatile("s_waitcnt vmcnt(0)" ::: "memory");
            const unsigned og = xb_add(&bar[XB_TOP], 1u);
            const unsigned tg = og / nx;
            if (og + 1u == (tg + 1u) * nx) xb_add(&bar[XB_TOPGEN], 1u);
            else XB_SPIN(xb_ld(&bar[XB_TOPGEN]) == tg, bar);
            __builtin_amdgcn_fence(__ATOMIC_ACQUIRE, "agent");
            xb_add(&bar[XB_XGEN(b.x)], 1u);
            asm volatile("s_waitcnt vmcnt(0)" ::: "memory");
        } else {
            XB_SPIN(xb_ld(&bar[XB_XGEN(b.x)]) == gen, bar);
            __builtin_amdgcn_fence(__ATOMIC_ACQUIRE, "agent");
            asm volatile("s_waitcnt vmcnt(0)" ::: "memory");
        }
    }
    __syncthreads();
}

constexpr int RING_BYTES = 131072;
constexpr int LDSCTL_OFF = 143360;
constexpr int LDS_BYTES = 147456;
constexpr int NWAVES = 8;
#ifndef T_IN_P4
#define T_IN_P4 1
#endif
constexpr int NT_GV = (T_IN_P4 && GV_Q) ? 256 : 0, NT_ITEMS = T_IN_P4 ? 576 + NT_GV : 0, NQ_TOTAL = 512 + NT_ITEMS, NQ_MAX = 1088;

struct Args { const float* in[18]; float* out; unsigned char* ws; int ph_lo, ph_hi; unsigned short order[NQ_MAX]; };

__device__ __forceinline__ float wave_sum(float v) {
#pragma unroll
    for (int o = 1; o < 64; o <<= 1) v += __shfl_xor(v, o);
    return v;
}
__device__ __forceinline__ float silu_f(float v) { return v / (1.f + __expf(-v)); }

__device__ __forceinline__ int win_src_col(int n) {
    if (n >= NQKV) { const int k = n - NQKV; return k < 24 ? 2560 + k : -1; }
    const int pn = n >> 8; int j = n & 127; const int hb = n & ~127;
    if (pg8::is_rope_tile(pn)) { const int a = j >> 3, b = j & 7; j = (b < 4) ? 4 * a + b : 64 + 4 * a + (b - 4); }
    return hb + j + (n >= 2560 ? 24 : 0);
}
__device__ __forceinline__ void transpose_item64(const float* W, int ldw, int K, h16* WT, int k0, int n0, int src4, int dl, LAS float* scr, int lane) {
    const int kk = lane >> 4;
    f32x4 v[16];
#pragma unroll
    for (int i = 0; i < 16; ++i) v[i] = src4 >= 0 ? *(const f32x4*)(W + (size_t)(k0 + 4 * i + kk) * ldw + src4) : (f32x4){0.f, 0.f, 0.f, 0.f};
#pragma unroll
    for (int i = 0; i < 16; ++i) { LAS float* p = scr + (4 * i + kk) * 65 + dl; p[0] = v[i].x; p[1] = v[i].y; p[2] = v[i].z; p[3] = v[i].w; }
    asm volatile("s_waitcnt lgkmcnt(0)" ::: "memory");
    const int c = lane & 7;
#pragma unroll
    for (int j = 0; j < 8; ++j) { const int n = (lane >> 3) + 8 * j; const LAS float* sp = scr + (8 * c) * 65 + n;
        u32x4 o; o.x = pk2h(sp[0 * 65], sp[1 * 65]); o.y = pk2h(sp[2 * 65], sp[3 * 65]); o.z = pk2h(sp[4 * 65], sp[5 * 65]); o.w = pk2h(sp[6 * 65], sp[7 * 65]);
        *(u32x4*)(WT + (size_t)(n0 + n) * K + k0 + 8 * c) = o; }
    asm volatile("s_waitcnt lgkmcnt(0)" ::: "memory");
}
template <bool NTL = false>
__device__ __forceinline__ void transpose_item128(const float* W, int ldw, int K, h16* WT, int k0, int n0, int src4, int dl, LAS float* scr, int lane) {
    const int kk = lane >> 4;
    f32x4 v[32];
#pragma unroll
    for (int i = 0; i < 32; ++i) { const f32x4* p = (const f32x4*)(W + (size_t)(k0 + 4 * i + kk) * ldw + src4); v[i] = src4 >= 0 ? (NTL ? __builtin_nontemporal_load(p) : *p) : (f32x4){0.f, 0.f, 0.f, 0.f}; }
    const int c = lane & 7;
#pragma unroll
    for (int hpass = 0; hpass < 2; ++hpass) {
#pragma unroll
        for (int i = 0; i < 16; ++i) { LAS float* p = scr + (4 * i + kk) * 65 + dl; const f32x4 x = v[16 * hpass + i]; p[0] = x.x; p[1] = x.y; p[2] = x.z; p[3] = x.w; }
        asm volatile("s_waitcnt lgkmcnt(0)" ::: "memory");
#pragma unroll
        for (int j = 0; j < 8; ++j) { const int n = (lane >> 3) + 8 * j; const LAS float* sp = scr + (8 * c) * 65 + n;
            u32x4 o; o.x = pk2h(sp[0 * 65], sp[1 * 65]); o.y = pk2h(sp[2 * 65], sp[3 * 65]); o.z = pk2h(sp[4 * 65], sp[5 * 65]); o.w = pk2h(sp[6 * 65], sp[7 * 65]);
            *(u32x4*)(WT + (size_t)(n0 + n) * K + k0 + 64 * hpass + 8 * c) = o; }
        asm volatile("s_waitcnt lgkmcnt(0)" ::: "memory");
    }
}
__device__ __forceinline__ void win_map64(int n0, int q, int& src4, int& dl) {
    if (n0 >= NQKV) { const int k = n0 - NQKV + 4 * q; src4 = (k + 4 <= 24) ? 2560 + k : -1; dl = 4 * q; return; }
    const int pn = n0 >> 8, hb = n0 & ~127, j0 = n0 & 127, add = n0 >= 2560 ? 24 : 0;
    if (pg8::is_rope_tile(pn)) { if (q < 8) { src4 = hb + (j0 >> 1) + 4 * q + add; dl = 8 * q; } else { src4 = hb + 64 + (j0 >> 1) + 4 * (q - 8) + add; dl = 8 * (q - 8) + 4; } }
    else { src4 = n0 + 4 * q + add; dl = 4 * q; }
}

__device__ __forceinline__ void gemv_half(const float* c_in, const float* w_ada, const float* b_ada, float* mod, int cch, int k32, int lane) {
    const int col = cch * 256 + lane * 4; const int kb = k32 * 32;
    const int s0v = __float_as_int(silu_f(c_in[kb + (lane & 31)])), s1v = __float_as_int(silu_f(c_in[DM + kb + (lane & 31)]));
    const float* wp = w_ada + (size_t)kb * (6 * DM) + col;
    f32x4 w[32];
#pragma unroll
    for (int k = 0; k < 32; ++k) w[k] = __builtin_nontemporal_load((const f32x4*)(wp + (size_t)k * (6 * DM)));
    f32x4 a0 = {0.f, 0.f, 0.f, 0.f}, a1 = {0.f, 0.f, 0.f, 0.f};
#pragma unroll
    for (int k = 0; k < 32; ++k) { const float s0 = __int_as_float(__builtin_amdgcn_readlane(s0v, k)), s1 = __int_as_float(__builtin_amdgcn_readlane(s1v, k)); a0 += w[k] * s0; a1 += w[k] * s1; }
    if (k32 == 0) { const f32x4 bv = *(const f32x4*)(b_ada + col); a0 += bv; a1 += bv; }
#pragma unroll
    for (int e = 0; e < 4; ++e) { atomicAdd(mod + col + e, a0[e]); atomicAdd(mod + 6 * DM + col + e, a1[e]); }
}

__device__ __forceinline__ void p0_prologue(const Args& A, LAS unsigned char* lds, int gw, int NGW, int wave, int lane, int rep) {
    unsigned char* ws = A.ws;
    LAS float* scr = (LAS float*)(lds + wave * 16640);
    const float* c_in = A.in[1]; const float* w_ada = A.in[2]; const float* b_ada = A.in[3];
    float* mod = (float*)(ws + WS_MOD); float* posb = (float*)(ws + WS_POSB);
    constexpr int I_GEMV = 48 * 32;
    constexpr int I_DN = (DFF / 128) * (DM / 64), I_UP = (DM / 128) * (DFF / 64), I_IN = (DM / 128) * (NPAD / 64), I_O = (DM / 128) * (DM / 64);
    constexpr int I_W1 = 2 * (4096 / 64) * (128 / 64), I_W2 = 2 * (128 / 64) * (128 / 64), I_ROPE = 4096, I_POSB = 256, I_KMZ = 32;
    constexpr int NITEMS = I_GEMV + (T_IN_P4 ? 0 : I_DN + I_UP + I_O) + I_IN + I_W1 + I_W2 + I_ROPE + I_POSB + I_KMZ;
    const int q16 = lane & 15;
    const bool bal = P0_BAL && T_IN_P4 && NGW == 2048 && rep == 0;
    if (bal && GV_Q) {
        int wi = -1;
        if (gw < 1024) { gemv_half(c_in, w_ada, b_ada, mod, gw & 15, gw >> 4, lane); if (gw < I_IN - 1024) wi = 1024 + gw; } else wi = gw - 1024;
        if (wi >= 0) { const int nblk = NPAD / 64, kb = wi / nblk, nb = wi % nblk; int src4, dl; win_map64(64 * nb, q16, src4, dl); transpose_item128<true>(A.in[6], INCOLS, DM, (h16*)(ws + WS_WIN), 128 * kb, 64 * nb, src4, dl, scr, lane); }
    } else if (bal) {
        if (gw < I_IN) { gemv_half(c_in, w_ada, b_ada, mod, gw % 48, gw / 48, lane);
            const int nblk = NPAD / 64, kb = gw / nblk, nb = gw % nblk; int src4, dl; win_map64(64 * nb, q16, src4, dl); transpose_item128<true>(A.in[6], INCOLS, DM, (h16*)(ws + WS_WIN), 128 * kb, 64 * nb, src4, dl, scr, lane); }
        else {
#pragma unroll 1
            for (int h = gw; h < 2 * I_GEMV; h += 2048 - I_IN) gemv_half(c_in, w_ada, b_ada, mod, h % 48, h / 48, lane); }
    }
    for (int it = gw + (bal ? I_GEMV + I_IN : 0); it < NITEMS; it += NGW) {
        int r = it;
        if (r < I_GEMV) {
            const int cch = r % 48, kch = r / 48; const int col = cch * 256 + lane * 4; const int kb = kch * 64;
            if (GV_Q && T_IN_P4 && cch >= 16) continue;
            f32x4 a0 = {0.f, 0.f, 0.f, 0.f}, a1 = {0.f, 0.f, 0.f, 0.f};
#pragma unroll 16
            for (int k = 0; k < 64; ++k) { const float s0 = silu_f(c_in[kb + k]), s1 = silu_f(c_in[DM + kb + k]);
                const f32x4 w = __builtin_nontemporal_load((const f32x4*)(w_ada + (size_t)(kb + k) * (6 * DM) + col)); a0 += w * s0; a1 += w * s1; }
            if (kch == 0) { const f32x4 bv = *(const f32x4*)(b_ada + col); a0 += bv; a1 += bv; }
#pragma unroll
            for (int e = 0; e < 4; ++e) { atomicAdd(mod + rep * 24576 + col + e, a0[e]); atomicAdd(mod + rep * 24576 + 6 * DM + col + e, a1[e]); }
            continue; }
        r -= I_GEMV;
        if (!T_IN_P4 && r < I_DN) { const int nblk = DM / 64, kb = r / nblk, nb = r % nblk; transpose_item128(A.in[17], DM, DFF, (h16*)(ws + WS_WDN), 128 * kb, 64 * nb, 64 * nb + 4 * q16, 4 * q16, scr, lane); continue; }
        if (!T_IN_P4) r -= I_DN;
        if (!T_IN_P4 && r < I_UP) { const int nblk = DFF / 64, kb = r / nblk, nb = r % nblk; transpose_item128(A.in[16], DFF, DM, (h16*)(ws + WS_WUP), 128 * kb, 64 * nb, 64 * nb + 4 * q16, 4 * q16, scr, lane); continue; }
        if (!T_IN_P4) r -= I_UP;
        if (r < I_IN) { const int nblk = NPAD / 64, kb = r / nblk, nb = r % nblk; int src4, dl; win_map64(64 * nb, q16, src4, dl); transpose_item128<true>(A.in[6], INCOLS, DM, (h16*)(ws + WS_WIN), 128 * kb, 64 * nb, src4, dl, scr, lane); continue; }
        r -= I_IN;
        if (!T_IN_P4 && r < I_O) { const int nblk = DM / 64, kb = r / nblk, nb = r % nblk; transpose_item128(A.in[13], DM, DM, (h16*)(ws + WS_WO), 128 * kb, 64 * nb, 64 * nb + 4 * q16, 4 * q16, scr, lane); continue; }
        if (!T_IN_P4) r -= I_O;
        if (r < I_W1) { const int kv = r / 128, q = r % 128, kb = q / 2, nb = q % 2; transpose_item64(A.in[kv ? 11 : 8], 128, 4096, (h16*)(ws + WS_W1T) + (size_t)kv * 128 * 4096, 64 * kb, 64 * nb, 64 * nb + 4 * q16, 4 * q16, scr, lane); continue; }
        r -= I_W1;
        if (r < I_W2) { const int kv = r / 4, q = r % 4, kb = q / 2, nb = q % 2; transpose_item64(A.in[kv ? 12 : 9], 128, 128, (h16*)(ws + WS_W2T) + (size_t)kv * 128 * 128, 64 * kb, 64 * nb, 64 * nb + 4 * q16, 4 * q16, scr, lane); continue; }
        r -= I_W2;
        if (r < I_POSB) { const int kv = r / 128, kc = r % 128; const float* pos = A.in[kv ? 10 : 7]; const float* w1 = A.in[kv ? 11 : 8];
            f32x2 wv[32];
#pragma unroll
            for (int k = 0; k < 32; ++k) wv[k] = *(const f32x2*)(w1 + (size_t)(kc * 32 + k) * 128 + 2 * lane);
            const int pl = __float_as_int(pos[kc * 32 + (lane & 31)]);
            f32x2 a = {0.f, 0.f};
#pragma unroll
            for (int k = 0; k < 32; ++k) a += wv[k] * __int_as_float(__builtin_amdgcn_readlane(pl, k));
            atomicAdd(posb + rep * 256 + kv * 128 + 2 * lane, a.x); atomicAdd(posb + rep * 256 + kv * 128 + 2 * lane + 1, a.y);
            continue; }
        r -= I_POSB;
        if (r < I_KMZ) { u32x4 z = {0u, 0u, 0u, 0u}; u32x4* p = (u32x4*)(ws + WS_KMEAN + (size_t)r * 4096);
#pragma unroll
          for (int q = 0; q < 4; ++q) p[q * 64 + lane] = z;
          continue; }
        r -= I_KMZ;
        { float* COS = (float*)(ws + WS_COS); float* SIN = (float*)(ws + WS_SIN);
            { const int e = r * 64 + lane; const int t = e >> 6, i = e & 63;
              const float inv = powf(10000.f, -(float)(2 * i) / 128.f); const float ang = (float)t * inv; COS[e] = cosf(ang); SIN[e] = sinf(ang); } }
    }
}

__device__ __forceinline__ void p1_rows(const Args& A, int gw, int NGW, int lane) {
    const float* x = A.in[0]; const float* g1 = A.in[4]; const float* mod = (const float*)(A.ws + WS_MOD); h16* H = (h16*)(A.ws + WS_H);
    for (int row = gw; row < M; row += NGW) {
        const int b = row >> 12; const f32x4* xr = (const f32x4*)(x + (size_t)row * DM) + lane;
        f32x4 v[8]; float s = 0.f;
#pragma unroll
        for (int j = 0; j < 8; ++j) { v[j] = __builtin_nontemporal_load(xr + 64 * j); s += (v[j].x * v[j].x + v[j].y * v[j].y) + (v[j].z * v[j].z + v[j].w * v[j].w); }
        const float rstd = 1.f / sqrtf(wave_sum(s) * (1.f / DM) + EPS);
        u32x2* o8 = (u32x2*)(H + (size_t)row * DM) + lane;
#pragma unroll
        for (int j = 0; j < 8; ++j) { const int col = 4 * lane + 256 * j;
            const f32x4 g = *(const f32x4*)(g1 + col), sh = *(const f32x4*)(mod + b * 6 * DM + col), sc = *(const f32x4*)(mod + b * 6 * DM + DM + col);
            const f32x4 y = (v[j] * rstd * g) * (sc + 1.f) + sh;
            u32x2 w; w.x = pk2h(y.x, y.y); w.y = pk2h(y.z, y.w); o8[64 * j] = w; }
    }
}
__device__ __forceinline__ void p6_rows(const Args& A, int gw, int NGW, int lane) {
    const float* x = A.in[0]; const float* gpost = A.in[5]; const float* gpre = A.in[14]; const float* mod = (const float*)(A.ws + WS_MOD);
    const h16* OP = (const h16*)(A.ws + WS_OP); const float* SSQ = (const float*)(A.ws + WS_SSQ); h16* H = (h16*)(A.ws + WS_H); h16* X1 = (h16*)(A.ws + WS_X1);
    for (int row0 = gw; row0 < M; row0 += 2 * NGW) {
        f32x4 v[2][8]; u32x2 opv[2][8]; float ssp[2];
#pragma unroll
        for (int q = 0; q < 2; ++q) { const int row = row0 + q * NGW;
            ssp[q] = lane < 32 ? SSQ[(size_t)row * 32 + lane] : 0.f;
            const f32x4* xr = (const f32x4*)(x + (size_t)row * DM) + lane; const u32x2* opr = (const u32x2*)(OP + (size_t)row * DM) + lane;
#pragma unroll
            for (int j = 0; j < 8; ++j) { v[q][j] = xr[64 * j]; opv[q][j] = opr[64 * j]; } }
#pragma unroll
        for (int q = 0; q < 2; ++q) { const int row = row0 + q * NGW; const int b = row >> 12; const float* mb = mod + b * 6 * DM;
            const float rstd = 1.f / sqrtf(wave_sum(ssp[q]) * (1.f / DM) + EPS); float s = 0.f;
#pragma unroll
            for (int j = 0; j < 8; ++j) { const int col = 4 * lane + 256 * j;
                const f32x4 g = *(const f32x4*)(gpost + col), gm = *(const f32x4*)(mb + 2 * DM + col);
                v[q][j] = v[q][j] + gm * (unpack4h(opv[q][j]) * rstd * g);
                s += (v[q][j].x * v[q][j].x + v[q][j].y * v[q][j].y) + (v[q][j].z * v[q][j].z + v[q][j].w * v[q][j].w); }
            const float rstd2 = 1.f / sqrtf(wave_sum(s) * (1.f / DM) + EPS);
            u32x2* x1r = (u32x2*)(X1 + (size_t)row * DM) + lane; u32x2* o8 = (u32x2*)(H + (size_t)row * DM) + lane;
#pragma unroll
            for (int j = 0; j < 8; ++j) { const int col = 4 * lane + 256 * j;
                { u32x2 w1; w1.x = pk2h(v[q][j].x, v[q][j].y); w1.y = pk2h(v[q][j].z, v[q][j].w); x1r[64 * j] = w1; }
                const f32x4 g = *(const f32x4*)(gpre + col), sh = *(const f32x4*)(mb + 3 * DM + col), sc = *(const f32x4*)(mb + 4 * DM + col);
                const f32x4 y = (v[q][j] * rstd2 * g) * (sc + 1.f) + sh;
                u32x2 w; w.x = pk2h(y.x, y.y); w.y = pk2h(y.z, y.w); o8[64 * j] = w; } }
    }
}
__device__ __forceinline__ void p9_rows(const Args& A, int gw, int NGW, int lane) {
    const float* gpost = A.in[15]; const float* mod = (const float*)(A.ws + WS_MOD);
    const h16* F = (const h16*)(A.ws + WS_F); const float* SSQ = (const float*)(A.ws + WS_SSQ); const h16* X1 = (const h16*)(A.ws + WS_X1); float* OUT = A.out;
    for (int row0 = gw; row0 < M; row0 += 2 * NGW) {
        u32x2 xv[2][8], fv[2][8]; float ssp[2];
#pragma unroll
        for (int q = 0; q < 2; ++q) { const int row = row0 + q * NGW;
            ssp[q] = lane < 32 ? SSQ[(size_t)row * 32 + lane] : 0.f;
            const u32x2* x1r = (const u32x2*)(X1 + (size_t)row * DM) + lane; const u32x2* fr = (const u32x2*)(F + (size_t)row * DM) + lane;
#pragma unroll
            for (int j = 0; j < 8; ++j) { xv[q][j] = x1r[64 * j]; fv[q][j] = fr[64 * j]; } }
#pragma unroll
        for (int q = 0; q < 2; ++q) { const int row = row0 + q * NGW; const int b = row >> 12; const float* mb = mod + b * 6 * DM;
            const float rstd = 1.f / sqrtf(wave_sum(ssp[q]) * (1.f / DM) + EPS);
            f32x4* outr = (f32x4*)(OUT + (size_t)row * DM) + lane;
#pragma unroll
            for (int j = 0; j < 8; ++j) { const int col = 4 * lane + 256 * j;
                const f32x4 g = *(const f32x4*)(gpost + col), gf = *(const f32x4*)(mb + 5 * DM + col);
                outr[64 * j] = unpack4h(xv[q][j]) + gf * (unpack4h(fv[q][j]) * rstd * g); } }
    }
}

__device__ __forceinline__ void p3_compress_item(const Args& A, LAS unsigned char* lds, int item, int wave, int lane) {
    const int kv = item >> 6, b = (item >> 5) & 1, g = (item >> 4) & 1, rt = item & 15;
    const h16* QKV = (const h16*)(A.ws + WS_QKV); const h16* W1T = (const h16*)(A.ws + WS_W1T) + (size_t)kv * 128 * 4096;
    const h16* W2T = (const h16*)(A.ws + WS_W2T) + (size_t)kv * 128 * 128; const float* posb = (const float*)(A.ws + WS_POSB) + kv * 128;
    h16* OUT = (h16*)(A.ws + WS_KC) + ((size_t)((kv * 2 + b) * 2 + g) * 256) * 128;
    const int colbase = (kv ? C_VCMP : C_KCMP) + g * 128;
    const int i16 = lane & 15, kq = lane >> 4;
    int n = 16 * rt + i16; const int nc = n > 254 ? 254 : n;
    f32x4 acc[8];
#pragma unroll
    for (int nt = 0; nt < 8; ++nt) acc[nt] = (f32x4){0.f, 0.f, 0.f, 0.f};
#pragma unroll 8
    for (int ks = 0; ks < 16; ++ks) {
        const int l = 4 * wave + (ks >> 2), d = ((ks & 3) * 32 + 8 * kq);
        const h16x8 af = *(const h16x8*)(QKV + (size_t)(b * SEQ + 16 * nc + l) * NQKV + colbase + d);
        const int k = 512 * wave + 32 * ks + 8 * kq;
#pragma unroll
        for (int nt = 0; nt < 8; ++nt) { const h16x8 bf = *(const h16x8*)(W1T + (size_t)(16 * nt + i16) * 4096 + k);
            acc[nt] = __builtin_amdgcn_mfma_f32_16x16x32_f16(af, bf, acc[nt], 0, 0, 0); }
    }
    LAS float* red = (LAS float*)lds;
    LAS h16* hid = (LAS h16*)(lds + 65536);
#pragma unroll
    for (int nt = 0; nt < 8; ++nt)
#pragma unroll
        for (int rg = 0; rg < 4; ++rg) red[(wave * 16 + 4 * kq + rg) * 128 + 16 * nt + i16] = acc[nt][rg];
    __syncthreads();
    { const int tid = wave * 64 + lane;
#pragma unroll
      for (int q = 0; q < 4; ++q) { const int e = tid + 512 * q; const int j = e & 127; float s = posb[j];
#pragma unroll
          for (int w = 0; w < 8; ++w) s += red[w * 2048 + e];
          hid[e] = (h16)silu_f(s); } }
    __syncthreads();
    f32x4 o = {0.f, 0.f, 0.f, 0.f};
#pragma unroll
    for (int ks = 0; ks < 4; ++ks) { const h16x8 af = *(const LAS h16x8*)(hid + i16 * 128 + 32 * ks + 8 * kq);
        const h16x8 bf = *(const h16x8*)(W2T + (size_t)(16 * wave + i16) * 128 + 32 * ks + 8 * kq);
        o = __builtin_amdgcn_mfma_f32_16x16x32_f16(af, bf, o, 0, 0, 0); }
#pragma unroll
    for (int rg = 0; rg < 4; ++rg) { const int nn = 16 * rt + 4 * kq + rg; OUT[(size_t)nn * 128 + 16 * wave + i16] = nn > 254 ? (h16)0.f : (h16)o[rg]; }
    __syncthreads();
}
__device__ __forceinline__ void p3_compress_splitk(const Args& A, LAS unsigned char* lds, unsigned* ctl, int it, int wave, int lane) {
    const int kv = it >> 7, mt = (it >> 3) & 15, ks8 = it & 7, b = mt >> 3, g = (mt >> 2) & 1, mq = mt & 3;
    const h16* QKV = (const h16*)(A.ws + WS_QKV); const h16* W1T = (const h16*)(A.ws + WS_W1T) + (size_t)kv * 128 * 4096;
    const h16* W2T = (const h16*)(A.ws + WS_W2T) + (size_t)kv * 128 * 128; const float* posb = (const float*)(A.ws + WS_POSB) + kv * 128;
    h16* OUT = (h16*)(A.ws + WS_KC) + ((size_t)((kv * 2 + b) * 2 + g) * 256) * 128;
    float* PART = (float*)(A.ws + WS_F) + (size_t)((kv * 16 + mt) * 8) * 8192;
    unsigned* cntw = ctl + CW_XCH + 6144 + 64 * (kv * 16 + mt);
    const int colbase = (kv ? C_VCMP : C_KCMP) + g * 128;
    const int i16 = lane & 15, kq = lane >> 4, wr = wave >> 1, wk = wave & 1;
    const int n = 64 * mq + 16 * wr + i16; const int nc = n > 254 ? 254 : n;
    f32x4 acc[8];
#pragma unroll
    for (int nt = 0; nt < 8; ++nt) acc[nt] = (f32x4){0.f, 0.f, 0.f, 0.f};
#pragma unroll
    for (int s_ = 0; s_ < 8; ++s_) {
        const int l = 4 * ks8 + 2 * wk + (s_ >> 2), d = (s_ & 3) * 32 + 8 * kq;
        const h16x8 af = *(const h16x8*)(QKV + (size_t)(b * SEQ + 16 * nc + l) * NQKV + colbase + d);
        const int k = 512 * ks8 + 256 * wk + 32 * s_ + 8 * kq;
#pragma unroll
        for (int nt = 0; nt < 8; ++nt) { const h16x8 bf = *(const h16x8*)(W1T + (size_t)(16 * nt + i16) * 4096 + k);
            acc[nt] = __builtin_amdgcn_mfma_f32_16x16x32_f16(af, bf, acc[nt], 0, 0, 0); }
    }
    LAS float* red = (LAS float*)lds;
    LAS h16* hid = (LAS h16*)(lds + 65536);
#pragma unroll
    for (int nt = 0; nt < 8; ++nt)
#pragma unroll
        for (int rg = 0; rg < 4; ++rg) red[(wave * 16 + 4 * kq + rg) * 128 + 16 * nt + i16] = acc[nt][rg];
    __syncthreads();
    { const int tid = wave * 64 + lane;
#pragma unroll
      for (int q = 0; q < 4; ++q) { const int f = (tid + 512 * q) * 4; const int w2 = f >> 11, rest = f & 2047;
          const f32x4 v = *(const LAS f32x4*)(red + (2 * w2) * 2048 + rest) + *(const LAS f32x4*)(red + (2 * w2 + 1) * 2048 + rest);
          const float* dp = PART + (size_t)ks8 * 8192 + f;
          asm volatile("global_store_dwordx4 %0, %1, off sc0 sc1\n\ts_nop 2" :: "v"(dp), "v"(v) : "memory"); } }
    asm volatile("s_waitcnt vmcnt(0)" ::: "memory");
    if (lane == 0) __hip_atomic_fetch_add(cntw, 1u, __ATOMIC_RELAXED, __HIP_MEMORY_SCOPE_AGENT);
    if (ks8 < 4) {
        if (wave == 0) { unsigned sp = 0u;
            while ((unsigned)__builtin_amdgcn_readfirstlane((int)__hip_atomic_load(cntw, __ATOMIC_RELAXED, __HIP_MEMORY_SCOPE_AGENT)) < 64u) { __builtin_amdgcn_s_sleep(1); if (++sp > (1u << 22)) break; }
            __builtin_amdgcn_fence(__ATOMIC_ACQUIRE, "agent"); }
        __syncthreads();
        { const int tid = wave * 64 + lane; const int e4 = tid * 4; const float* p = PART + (size_t)ks8 * 2048 + e4; f32x4 q0, q1, q2, q3, q4, q5, q6, q7;
          asm volatile("global_load_dwordx4 %0, %8, off sc1\n\tglobal_load_dwordx4 %1, %9, off sc1\n\tglobal_load_dwordx4 %2, %10, off sc1\n\tglobal_load_dwordx4 %3, %11, off sc1\n\t"
                       "global_load_dwordx4 %4, %12, off sc1\n\tglobal_load_dwordx4 %5, %13, off sc1\n\tglobal_load_dwordx4 %6, %14, off sc1\n\tglobal_load_dwordx4 %7, %15, off sc1\n\ts_waitcnt vmcnt(0)"
                       : "=&v"(q0), "=&v"(q1), "=&v"(q2), "=&v"(q3), "=&v"(q4), "=&v"(q5), "=&v"(q6), "=&v"(q7)
                       : "v"(p), "v"(p + 8192), "v"(p + 2 * 8192), "v"(p + 3 * 8192), "v"(p + 4 * 8192), "v"(p + 5 * 8192), "v"(p + 6 * 8192), "v"(p + 7 * 8192) : "memory");
          const f32x4 t = (((q0 + q1) + (q2 + q3)) + ((q4 + q5) + (q6 + q7))) + *(const f32x4*)(posb + (e4 & 127));
          h16* hp = (h16*)nullptr; (void)hp;
          u32x2 hw; hw.x = pk2h(silu_f(t[0]), silu_f(t[1])); hw.y = pk2h(silu_f(t[2]), silu_f(t[3]));
          *(LAS u32x2*)(hid + e4) = hw; }
        __syncthreads();
        f32x4 o = {0.f, 0.f, 0.f, 0.f};
#pragma unroll
        for (int ks = 0; ks < 4; ++ks) { const h16x8 af = *(const LAS h16x8*)(hid + i16 * 128 + 32 * ks + 8 * kq);
            const h16x8 bf = *(const h16x8*)(W2T + (size_t)(16 * wave + i16) * 128 + 32 * ks + 8 * kq);
            o = __builtin_amdgcn_mfma_f32_16x16x32_f16(af, bf, o, 0, 0, 0); }
#pragma unroll
        for (int rg = 0; rg < 4; ++rg) { const int nn = 64 * mq + 16 * ks8 + 4 * kq + rg; const h16 ov = nn > 254 ? (h16)0.f : (h16)o[rg]; h16* op_ = OUT + (size_t)nn * 128 + 16 * wave + i16;
            const unsigned ob = (unsigned)__builtin_bit_cast(unsigned short, ov); asm volatile("global_store_short %0, %1, off sc0 sc1" :: "v"(op_), "v"(ob) : "memory"); }
        asm volatile("s_waitcnt vmcnt(0)" ::: "memory");
    }
    __syncthreads();
    if (ks8 < 4 && wave == 0 && lane == 0) __hip_atomic_fetch_add(ctl + CW_P34 + 64 * (b * 2 + g), 1u, __ATOMIC_RELAXED, __HIP_MEMORY_SCOPE_AGENT);
}
__device__ __forceinline__ void p3_kmean_item(const Args& A, LAS unsigned char* lds, int item, int wave, int lane, unsigned* ctl = nullptr) {
    const int b = item >> 6, nb = (item >> 2) & 15, cq = item & 3;
    const h16* QKV = (const h16*)(A.ws + WS_QKV); h16* KM = (h16*)(A.ws + WS_KMEAN);
    const int tid = wave * 64 + lane, cc = tid & 31, rg = tid >> 5;
    const h16* src = QKV + (size_t)(b * SEQ + nb * 256 + rg * 16) * NQKV + C_KM + cq * 256 + cc * 8;
    h16x8 v[16];
#pragma unroll
    for (int r = 0; r < 16; ++r) v[r] = *(const h16x8*)(src + (size_t)r * NQKV);
    float s8[8];
#pragma unroll
    for (int e = 0; e < 8; ++e) s8[e] = 0.f;
#pragma unroll
    for (int r = 0; r < 16; ++r)
#pragma unroll
        for (int e = 0; e < 8; ++e) s8[e] += (float)v[r][e];
    LAS float* red = (LAS float*)lds;
    *(LAS f32x4*)(red + rg * 256 + cc * 8) = (f32x4){s8[0], s8[1], s8[2], s8[3]}; *(LAS f32x4*)(red + rg * 256 + cc * 8 + 4) = (f32x4){s8[4], s8[5], s8[6], s8[7]};
    __syncthreads();
    if (tid < 256) { float t = 0.f;
#pragma unroll
        for (int g_ = 0; g_ < 16; ++g_) t += red[g_ * 256 + tid];
        const int h = cq * 2 + (tid >> 7), d = tid & 127;
        h16* kp_ = KM + ((size_t)(b * 8 + h) * 32 + nb) * 128 + d; const unsigned kb_ = (unsigned)__builtin_bit_cast(unsigned short, (h16)(t * (1.f / 256.f)));
        asm volatile("global_store_short %0, %1, off sc0 sc1\n\ts_waitcnt vmcnt(0)" :: "v"(kp_), "v"(kb_) : "memory"); }
    __syncthreads();
    if (ctl && tid == 0) __hip_atomic_fetch_add(ctl + CW_P34 + 64 * (4 + b * 4 + cq), 1u, __ATOMIC_RELAXED, __HIP_MEMORY_SCOPE_AGENT);
}

namespace att {
constexpr int SHM_K = 16384, SHM_V = 16384;
constexpr int L_V = 0, L_K = 3 * SHM_V, L_WS = L_K + 3 * SHM_K, L_IMP = L_WS + NWAVES * 256, L_SEL = L_IMP + 64 * 64 * 4, L_END = L_SEL + 64 * 8;
#define KSWZ(row, colB) ((row) * 256 + ((colB) ^ (((row) & 7) << 4)))
#define SBAR() __builtin_amdgcn_sched_barrier(0)
__device__ __forceinline__ int v_st(int k, int c) { const int kk = (k & ~0xC) | ((k & 4) << 1) | ((k & 8) >> 1); return ((kk >> 3) * 4 + (c >> 5)) * 512 + ((kk & 7) * 32 + (c & 31)) * 2; }
__device__ __forceinline__ int v_rd_base(int lane) { return ((lane & 3) << 3) | (((lane >> 2) & 3) << 6) | (((lane >> 4) & 1) << 5) | (((lane >> 5) & 1) << 8); }
constexpr int v_rd_off(int d0, int ks, int half) { return d0 * 512 + ks * 4096 + half * 2048; }
__device__ __forceinline__ int crow(int r, int hi) { return (r & 3) + 8 * (r >> 2) + 4 * hi; }

struct Ctx {
    int tid, wid, lane, r32, hi, sr, sc, kws, vst0, vst1, vb0;
    LAS char* lds; LAS char* V_lds; LAS char* K_lds; LAS float* wsc;
};
struct Stage { h16x8 k0, k1, v0, v1; };

__device__ __forceinline__ void stage_load(Stage& S, const Ctx& c, const h16* Kp, const h16* Vp, int rs, int key0) {
    const char* kb = (const char*)Kp + (size_t)key0 * rs * 2; const char* vb = (const char*)Vp + (size_t)key0 * rs * 2;
    const unsigned lo = (unsigned)(c.sr * rs + c.sc) * 2u, lo2 = lo + (unsigned)(32 * rs) * 2u;
    S.v0 = *(const h16x8*)(vb + lo); S.v1 = *(const h16x8*)(vb + lo2);
    S.k0 = *(const h16x8*)(kb + lo); S.k1 = *(const h16x8*)(kb + lo2);
}
__device__ __forceinline__ void stage_load_k(Stage& S, const Ctx& c, const h16* Kp, int rs, int key0) {
    const char* kb = (const char*)Kp + (size_t)key0 * rs * 2;
    const unsigned lo = (unsigned)(c.sr * rs + c.sc) * 2u, lo2 = lo + (unsigned)(32 * rs) * 2u;
    S.k0 = *(const h16x8*)(kb + lo); S.k1 = *(const h16x8*)(kb + lo2);
}
template <int BUF> __device__ __forceinline__ void stage_write_k(const Stage& S, const Ctx& c) {
    *(LAS h16x8*)(c.K_lds + BUF * SHM_K + c.kws) = S.k0; *(LAS h16x8*)(c.K_lds + BUF * SHM_K + c.kws + 32 * 256) = S.k1;
}
template <int BUF> __device__ __forceinline__ void stage_write(const Stage& S, const Ctx& c) {
    *(LAS h16x8*)(c.V_lds + BUF * SHM_V + c.vst0) = S.v0; *(LAS h16x8*)(c.V_lds + BUF * SHM_V + c.vst1) = S.v1;
    stage_write_k<BUF>(S, c);
}
template <int KB, bool HALF_ONLY>
__device__ __forceinline__ void qkt(f32x16& p0, f32x16& p1, const Ctx& c, const h16x8* qr) {
    p0 = f32x16{}; p1 = f32x16{};
    const LAS char* kb[4];
#pragma unroll
    for (int dd = 0; dd < 4; ++dd) kb[dd] = c.K_lds + KB * SHM_K + KSWZ(c.r32, (dd * 16 + c.hi * 8) * 2);
#pragma unroll
    for (int d0 = 0; d0 < 8; ++d0) { const LAS char* a = kb[d0 & 3] + (d0 >> 2) * 128;
        const h16x8 b0 = *(const LAS h16x8*)(a);
        p0 = __builtin_amdgcn_mfma_f32_32x32x16_f16(b0, qr[d0], p0, 0, 0, 0);
        if (!HALF_ONLY) { const h16x8 b1 = *(const LAS h16x8*)(a + 32 * 256);
            p1 = __builtin_amdgcn_mfma_f32_32x32x16_f16(b1, qr[d0], p1, 0, 0, 0); } }
}
template <int VB>
__device__ __forceinline__ void pv_tile(f32x16* o, int vb0, h16x8 pa0, h16x8 pa1, h16x8 pa2, h16x8 pa3) {
#define TRRD(dst, off) asm volatile("ds_read_b64_tr_b16 %0, %1 offset:%2" : "=&v"(dst) : "v"(vb0), "i"(off) : "memory")
#define MKB(l, h) __builtin_bit_cast(h16x8, (s16x8){l[0], l[1], l[2], l[3], h[0], h[1], h[2], h[3]})
#define PV_D0(d0) do { s16x4 l0, l1, l2, l3, h0, h1, h2, h3; constexpr int b_ = VB * SHM_V + v_rd_off(d0, 0, 0); \
        TRRD(l0, b_); TRRD(h0, b_ + 2048); TRRD(l1, b_ + 4096); TRRD(h1, b_ + 6144); TRRD(l2, b_ + 8192); TRRD(h2, b_ + 10240); TRRD(l3, b_ + 12288); TRRD(h3, b_ + 14336); \
        asm volatile("s_waitcnt lgkmcnt(0)" ::: "memory"); SBAR(); \
        o[d0] = __builtin_amdgcn_mfma_f32_32x32x16_f16(pa0, MKB(l0, h0), o[d0], 0, 0, 0); \
        o[d0] = __builtin_amdgcn_mfma_f32_32x32x16_f16(pa1, MKB(l1, h1), o[d0], 0, 0, 0); \
        o[d0] = __builtin_amdgcn_mfma_f32_32x32x16_f16(pa2, MKB(l2, h2), o[d0], 0, 0, 0); \
        o[d0] = __builtin_amdgcn_mfma_f32_32x32x16_f16(pa3, MKB(l3, h3), o[d0], 0, 0, 0); } while (0)
    PV_D0(0); PV_D0(1); PV_D0(2); PV_D0(3);
#undef PV_D0
#undef MKB
#undef TRRD
}
__device__ __forceinline__ void mask_tile(f32x16& p0, f32x16& p1, int dq, unsigned W, bool rowon) {
    const float NEG = -__builtin_inff();
#pragma unroll
    for (int r = 0; r < 16; ++r) {
        const int c = (r & 3) + 8 * (r >> 2);
        if (!rowon || (unsigned)(dq - c) >= W) p0[r] = NEG;
        if (!rowon || (unsigned)(dq - c - 32) >= W) p1[r] = NEG;
    }
}
__device__ __forceinline__ float rowmax32(const f32x16& p0, const f32x16& p1) {
    float pmax = p0[0];
#pragma unroll
    for (int r = 1; r < 16; ++r) pmax = fmaxf(pmax, p0[r]);
#pragma unroll
    for (int r = 0; r < 16; ++r) pmax = fmaxf(pmax, p1[r]);
    auto rr = __builtin_amdgcn_permlane32_swap(__float_as_uint(pmax), __float_as_uint(pmax), false, false);
    return fmaxf(__uint_as_float(rr[0]), __uint_as_float(rr[1]));
}
__device__ __forceinline__ float rowsum32(const f32x16& p0, const f32x16& p1) {
    float ps = 0.f;
#pragma unroll
    for (int r = 0; r < 16; ++r) ps += p0[r];
#pragma unroll
    for (int r = 0; r < 16; ++r) ps += p1[r];
    auto rr = __builtin_amdgcn_permlane32_swap(__float_as_uint(ps), __float_as_uint(ps), false, false);
    return __uint_as_float(rr[0]) + __uint_as_float(rr[1]);
}
__device__ __forceinline__ void pack_p(const f32x16& p0, const f32x16& p1, h16x8& pa0, h16x8& pa1, h16x8& pa2, h16x8& pa3) {
#define PK4(P, B_, OUT) do { unsigned a0 = pk2h(P[B_+0], P[B_+1]), a1 = pk2h(P[B_+2], P[B_+3]); \
        unsigned b0 = pk2h(P[B_+4], P[B_+5]), b1 = pk2h(P[B_+6], P[B_+7]); \
        auto r0 = __builtin_amdgcn_permlane32_swap(a0, b0, false, false); auto r1 = __builtin_amdgcn_permlane32_swap(a1, b1, false, false); \
        u32x4 w = {r0[0], r1[0], r0[1], r1[1]}; OUT = __builtin_bit_cast(h16x8, w); } while (0)
    PK4(p0, 0, pa0); PK4(p0, 8, pa1); PK4(p1, 0, pa2); PK4(p1, 8, pa3);
#undef PK4
}
constexpr float THR = 8.f;
struct SM { float m, l; };

template <int BUF>
__device__ __forceinline__ void tile_step(const Ctx& c, const h16x8* qr, f32x16* o, SM& sm, int j, int pos, unsigned W, unsigned long long rowmask, int qlo, int qhi) {
    const int kb = 64 * j;
    const bool rowon = (rowmask >> j) & 1ull;
    const bool act = __any(rowon) && (kb <= qhi) && (kb + 63 >= qlo - (int)W + 1);
    if (!act) return;
    f32x16 p0, p1;
    qkt<BUF, false>(p0, p1, c, qr);
    const bool need = (kb + 63 > qlo) || (kb <= qhi - (int)W) || !__all(rowon);
    if (need) mask_tile(p0, p1, pos - kb - 4 * c.hi, W, rowon);
    const float pmax = rowmax32(p0, p1);
    float mn, alpha;
    if (__builtin_expect(__all((pmax - sm.m) <= THR), 1)) { mn = sm.m; alpha = 1.f; }
    else { mn = fmaxf(sm.m, pmax); alpha = __builtin_amdgcn_exp2f((sm.m - mn) * LOG2E); sm.m = mn; }
    const float mnL = -mn * LOG2E;
#pragma unroll
    for (int r = 0; r < 16; ++r) { p0[r] = __builtin_amdgcn_exp2f(fmaf(p0[r], LOG2E, mnL)); p1[r] = __builtin_amdgcn_exp2f(fmaf(p1[r], LOG2E, mnL)); }
    sm.l = sm.l * alpha + rowsum32(p0, p1);
    h16x8 pa0, pa1, pa2, pa3; pack_p(p0, p1, pa0, pa1, pa2, pa3);
    if (__any(alpha < 1.f)) { LAS float* al = c.wsc + 32; if (c.hi == 0) al[c.r32] = alpha; asm volatile("s_waitcnt lgkmcnt(0)" ::: "memory");
#pragma unroll
        for (int d_ = 0; d_ < 4; ++d_)
#pragma unroll
            for (int r = 0; r < 16; ++r) o[d_][r] *= al[crow(r, c.hi)]; }
    SBAR();
    pv_tile<BUF>(o, c.vb0, pa0, pa1, pa2, pa3);
}
__device__ __forceinline__ int next_tile(unsigned long long tiles, int j) {
    const unsigned long long rest = (j >= 63) ? 0ull : (tiles >> (j + 1)) << (j + 1);
    return rest ? (int)__builtin_ctzll(rest) : -1;
}
template <int VAR>
__device__ __forceinline__ void run_attn(const Ctx& c, const h16x8* qr, f32x16* o, SM& sm, const h16* Kp, const h16* Vp, int rs,
                                         unsigned long long tiles, int pos, unsigned W, unsigned long long rowmask, int qlo, int qhi) {
    Stage S;
    int j = (int)__builtin_ctzll(tiles);
#define SLOAD(jj) do { if (VAR == 0) stage_load(S, c, Kp, Vp, rs, 64 * (jj)); } while (0)
#define SWRITE(B) do { if (VAR == 0) stage_write<B>(S, c); } while (0)
#define TSYNC() do { if (VAR != 2) __syncthreads(); } while (0)
    SLOAD(j); SWRITE(0); __syncthreads();
    for (;;) {
        int jn = next_tile(tiles, j);
        if (jn >= 0) SLOAD(jn);
        tile_step<0>(c, qr, o, sm, j, pos, W, rowmask, qlo, qhi);
        if (jn < 0) break;
        SWRITE(1); TSYNC();
        j = jn; jn = next_tile(tiles, j);
        if (jn >= 0) SLOAD(jn);
        tile_step<1>(c, qr, o, sm, j, pos, W, rowmask, qlo, qhi);
        if (jn < 0) break;
        SWRITE(0); TSYNC();
        j = jn;
    }
    __syncthreads();
#undef SLOAD
#undef SWRITE
#undef TSYNC
}

template <int KB, bool HALF_ONLY>
__device__ __forceinline__ void qkt_sk(f32x16& p0, f32x16& p1, const Ctx& c, const h16x8* qr, bool act) {
    if (!act) { const float NEG = -__builtin_inff();
#pragma unroll
        for (int r = 0; r < 16; ++r) { p0[r] = NEG; p1[r] = NEG; } return; }
    qkt<KB, HALF_ONLY>(p0, p1, c, qr);
}
__device__ __forceinline__ void partialSM(f32x16& p0, f32x16& p1, float& m_reg, float& alpha) {
    const float pmax = rowmax32(p0, p1); float mn;
    if (__builtin_expect(__all((pmax - m_reg) <= THR), 1)) { mn = m_reg; alpha = 1.f; }
    else { mn = fmaxf(m_reg, pmax); alpha = __builtin_amdgcn_exp2f((m_reg - mn) * LOG2E); m_reg = mn; }
    const float mnL = -mn * LOG2E;
#pragma unroll
    for (int r = 0; r < 16; ++r) { p0[r] = fmaf(p0[r], LOG2E, mnL); p1[r] = fmaf(p1[r], LOG2E, mnL); }
#pragma unroll
    for (int r = 0; r < 16; ++r) p0[r] = __builtin_amdgcn_exp2f(p0[r]);
}
__device__ __forceinline__ void finishSM(f32x16& p0, f32x16& p1, float alpha, float& l_reg, h16x8& pa0, h16x8& pa1, h16x8& pa2, h16x8& pa3) {
#pragma unroll
    for (int r = 0; r < 16; ++r) p1[r] = __builtin_amdgcn_exp2f(p1[r]);
    l_reg = l_reg * alpha + rowsum32(p0, p1);
    pack_p(p0, p1, pa0, pa1, pa2, pa3);
}
__device__ __forceinline__ void run_attn2(const Ctx& c, const h16x8* qr, f32x16* o, SM& sm, const h16* Kp, const h16* Vp, int rs,
                                          int j_lo, int j_hi, int pos, unsigned W, unsigned long long rowmask, int qlo, int qhi) {
    const int NT = j_hi - j_lo;
    Stage S;
    f32x16 pA0, pA1, pB0, pB1; float alA, alB; h16x8 pa0, pa1, pa2, pa3;
#define KBASE(t) ((j_lo + (t)) * 64)
#define ROWON(t) (((rowmask >> (j_lo + (t))) & 1ull) != 0ull)
#define ACT(t) (__any(ROWON(t)) && KBASE(t) <= qhi && KBASE(t) + 63 >= qlo - (int)W + 1)
#define MASKT(P0_, P1_, t) do { const int kb_ = KBASE(t); const bool ron_ = ROWON(t); \
        if (ACT(t) && ((kb_ + 63 > qlo) || (kb_ <= qhi - (int)W) || !__all(ron_))) mask_tile(P0_, P1_, pos - kb_ - 4 * c.hi, W, ron_); } while (0)
#define RESC(a) do { if (__any((a) < 1.f)) { LAS float* al = c.wsc + 32; if (c.hi == 0) al[c.r32] = (a); asm volatile("s_waitcnt lgkmcnt(0)" ::: "memory"); \
        _Pragma("unroll") for (int d_ = 0; d_ < 4; ++d_) _Pragma("unroll") for (int r = 0; r < 16; ++r) o[d_][r] *= al[crow(r, c.hi)]; } } while (0)
    stage_load(S, c, Kp, Vp, rs, KBASE(0)); stage_write<0>(S, c);
    if (NT > 1) stage_load(S, c, Kp, Vp, rs, KBASE(1));
    __syncthreads();
    SBAR(); qkt_sk<0, false>(pA0, pA1, c, qr, ACT(0));
    MASKT(pA0, pA1, 0); partialSM(pA0, pA1, sm.m, alA);
    if (NT > 1) stage_write<1>(S, c);
    __syncthreads();
#define HALF_STEP(PX0, PX1, alX, PY0, PY1, alY, t, KB, VB, SB) do { \
        SBAR(); qkt_sk<KB, false>(PX0, PX1, c, qr, ACT(t)); \
        finishSM(PY0, PY1, alY, sm.l, pa0, pa1, pa2, pa3); SBAR(); \
        if ((t) + 1 < NT) { stage_load(S, c, Kp, Vp, rs, KBASE((t) + 1)); SBAR(); } \
        if (ACT((t) - 1)) pv_tile<VB>(o, c.vb0, pa0, pa1, pa2, pa3); \
        MASKT(PX0, PX1, (t)); partialSM(PX0, PX1, sm.m, alX); \
        __syncthreads(); \
        if ((t) + 1 < NT) { stage_write<SB>(S, c); } \
        RESC(alX); __syncthreads(); } while (0)
    for (int t = 1; t + 1 < NT; t += 2) {
        HALF_STEP(pB0, pB1, alB, pA0, pA1, alA, t, 1, 0, 0);
        HALF_STEP(pA0, pA1, alA, pB0, pB1, alB, t + 1, 0, 1, 1);
    }
    const bool even = (NT & 1) == 0;
    if (even) { SBAR(); qkt_sk<1, false>(pB0, pB1, c, qr, ACT(NT - 1)); SBAR(); }
    finishSM(pA0, pA1, alA, sm.l, pa0, pa1, pa2, pa3); SBAR();
    if (ACT(even ? NT - 2 : NT - 1)) pv_tile<0>(o, c.vb0, pa0, pa1, pa2, pa3);
    if (even) { MASKT(pB0, pB1, NT - 1); partialSM(pB0, pB1, sm.m, alB); RESC(alB);
        finishSM(pB0, pB1, alB, sm.l, pa0, pa1, pa2, pa3); SBAR(); if (ACT(NT - 1)) pv_tile<1>(o, c.vb0, pa0, pa1, pa2, pa3); }
    __syncthreads();
#undef HALF_STEP
#undef RESC
#undef MASKT
#undef ACT
#undef ROWON
#undef KBASE
}

__device__ __forceinline__ void qkt_rt(f32x16& p0, f32x16& p1, const Ctx& c, const h16x8* qr, int kbo  , float bias = 0.f) {
#pragma unroll
    for (int r = 0; r < 16; ++r) { p0[r] = bias; p1[r] = bias; }
    const LAS char* kb[4];
#pragma unroll
    for (int dd = 0; dd < 4; ++dd) kb[dd] = c.K_lds + kbo + KSWZ(c.r32, (dd * 16 + c.hi * 8) * 2);
#define KFRAG(d0, half) (*(const LAS h16x8*)(kb[(d0) & 3] + ((d0) >> 2) * 128 + (half) * 32 * 256))
#define QK4(A0, A1, A2, A3, g) do { p0 = __builtin_amdgcn_mfma_f32_32x32x16_f16(A0, qr[2 * (g)], p0, 0, 0, 0); p1 = __builtin_amdgcn_mfma_f32_32x32x16_f16(A1, qr[2 * (g)], p1, 0, 0, 0); \
        p0 = __builtin_amdgcn_mfma_f32_32x32x16_f16(A2, qr[2 * (g) + 1], p0, 0, 0, 0); p1 = __builtin_amdgcn_mfma_f32_32x32x16_f16(A3, qr[2 * (g) + 1], p1, 0, 0, 0); } while (0)
    h16x8 a0 = KFRAG(0, 0), a1 = KFRAG(0, 1), a2 = KFRAG(1, 0), a3 = KFRAG(1, 1);
    h16x8 b0 = KFRAG(2, 0), b1 = KFRAG(2, 1), b2 = KFRAG(3, 0), b3 = KFRAG(3, 1);
    SBAR(); QK4(a0, a1, a2, a3, 0); SBAR();
    a0 = KFRAG(4, 0); a1 = KFRAG(4, 1); a2 = KFRAG(5, 0); a3 = KFRAG(5, 1);
    SBAR(); QK4(b0, b1, b2, b3, 1); SBAR();
    b0 = KFRAG(6, 0); b1 = KFRAG(6, 1); b2 = KFRAG(7, 0); b3 = KFRAG(7, 1);
    SBAR(); QK4(a0, a1, a2, a3, 2); SBAR();
    QK4(b0, b1, b2, b3, 3);
#undef QK4
#undef KFRAG
}
__device__ __forceinline__ void stage_write_rt(const Stage& S, const Ctx& c, int kbo, int vbo) {
    *(LAS h16x8*)(c.V_lds + vbo + c.vst0) = S.v0; *(LAS h16x8*)(c.V_lds + vbo + c.vst1) = S.v1;
    *(LAS h16x8*)(c.K_lds + kbo + c.kws) = S.k0; *(LAS h16x8*)(c.K_lds + kbo + c.kws + 32 * 256) = S.k1;
}
template <bool LAG>
__device__ __forceinline__ void run_attn4_impl(const Ctx& c, const h16x8* qr, f32x16* o, SM& sm, const h16* Kp, const h16* Vp, int rs,
                                          int j_lo, int j_hi, int pos, unsigned W, unsigned long long rowmask, int qlo, int qhi) {
    const int NT = j_hi - j_lo;
    constexpr bool lag = LAG;
    Stage S;
    f32x16 p0, p1;
#define KBASE(t) ((j_lo + (t)) * 64)
#define ROWON(t) (((rowmask >> (j_lo + (t))) & 1ull) != 0ull)
#define ACT(t) (__any(ROWON(t)) && KBASE(t) <= qhi && KBASE(t) + 63 >= qlo - (int)W + 1)
#define QK_STEP(t, kbo_) do { if (ACT(t)) { qkt_rt(p0, p1, c, qr, (kbo_)); const int kb_ = KBASE(t); const bool ron_ = ROWON(t); \
            if ((kb_ + 63 > qlo) || (kb_ <= qhi - (int)W) || !__all(ron_)) mask_tile(p0, p1, pos - kb_ - 4 * c.hi, W, ron_); } } while (0)
#define SMPV_STEP(t, vbo_) do { if (ACT(t)) { \
        const float pmax = rowmax32(p0, p1); float mn, alpha; \
        if (__builtin_expect(__all((pmax - sm.m) <= THR), 1)) { mn = sm.m; alpha = 1.f; } \
        else { mn = fmaxf(sm.m, pmax); alpha = __builtin_amdgcn_exp2f((sm.m - mn) * LOG2E); sm.m = mn; } \
        const float mnL = -mn * LOG2E; \
        _Pragma("unroll") for (int r = 0; r < 16; ++r) { p0[r] = __builtin_amdgcn_exp2f(fmaf(p0[r], LOG2E, mnL)); p1[r] = __builtin_amdgcn_exp2f(fmaf(p1[r], LOG2E, mnL)); } \
        sm.l = sm.l * alpha + rowsum32(p0, p1); \
        h16x8 pa0, pa1, pa2, pa3; pack_p(p0, p1, pa0, pa1, pa2, pa3); \
        if (__any(alpha < 1.f)) { LAS float* al = c.wsc + 32; if (c.hi == 0) al[c.r32] = alpha; asm volatile("s_waitcnt lgkmcnt(0)" ::: "memory"); \
            _Pragma("unroll") for (int d_ = 0; d_ < 4; ++d_) _Pragma("unroll") for (int r = 0; r < 16; ++r) o[d_][r] *= al[crow(r, c.hi)]; } \
        SBAR(); pv_tile<0>(o, c.vb0 + (vbo_), pa0, pa1, pa2, pa3); } } while (0)
    stage_load(S, c, Kp, Vp, rs, KBASE(0)); stage_write_rt(S, c, 0, 0);
    __syncthreads();
    int kbo = 0, vbo = 0;
    for (int t = 0; t < NT; ++t) {
        const int kbn = kbo ^ SHM_K, vbn = (vbo == 2 * SHM_V) ? 0 : vbo + SHM_V, vbp = (vbo == 0) ? 2 * SHM_V : vbo - SHM_V;
        if (t + 1 < NT) stage_load(S, c, Kp, Vp, rs, KBASE(t + 1));
        if (!lag) { QK_STEP(t, kbo); SMPV_STEP(t, vbo); }
        else { if (t > 0) SMPV_STEP(t - 1, vbp); QK_STEP(t, kbo); }
        if (t + 1 < NT) stage_write_rt(S, c, kbn, vbn);
        __syncthreads();
        kbo = kbn; vbo = vbn;
    }
    if (lag) { const int vlast = (vbo == 0) ? 2 * SHM_V : vbo - SHM_V; SMPV_STEP(NT - 1, vlast); }
    __syncthreads();
#undef SMPV_STEP
#undef QK_STEP
#undef ACT
#undef ROWON
#undef KBASE
}
__device__ __forceinline__ void run_attn4(const Ctx& c, const h16x8* qr, f32x16* o, SM& sm, const h16* Kp, const h16* Vp, int rs,
                                          int j_lo, int j_hi, int pos, unsigned W, unsigned long long rowmask, int qlo, int qhi) {
    if (c.wid >= 4) run_attn4_impl<true>(c, qr, o, sm, Kp, Vp, rs, j_lo, j_hi, pos, W, rowmask, qlo, qhi);
    else run_attn4_impl<false>(c, qr, o, sm, Kp, Vp, rs, j_lo, j_hi, pos, W, rowmask, qlo, qhi);
}

#define ABAR() do { asm volatile("s_waitcnt lgkmcnt(0)" ::: "memory"); __builtin_amdgcn_s_barrier(); asm volatile("" ::: "memory"); } while (0)
__device__ __forceinline__ void run_attn5(const Ctx& c, const h16x8* qr, f32x16* o, SM& sm, const h16* Kp, const h16* Vp, int rs,
                                          int j_lo, int j_hi, int pos, unsigned W, unsigned long long rowmask, int qlo, int qhi) {
    const int NT = j_hi - j_lo;
    const bool lagw = (c.wid & 1) != 0;
    Stage S;
    f32x16 p0, p1;
#define KBASE(t) ((j_lo + (t)) * 64)
#define ROWON(t) (((rowmask >> (j_lo + (t))) & 1ull) != 0ull)
#define ACT(t) (__any(ROWON(t)) && KBASE(t) <= qhi && KBASE(t) + 63 >= qlo - (int)W + 1)
    stage_load(S, c, Kp, Vp, rs, KBASE(0)); stage_write_rt(S, c, 0, 0);
    if (NT > 1) { stage_load(S, c, Kp, Vp, rs, KBASE(1)); stage_write_rt(S, c, SHM_K, SHM_V); }
    __syncthreads();
    if (lagw) ABAR();
    int bo = 0;
    for (int t = 0; t < NT; ++t) {
        const int bo2 = (bo == 0) ? 2 * SHM_K : bo - SHM_K;
        const bool act = ACT(t);
        if (t + 2 < NT) stage_load(S, c, Kp, Vp, rs, KBASE(t + 2));
        float alpha = 1.f;
        if (act) { qkt_rt(p0, p1, c, qr, bo); const int kb_ = KBASE(t); const bool ron_ = ROWON(t);
            if ((kb_ + 63 > qlo) || (kb_ <= qhi - (int)W) || !__all(ron_)) mask_tile(p0, p1, pos - kb_ - 4 * c.hi, W, ron_);
            const float pmax = rowmax32(p0, p1); float mn;
            if (__builtin_expect(__all((pmax - sm.m) <= THR), 1)) { mn = sm.m; }
            else { mn = fmaxf(sm.m, pmax); alpha = __builtin_amdgcn_exp2f((sm.m - mn) * LOG2E); sm.m = mn; }
            const float mnL = -mn * LOG2E;
#pragma unroll
            for (int r = 0; r < 16; ++r) { p0[r] = __builtin_amdgcn_exp2f(fmaf(p0[r], LOG2E, mnL)); p1[r] = fmaf(p1[r], LOG2E, mnL); } }
        ABAR();
        if (act) {
#pragma unroll
            for (int r = 0; r < 16; ++r) p1[r] = __builtin_amdgcn_exp2f(p1[r]);
            sm.l = sm.l * alpha + rowsum32(p0, p1);
            h16x8 pa0, pa1, pa2, pa3; pack_p(p0, p1, pa0, pa1, pa2, pa3);
            if (__any(alpha < 1.f)) { LAS float* al = c.wsc + 32; if (c.hi == 0) al[c.r32] = alpha; asm volatile("s_waitcnt lgkmcnt(0)" ::: "memory");
#pragma unroll
                for (int d_ = 0; d_ < 4; ++d_)
#pragma unroll
                    for (int r = 0; r < 16; ++r) o[d_][r] *= al[crow(r, c.hi)]; }
            SBAR(); pv_tile<0>(o, c.vb0 + bo, pa0, pa1, pa2, pa3);
        }
        if (t + 2 < NT) stage_write_rt(S, c, bo2, bo2);
        ABAR();
        bo = (bo == 2 * SHM_K) ? 0 : bo + SHM_K;
    }
    if (!lagw) ABAR();
    __syncthreads();
#undef ACT
#undef ROWON
#undef KBASE
}

__device__ __forceinline__ void mask_tile2(f32x16& p0, f32x16& p1, int dq, unsigned W, bool rowon) {
    const float NEG = -__builtin_inff();
    const int dqe = rowon ? dq : -1;
    if (W >= (1u << 30)) {
#pragma unroll
        for (int r = 0; r < 16; ++r) { const int c = (r & 3) + 8 * (r >> 2); if (c > dqe) p0[r] = NEG; if (c + 32 > dqe) p1[r] = NEG; }
    } else {
#pragma unroll
        for (int r = 0; r < 16; ++r) { const int c = (r & 3) + 8 * (r >> 2); if ((unsigned)(dqe - c) >= W) p0[r] = NEG; if ((unsigned)(dqe - c - 32) >= W) p1[r] = NEG; }
    }
}
__device__ __forceinline__ void pv_rt(f32x16* o, int vb, h16x8 pa0, h16x8 pa1, h16x8 pa2, h16x8 pa3) {
#define TRRD(dst, off) asm volatile("ds_read_b64_tr_b16 %0, %1 offset:%2" : "=&v"(dst) : "v"(vb), "i"(off) : "memory")
#define MKB(l, h) __builtin_bit_cast(h16x8, (s16x8){l[0], l[1], l[2], l[3], h[0], h[1], h[2], h[3]})
#define RD8(L0, H0, L1, H1, L2, H2, L3, H3, d0) do { constexpr int b_ = v_rd_off(d0, 0, 0); \
        TRRD(L0, b_); TRRD(H0, b_ + 2048); TRRD(L1, b_ + 4096); TRRD(H1, b_ + 6144); TRRD(L2, b_ + 8192); TRRD(H2, b_ + 10240); TRRD(L3, b_ + 12288); TRRD(H3, b_ + 14336); } while (0)
#define MM4(L0, H0, L1, H1, L2, H2, L3, H3, d0) do { \
        o[d0] = __builtin_amdgcn_mfma_f32_32x32x16_f16(pa0, MKB(L0, H0), o[d0], 0, 0, 0); o[d0] = __builtin_amdgcn_mfma_f32_32x32x16_f16(pa1, MKB(L1, H1), o[d0], 0, 0, 0); \
        o[d0] = __builtin_amdgcn_mfma_f32_32x32x16_f16(pa2, MKB(L2, H2), o[d0], 0, 0, 0); o[d0] = __builtin_amdgcn_mfma_f32_32x32x16_f16(pa3, MKB(L3, H3), o[d0], 0, 0, 0); } while (0)
    s16x4 al0, ah0, al1, ah1, al2, ah2, al3, ah3, bl0, bh0, bl1, bh1, bl2, bh2, bl3, bh3;
    RD8(al0, ah0, al1, ah1, al2, ah2, al3, ah3, 0);
    RD8(bl0, bh0, bl1, bh1, bl2, bh2, bl3, bh3, 1);
    asm volatile("s_waitcnt lgkmcnt(8)" ::: "memory"); SBAR();
    MM4(al0, ah0, al1, ah1, al2, ah2, al3, ah3, 0); SBAR();
    RD8(al0, ah0, al1, ah1, al2, ah2, al3, ah3, 2);
    asm volatile("s_waitcnt lgkmcnt(8)" ::: "memory"); SBAR();
    MM4(bl0, bh0, bl1, bh1, bl2, bh2, bl3, bh3, 1); SBAR();
    RD8(bl0, bh0, bl1, bh1, bl2, bh2, bl3, bh3, 3);
    asm volatile("s_waitcnt lgkmcnt(8)" ::: "memory"); SBAR();
    MM4(al0, ah0, al1, ah1, al2, ah2, al3, ah3, 2); SBAR();
    asm volatile("s_waitcnt lgkmcnt(0)" ::: "memory"); SBAR();
    MM4(bl0, bh0, bl1, bh1, bl2, bh2, bl3, bh3, 3);
#undef MM4
#undef RD8
#undef MKB
#undef TRRD
}
__device__ __forceinline__ void run_attn6(const Ctx& c, const h16x8* qr, f32x16* o, SM& sm, const h16* Kp, const h16* Vp, int rs,
                                          int j_lo, int j_hi, int pos, unsigned W, unsigned long long rowmask, int qlo, int qhi) {
    const int NT = j_hi - j_lo;
    Stage S;
#define KBASE(t) ((j_lo + (t)) * 64)
#define ROWON(t) (((rowmask >> (j_lo + (t))) & 1ull) != 0ull)
#define ACT(t) (__any(ROWON(t)) && KBASE(t) <= qhi && KBASE(t) + 63 >= qlo - (int)W + 1)
    stage_load(S, c, Kp, Vp, rs, KBASE(0)); stage_write_rt(S, c, 0, 0);
    __syncthreads();
    int bo = 0;
    for (int t = 0; t < NT; ++t) {
        if (t + 1 < NT) stage_load(S, c, Kp, Vp, rs, KBASE(t + 1));
        if (ACT(t)) {
            const bool ron_ = ROWON(t);
            f32x16 p0, p1; qkt_rt(p0, p1, c, qr, bo, ron_ ? 0.f : -__builtin_inff());
            { const int kb_ = KBASE(t);
              if ((kb_ + 63 > qlo) || (kb_ <= qhi - (int)W)) mask_tile2(p0, p1, pos - kb_ - 4 * c.hi, W, ron_); }
            const float pmax = rowmax32(p0, p1); float mn, alpha;
            if (__builtin_expect(__all((pmax - sm.m) <= THR), 1)) { mn = sm.m; alpha = 1.f; }
            else { mn = fmaxf(sm.m, pmax); alpha = __builtin_amdgcn_exp2f((sm.m - mn) * LOG2E); sm.m = mn; }
            const float mnL = -mn * LOG2E;
#pragma unroll
            for (int r = 0; r < 16; ++r) { p0[r] = __builtin_amdgcn_exp2f(fmaf(p0[r], LOG2E, mnL)); p1[r] = __builtin_amdgcn_exp2f(fmaf(p1[r], LOG2E, mnL)); }
            sm.l = sm.l * alpha + rowsum32(p0, p1);
            h16x8 pa0, pa1, pa2, pa3; pack_p(p0, p1, pa0, pa1, pa2, pa3);
            if (__any(alpha < 1.f)) { LAS float* al = c.wsc + 32; if (c.hi == 0) al[c.r32] = alpha; asm volatile("s_waitcnt lgkmcnt(0)" ::: "memory");
#pragma unroll
                for (int d_ = 0; d_ < 4; ++d_)
#pragma unroll
                    for (int r = 0; r < 16; ++r) o[d_][r] *= al[crow(r, c.hi)]; }
            SBAR(); pv_rt(o, c.vb0 + bo, pa0, pa1, pa2, pa3);
        }
        if (t + 1 < NT) stage_write_rt(S, c, bo ^ SHM_K, bo ^ SHM_V);
        __syncthreads();
        bo ^= SHM_K;
    }
#undef ACT
#undef ROWON
#undef KBASE
}


struct DmaOff { unsigned k0, k1, v0, v1; };
__device__ __forceinline__ DmaOff dma_offsets(const Ctx& c, int rs) {
    DmaOff d;
#pragma unroll
    for (int i = 0; i < 2; ++i) { const int o = (2 * c.wid + i) * 1024 + 16 * c.lane;
        const int row = o >> 8, phys = (o & 255) >> 4, logical = phys ^ (row & 7);
        const unsigned ko = (unsigned)(row * rs + logical * 8);
        const int st = o >> 9, kh = st >> 2, cq = st & 3, kk = kh * 8 + ((o & 511) >> 6), c8 = ((o & 63) >> 4) * 8;
        const int k = (kk & ~0xC) | ((kk & 4) << 1) | ((kk & 8) >> 1);
        const unsigned vo = (unsigned)(k * rs + cq * 32 + c8);
        if (i == 0) { d.k0 = ko; d.v0 = vo; } else { d.k1 = ko; d.v1 = vo; } }
    return d;
}
__device__ __forceinline__ void stage_dma(const Ctx& c, const DmaOff& d, const h16* Kp, const h16* Vp, int rs, int key0, int slot) {
    const h16* kb = Kp + (size_t)key0 * rs; const h16* vb = Vp + (size_t)key0 * rs;
    LAS char* kd = (LAS char*)c.K_lds + slot + c.wid * 2048; LAS char* vd = (LAS char*)c.V_lds + slot + c.wid * 2048;
    __builtin_amdgcn_global_load_lds((const unsigned*)(kb + d.k0), (LAS unsigned*)(kd), 16, 0, 0);
    __builtin_amdgcn_global_load_lds((const unsigned*)(kb + d.k1), (LAS unsigned*)(kd + 1024), 16, 0, 0);
    __builtin_amdgcn_global_load_lds((const unsigned*)(vb + d.v0), (LAS unsigned*)(vd), 16, 0, 0);
    __builtin_amdgcn_global_load_lds((const unsigned*)(vb + d.v1), (LAS unsigned*)(vd + 1024), 16, 0, 0);
}
typedef short v4i16_t __attribute__((ext_vector_type(4)));
__device__ __forceinline__ s16x4 vtr(const LAS char* p) { return __builtin_bit_cast(s16x4, __builtin_amdgcn_ds_read_tr16_b64_v4i16((LAS v4i16_t*)p)); }
__device__ __forceinline__ void run_attn9(const Ctx& c, const h16x8* qr, f32x16* o, SM& sm, const h16* Kp, const h16* Vp, int rs,
                                          int j_lo, int j_hi, int pos, unsigned W, unsigned long long rowmask, int qlo, int qhi) {
    const int NT = j_hi - j_lo;
    const DmaOff dmo = dma_offsets(c, rs);
    f32x16 X0, X1;
    u32x4 pwA0, pwA1, pwA2, pwA3, pwB0, pwB1, pwB2, pwB3;
    float l_reg = 0.f, m_reg = -1e30f;
#define KBASE(t) ((j_lo + (t)) * 64)
#define ROWON(t) (((rowmask >> (j_lo + (t))) & 1ull) != 0ull)
    const LAS char* kq[4];
#pragma unroll
    for (int dd = 0; dd < 4; ++dd) kq[dd] = c.K_lds + KSWZ(c.r32, (dd * 16 + c.hi * 8) * 2);
    const LAS char* vq = c.V_lds + v_rd_base(c.lane);
#define KFR(kbo, i) (*(const LAS h16x8*)(kq[((i) >> 1) & 3] + (kbo) + ((i) >> 3) * 128 + ((i) & 1) * 32 * 256))
#define VLO(vbo, j) vtr(vq + (vbo) + v_rd_off((j) >> 2, (j) & 3, 0))
#define VHI(vbo, j) vtr(vq + (vbo) + v_rd_off((j) >> 2, (j) & 3, 1))
#define MKB(l, h) __builtin_bit_cast(h16x8, (s16x8){l[0], l[1], l[2], l[3], h[0], h[1], h[2], h[3]})
    const f32x16 zero16 = {};
#define GA(i, kbo) do { \
        if ((i) & 1) X1 = __builtin_amdgcn_mfma_f32_32x32x16_f16(kf[(i) & 3], qr[(i) >> 1], (i) == 1 ? zero16 : X1, 0, 0, 0); \
        else X0 = __builtin_amdgcn_mfma_f32_32x32x16_f16(kf[(i) & 3], qr[(i) >> 1], (i) == 0 ? zero16 : X0, 0, 0, 0); \
        if ((i) + 4 < 16) kf[(i) & 3] = KFR(kbo, (i) + 4); \
        SBAR(); } while (0)
#define GB(j, HP, vbo, mnL_, PP0, PP1, PP2, PP3, PN0, PN1, PN2, PN3) do { \
        if (HP) { const u32x4 pwj_ = ((j) & 3) == 0 ? PP0 : ((j) & 3) == 1 ? PP1 : ((j) & 3) == 2 ? PP2 : PP3; \
            o[(j) >> 2] = __builtin_amdgcn_mfma_f32_32x32x16_f16(__builtin_bit_cast(h16x8, pwj_), MKB(vl[(j) & 3], vh[(j) & 3]), o[(j) >> 2], 0, 0, 0); \
            if ((j) + 4 < 16) { vl[(j) & 3] = VLO(vbo, (j) + 4); vh[(j) & 3] = VHI(vbo, (j) + 4); } } \
        { const float e0_ = __builtin_amdgcn_exp2f(fmaf((j) < 8 ? X0[(2 * (j)) & 15] : X1[(2 * (j)) & 15], LOG2E, mnL_)); \
          const float e1_ = __builtin_amdgcn_exp2f(fmaf((j) < 8 ? X0[(2 * (j) + 1) & 15] : X1[(2 * (j) + 1) & 15], LOG2E, mnL_)); \
          sacc += e0_; sacc += e1_; const unsigned cv_ = pk2h(e0_, e1_); \
          constexpr int jj_ = (j) >> 2, sub_ = (j) & 3; \
          if (sub_ == 0) ca0 = cv_; else if (sub_ == 1) ca1 = cv_; else if (sub_ == 2) cb0 = cv_; else { \
              auto r0_ = __builtin_amdgcn_permlane32_swap(ca0, cb0, false, false); auto r1_ = __builtin_amdgcn_permlane32_swap(ca1, cv_, false, false); \
              const u32x4 w_ = {r0_[0], r1_[0], r0_[1], r1_[1]}; if (jj_ == 0) PN0 = w_; else if (jj_ == 1) PN1 = w_; else if (jj_ == 2) PN2 = w_; else PN3 = w_; } } \
        SBAR(); } while (0)
#define STEP(t, HP, PP0, PP1, PP2, PP3, PN0, PN1, PN2, PN3) do { \
        const int kbo_ = bo, vbo_ = bop; \
        if ((t) + 1 < NT) stage_dma(c, dmo, Kp, Vp, rs, KBASE((t) + 1), bon); \
        h16x8 kf[4]; kf[0] = KFR(kbo_, 0); kf[1] = KFR(kbo_, 1); kf[2] = KFR(kbo_, 2); kf[3] = KFR(kbo_, 3); \
        SBAR(); \
        GA(0, kbo_); GA(1, kbo_); GA(2, kbo_); GA(3, kbo_); GA(4, kbo_); GA(5, kbo_); GA(6, kbo_); GA(7, kbo_); \
        GA(8, kbo_); GA(9, kbo_); GA(10, kbo_); GA(11, kbo_); GA(12, kbo_); GA(13, kbo_); GA(14, kbo_); GA(15, kbo_); \
        s16x4 vl[4], vh[4]; \
        if (HP) { vl[0] = VLO(vbo_, 0); vh[0] = VHI(vbo_, 0); vl[1] = VLO(vbo_, 1); vh[1] = VHI(vbo_, 1); vl[2] = VLO(vbo_, 2); vh[2] = VHI(vbo_, 2); vl[3] = VLO(vbo_, 3); vh[3] = VHI(vbo_, 3); } \
        const bool ron_ = ROWON(t); \
        { const int kb_ = KBASE(t); if ((kb_ + 63 > qlo) || (kb_ <= qhi - (int)W)) mask_tile2(X0, X1, pos - kb_ - 4 * c.hi, W, true); } \
        const float pmax_ = ron_ ? rowmax32(X0, X1) : -__builtin_inff(); float mn_, alpha; \
        if (__builtin_expect(__all((pmax_ - m_reg) <= THR), 1)) { mn_ = m_reg; alpha = 1.f; } \
        else { mn_ = fmaxf(m_reg, pmax_); alpha = __builtin_amdgcn_exp2f((m_reg - mn_) * LOG2E); m_reg = mn_; } \
        const float mnL_ = ron_ ? -mn_ * LOG2E : -__builtin_inff(); \
        float sacc = 0.f; unsigned ca0 = 0u, ca1 = 0u, cb0 = 0u; \
        SBAR(); \
        GB(0, HP, vbo_, mnL_, PP0, PP1, PP2, PP3, PN0, PN1, PN2, PN3); GB(1, HP, vbo_, mnL_, PP0, PP1, PP2, PP3, PN0, PN1, PN2, PN3); \
        GB(2, HP, vbo_, mnL_, PP0, PP1, PP2, PP3, PN0, PN1, PN2, PN3); GB(3, HP, vbo_, mnL_, PP0, PP1, PP2, PP3, PN0, PN1, PN2, PN3); \
        GB(4, HP, vbo_, mnL_, PP0, PP1, PP2, PP3, PN0, PN1, PN2, PN3); GB(5, HP, vbo_, mnL_, PP0, PP1, PP2, PP3, PN0, PN1, PN2, PN3); \
        GB(6, HP, vbo_, mnL_, PP0, PP1, PP2, PP3, PN0, PN1, PN2, PN3); GB(7, HP, vbo_, mnL_, PP0, PP1, PP2, PP3, PN0, PN1, PN2, PN3); \
        GB(8, HP, vbo_, mnL_, PP0, PP1, PP2, PP3, PN0, PN1, PN2, PN3); GB(9, HP, vbo_, mnL_, PP0, PP1, PP2, PP3, PN0, PN1, PN2, PN3); \
        GB(10, HP, vbo_, mnL_, PP0, PP1, PP2, PP3, PN0, PN1, PN2, PN3); GB(11, HP, vbo_, mnL_, PP0, PP1, PP2, PP3, PN0, PN1, PN2, PN3); \
        GB(12, HP, vbo_, mnL_, PP0, PP1, PP2, PP3, PN0, PN1, PN2, PN3); GB(13, HP, vbo_, mnL_, PP0, PP1, PP2, PP3, PN0, PN1, PN2, PN3); \
        GB(14, HP, vbo_, mnL_, PP0, PP1, PP2, PP3, PN0, PN1, PN2, PN3); GB(15, HP, vbo_, mnL_, PP0, PP1, PP2, PP3, PN0, PN1, PN2, PN3); \
        { auto rr_ = __builtin_amdgcn_permlane32_swap(__float_as_uint(sacc), __float_as_uint(sacc), false, false); l_reg = l_reg * alpha + (__uint_as_float(rr_[0]) + __uint_as_float(rr_[1])); } \
        if (__any(alpha < 1.f)) { LAS float* al = c.wsc + 32; if (c.hi == 0) al[c.r32] = alpha; asm volatile("s_waitcnt lgkmcnt(0)" ::: "memory"); \
            _Pragma("unroll") for (int d_ = 0; d_ < 4; ++d_) _Pragma("unroll") for (int r = 0; r < 16; ++r) o[d_][r] *= al[crow(r, c.hi)]; } \
        asm volatile("s_waitcnt vmcnt(0)" ::: "memory"); __syncthreads(); \
        bop = bo; bo = bon; bon = (bon == 2 * SHM_K) ? 0 : bon + SHM_K; } while (0)
    __syncthreads();
    stage_dma(c, dmo, Kp, Vp, rs, KBASE(0), 0);
    asm volatile("s_waitcnt vmcnt(0)" ::: "memory"); __syncthreads();
    int bo = 0, bop = 0, bon = SHM_K;
    STEP(0, 0, pwB0, pwB1, pwB2, pwB3, pwA0, pwA1, pwA2, pwA3);
    int t = 1;
    for (; t + 1 < NT; t += 2) { STEP(t, 1, pwA0, pwA1, pwA2, pwA3, pwB0, pwB1, pwB2, pwB3); STEP(t + 1, 1, pwB0, pwB1, pwB2, pwB3, pwA0, pwA1, pwA2, pwA3); }
    if (t < NT) { STEP(t, 1, pwA0, pwA1, pwA2, pwA3, pwB0, pwB1, pwB2, pwB3);
        SBAR(); pv_rt(o, c.vb0 + bop, __builtin_bit_cast(h16x8, pwB0), __builtin_bit_cast(h16x8, pwB1), __builtin_bit_cast(h16x8, pwB2), __builtin_bit_cast(h16x8, pwB3)); }
    else { SBAR(); pv_rt(o, c.vb0 + bop, __builtin_bit_cast(h16x8, pwA0), __builtin_bit_cast(h16x8, pwA1), __builtin_bit_cast(h16x8, pwA2), __builtin_bit_cast(h16x8, pwA3)); }
    sm.m = m_reg; sm.l = l_reg;
    __syncthreads();
#undef STEP
#undef GB
#undef GA
#undef MKB
#undef VHI
#undef VLO
#undef KFR
#undef ROWON
#undef KBASE
}
__device__ __forceinline__ void finish(const Ctx& c, f32x16* o, SM& sm, float gate) {
    LAS float* li = c.wsc;
    const float s = sm.l > 0.f ? gate / sm.l : 0.f;
    if (c.hi == 0) li[c.r32] = s;
    asm volatile("s_waitcnt lgkmcnt(0)" ::: "memory");
#pragma unroll
    for (int r = 0; r < 16; ++r) { const float sr_ = li[crow(r, c.hi)];
#pragma unroll
        for (int d0 = 0; d0 < 4; ++d0) o[d0][r] *= sr_; }
    asm volatile("s_waitcnt lgkmcnt(0)" ::: "memory");
    sm.m = -1e30f; sm.l = 0.f;
}
__device__ __forceinline__ void store_o(const Ctx& c, f32x16* o, h16* Ow  , int ldo, bool acc) {
    LAS h16* stg = (LAS h16*)(c.lds + c.wid * 8192);
#pragma unroll
    for (int r = 0; r < 16; ++r) { const int orow = crow(r, c.hi);
#pragma unroll
        for (int d0 = 0; d0 < 4; ++d0) { stg[orow * 128 + d0 * 32 + c.r32] = (h16)o[d0][r]; o[d0][r] = 0.f; } }
    asm volatile("s_waitcnt lgkmcnt(0)" ::: "memory");
    const int rq = c.lane >> 4, ch = c.lane & 15;
    u32x4 own[8];
#pragma unroll
    for (int it = 0; it < 8; ++it) own[it] = *(const LAS u32x4*)(stg + (it * 4 + rq) * 128 + ch * 8);
    if (acc) {
        u32x4 old[8];
        const h16* p0 = Ow + (size_t)rq * ldo + ch * 8;
#define LD16(k) "global_load_dwordx4 %" #k ", %8, off sc1\n\t"
        const h16* a0 = p0, * a1 = p0 + (size_t)4 * ldo, * a2 = p0 + (size_t)8 * ldo, * a3 = p0 + (size_t)12 * ldo, * a4 = p0 + (size_t)16 * ldo, * a5 = p0 + (size_t)20 * ldo, * a6 = p0 + (size_t)24 * ldo, * a7 = p0 + (size_t)28 * ldo;
        asm volatile("global_load_dwordx4 %0, %8, off sc1\n\tglobal_load_dwordx4 %1, %9, off sc1\n\tglobal_load_dwordx4 %2, %10, off sc1\n\tglobal_load_dwordx4 %3, %11, off sc1\n\t"
                     "global_load_dwordx4 %4, %12, off sc1\n\tglobal_load_dwordx4 %5, %13, off sc1\n\tglobal_load_dwordx4 %6, %14, off sc1\n\tglobal_load_dwordx4 %7, %15, off sc1\n\ts_waitcnt vmcnt(0)"
                     : "=&v"(old[0]), "=&v"(old[1]), "=&v"(old[2]), "=&v"(old[3]), "=&v"(old[4]), "=&v"(old[5]), "=&v"(old[6]), "=&v"(old[7])
                     : "v"(a0), "v"(a1), "v"(a2), "v"(a3), "v"(a4), "v"(a5), "v"(a6), "v"(a7) : "memory");
#undef LD16
#pragma unroll
        for (int it = 0; it < 8; ++it) {
#pragma unroll
            for (int e = 0; e < 4; ++e) { const unsigned wa = own[it][e], wb = old[it][e]; const h16x2 ha = __builtin_bit_cast(h16x2, wa), hb = __builtin_bit_cast(h16x2, wb);
                own[it][e] = pk2h((float)ha.x + (float)hb.x, (float)ha.y + (float)hb.y); } }
    }
#pragma unroll
    for (int it = 0; it < 8; ++it) *(u32x4*)(Ow + (size_t)(it * 4 + rq) * ldo + ch * 8) = own[it];
}

template <bool WIN_FIRST = false>
__device__ __forceinline__ void nsa_prepare(const Args& A, const Ctx& c, int b, int g, int ci, h16x8* qr, f32x16* o, unsigned long long& rowmask, h16* O) {
    const h16* QKV = (const h16*)(A.ws + WS_QKV); const float* G = (const float*)(A.ws + WS_GATE);
    const h16* KC = (const h16*)(A.ws + WS_KC) + ((size_t)((0 * 2 + b) * 2 + g) * 256) * 128;
    const h16* VC = (const h16*)(A.ws + WS_KC) + ((size_t)((1 * 2 + b) * 2 + g) * 256) * 128;
    const int hh = c.wid >> 1, head = g * 4 + hh, sub = (c.wid & 1) * 32, t0 = 64 * ci;
    const int qidx = sub + c.r32, t = t0 + qidx; const size_t tokrow = (size_t)(b * SEQ + t);
    if (!WIN_FIRST) {
#pragma unroll
    for (int d0 = 0; d0 < 8; ++d0) qr[d0] = *(const h16x8*)(QKV + tokrow * NQKV + C_QN + head * 128 + d0 * 16 + c.hi * 8); }
    const float g0 = G[tokrow * 24 + head * 3];
    LAS float* impH = (LAS float*)((hh < 2 ? c.K_lds : c.V_lds) + SHM_K * (1 + (hh & 1)));
#define IMPP(s_) impH[qidx * 64 + (((s_) + 2 * qidx) & 63)]
    LAS float* rlH = (LAS float*)(c.lds + L_IMP);
    LAS unsigned long long* selm = (LAS unsigned long long*)(c.lds + L_SEL);
    h16* Ow = O + (size_t)(b * SEQ + t0 + sub) * DM + head * 128;
    __syncthreads();
    { LAS f32x4* z = (LAS f32x4*)(impH + qidx * 64 + 32 * c.hi);
#pragma unroll
      for (int e = 0; e < 8; ++e) z[e] = (f32x4){0.f, 0.f, 0.f, 0.f}; }
    const int posc = (t - 31) >> 4;
    const int ntc = ((4 * ci + 2) >> 6) + 1;
    const unsigned WC = 1u << 30;
    float m = -1e30f, l = 0.f;
    Stage S; stage_load(S, c, KC, VC, 128, 0);
    for (int j = 0; j < ntc; ++j) {
        __syncthreads();
        stage_write<0>(S, c); __syncthreads();
        if (j + 1 < ntc) stage_load(S, c, KC, VC, 128, 64 * (j + 1));
        f32x16 p0, p1; qkt<0, false>(p0, p1, c, qr);
        mask_tile2(p0, p1, posc - 64 * j - 4 * c.hi, WC, true);
        const float pmax = rowmax32(p0, p1); const float mn = fmaxf(m, pmax); const float alpha = __builtin_amdgcn_exp2f((m - mn) * LOG2E); m = mn;
        if (__any(alpha < 1.f)) {
            LAS float* al = c.wsc + 32; if (c.hi == 0) al[c.r32] = alpha; asm volatile("s_waitcnt lgkmcnt(0)" ::: "memory");
#pragma unroll
            for (int d_ = 0; d_ < 4; ++d_)
#pragma unroll
                for (int r = 0; r < 16; ++r) o[d_][r] *= al[crow(r, c.hi)];
            for (int k = 0; k < 8 * j + 1; ++k) IMPP(2 * k + c.hi) *= alpha; }
        const float mL = -mn * LOG2E;
#pragma unroll
        for (int r = 0; r < 16; ++r) { p0[r] = __builtin_amdgcn_exp2f(fmaf(p0[r], LOG2E, mL)); p1[r] = __builtin_amdgcn_exp2f(fmaf(p1[r], LOG2E, mL)); }
        l = l * alpha + rowsum32(p0, p1);
        {
            const int sb = 16 * j + c.hi;
#pragma unroll
            for (int gq = 0; gq < 4; ++gq) { IMPP(sb + 2 * gq) += p0[4 * gq] + p0[4 * gq + 1] + p0[4 * gq + 2] + 0.5f * p0[4 * gq + 3];
                IMPP(sb + 8 + 2 * gq) += p1[4 * gq] + p1[4 * gq + 1] + p1[4 * gq + 2] + 0.5f * p1[4 * gq + 3]; }
            asm volatile("s_waitcnt lgkmcnt(0)" ::: "memory");
#pragma unroll
            for (int gq = 0; gq < 4; ++gq) { IMPP(sb + 2 * gq + 1) += 0.5f * p0[4 * gq + 3];
                if (sb + 8 + 2 * gq + 1 < 64) IMPP(sb + 8 + 2 * gq + 1) += 0.5f * p1[4 * gq + 3]; }
        }
        h16x8 pa0, pa1, pa2, pa3; pack_p(p0, p1, pa0, pa1, pa2, pa3);
        SBAR();
        pv_tile<0>(o, c.vb0, pa0, pa1, pa2, pa3);
    }
    {
        LAS float* li = c.wsc; const float rli = l > 0.f ? 1.f / l : 0.f;
        if (c.hi == 0) { li[c.r32] = rli * g0; rlH[hh * 64 + qidx] = rli; }
        asm volatile("s_waitcnt lgkmcnt(0)" ::: "memory");
#pragma unroll
        for (int r = 0; r < 16; ++r) { const float sr_ = li[crow(r, c.hi)];
#pragma unroll
            for (int d0 = 0; d0 < 4; ++d0) o[d0][r] *= sr_; }
    }
    __syncthreads();
    {
        const int s = c.lane;
        const LAS float* i0 = (const LAS float*)(c.K_lds + SHM_K), * i1 = (const LAS float*)(c.K_lds + 2 * SHM_K), * i2 = (const LAS float*)(c.V_lds + SHM_V), * i3 = (const LAS float*)(c.V_lds + 2 * SHM_V);
        for (int qq = 0; qq < 8; ++qq) { const int q = c.wid * 8 + qq; const int ps = q * 64 + ((s + 2 * q) & 63);
            const float my = ((i0[ps] * rlH[q] + i1[ps] * rlH[64 + q]) + i2[ps] * rlH[128 + q]) + i3[ps] * rlH[192 + q];
            const bool valid = (s >= 1 && s <= ci - 2);
            bool pick = valid;
            if (ci - 2 > 13) {
                const unsigned key = valid ? __float_as_uint(my) + 1u : 0u; unsigned T = 0u;
                for (int bit = 31; bit >= 0; --bit) { const unsigned trial = T | (1u << bit); if (__popcll(__ballot(key >= trial)) >= 13) T = trial; }
                const unsigned long long gt = __ballot(key > T), eq = __ballot(key == T);
                const int need = 13 - __popcll(gt); const int rk = __popcll(eq & ((1ull << s) - 1ull));
                pick = (key > T) || (key == T && rk < need);
            }
            const bool sel = (s == 0) || (s == ci) || (s == ci - 1) || pick;
            const unsigned long long bm = __ballot(sel && s <= ci);
            if (c.lane == 0) selm[q] = bm; }
        __syncthreads();
    }
    rowmask = selm[qidx];
#undef IMPP
    store_o(c, o, Ow, DM, WIN_FIRST);
}
__device__ __forceinline__ void moba_prepare(const Args& A, const Ctx& c, int b, int h, int cj, h16x8* qr, unsigned long long& rowmask) {
    const h16* QKV = (const h16*)(A.ws + WS_QKV);
    const h16* KMT = (const h16*)(A.ws + WS_KMEAN) + (size_t)(b * 8 + h) * 32 * 128;
    const int wq0 = 256 * cj + 32 * c.wid, t = wq0 + c.r32; const size_t tokrow = (size_t)(b * SEQ + t);
#pragma unroll
    for (int d0 = 0; d0 < 8; ++d0) qr[d0] = *(const h16x8*)(QKV + tokrow * NQKV + C_QM + h * 128 + d0 * 16 + c.hi * 8);
    rowmask = 0xFull << (4 * cj);
    if (cj > 0) {
        __syncthreads();
        { const h16x8 kk = *(const h16x8*)(KMT + (size_t)c.sr * 128 + c.sc); *(LAS h16x8*)(c.K_lds + c.kws) = kk; }
        __syncthreads();
        f32x16 p0, p1; qkt<0, true>(p0, p1, c, qr);
        float S[16];
#pragma unroll
        for (int r = 0; r < 8; ++r) { auto rr = __builtin_amdgcn_permlane32_swap(__float_as_uint(p0[r]), __float_as_uint(p0[r]), false, false);
            const int n = (r & 3) + 8 * (r >> 2); S[n] = __uint_as_float(rr[0]); S[n + 4] = __uint_as_float(rr[1]); }
#pragma unroll
        for (int n = 0; n < 16; ++n) S[n] = (n < cj) ? S[n] : -__builtin_inff();
#pragma unroll
        for (int n = 0; n < 16; ++n) { int cnt = 0;
#pragma unroll
            for (int mm = 0; mm < 16; ++mm) { if (mm < n) cnt += (S[mm] >= S[n]) ? 1 : 0; else if (mm > n) cnt += (S[mm] > S[n]) ? 1 : 0; }
            const unsigned long long bits = (n < cj && cnt < 3) ? (0xFull << (4 * n)) : 0ull; rowmask |= bits; }
        __syncthreads();
    }
}
#undef SBAR
}


#if DIAG
constexpr int CW_DIAG = 96;
#ifndef DIAG_FIELD
#define DIAG_FIELD 4
#endif
__device__ __forceinline__ void diag_max(unsigned* ctl, float v, int lane, unsigned payload = 0u) { if (lane == 0 && fabsf(v) > 2.0f) atomicAdd(ctl + CW_DIAG + 4, 1u); if (lane == 0) atomicMax((unsigned long long*)(ctl + CW_DIAG), ((unsigned long long)__float_as_uint(fabsf(v)) << 32) | payload); }
__device__ __forceinline__ float diag_dot_h(const h16* a, const float* W, int ldw, int col, int K, int lane) {
    float s = 0.f; for (int k = lane; k < K; k += 64) s += (float)a[k] * W[(size_t)k * ldw + col]; return wave_sum(s); }
__device__ __forceinline__ unsigned diag_hash(unsigned x) { x ^= x >> 16; x *= 0x7feb352du; x ^= x >> 15; x *= 0x846ca68bu; x ^= x >> 16; return x; }
__device__ __forceinline__ void diag_qkv(const Args& A, unsigned* ctl, int gw, int NGW, int lane) {
    const h16* H = (const h16*)(A.ws + WS_H); const h16* QKV = (const h16*)(A.ws + WS_QKV); const float* G = (const float*)(A.ws + WS_GATE);
    const float* COS = (const float*)(A.ws + WS_COS); const float* SIN = (const float*)(A.ws + WS_SIN); const float* W = A.in[6];
    for (int sidx = gw; sidx < 8192; sidx += NGW) {
        const unsigned hsh = diag_hash(sidx * 2 + 1); const int row = hsh % M; const int cs = (hsh >> 13) % INCOLS; const int t = row & (SEQ - 1);
        const h16* hr = H + (size_t)row * DM;
        if (cs >= 2560 && cs < 2584) { const float raw = diag_dot_h(hr, W, INCOLS, cs, DM, lane); diag_max(ctl, G[(size_t)row * 24 + cs - 2560] - 1.f / (1.f + expf(-raw)), lane); continue; }
        const int n = cs < 2560 ? cs : cs - 24; const int pn = n >> 8; const int add = cs < 2560 ? 0 : 24;
        const float got = (float)QKV[(size_t)row * NQKV + n];
        float want;
        if (pg8::is_rope_tile(pn)) { const int d = n & 127, hb = n & ~127; const float rd = diag_dot_h(hr, W, INCOLS, cs, DM, lane), rp = diag_dot_h(hr, W, INCOLS, hb + (d ^ 64) + add, DM, lane);
            const int i = d & 63; const float c = COS[t * 64 + i], s_ = SIN[t * 64 + i];
            want = d < 64 ? rd * c - rp * s_ : rd * c + rp * s_; if (pg8::is_q_tile(pn)) want *= QSCALE; }
        else want = diag_dot_h(hr, W, INCOLS, cs, DM, lane);
        diag_max(ctl, got - want, lane);
    }
}
__device__ __forceinline__ void diag_kc(const Args& A, unsigned* ctl, int gw, int NGW, int lane) {
    const h16* QKV = (const h16*)(A.ws + WS_QKV); const h16* KC = (const h16*)(A.ws + WS_KC);
    for (int sidx = gw; sidx < 256; sidx += NGW) {
        const unsigned hsh = diag_hash(sidx * 2 + 77); const int kv = hsh & 1, b = (hsh >> 1) & 1, g = (hsh >> 2) & 1, n = (hsh >> 3) % 255, c = (hsh >> 12) & 127;
        const float* pos = A.in[kv ? 10 : 7]; const float* w1 = A.in[kv ? 11 : 8]; const float* w2 = A.in[kv ? 12 : 9];
        const int colbase = (kv ? C_VCMP : C_KCMP) + g * 128;
        float h0 = 0.f, h1 = 0.f;
        for (int k = 0; k < 4096; ++k) { const int l = k >> 7, d = k & 127; const float a = (float)QKV[(size_t)(b * SEQ + 16 * n + l) * NQKV + colbase + d] + pos[k];
            h0 += a * w1[(size_t)k * 128 + lane]; h1 += a * w1[(size_t)k * 128 + 64 + lane]; }
        h0 = h0 / (1.f + expf(-h0)); h1 = h1 / (1.f + expf(-h1));
        const float want = wave_sum(h0 * w2[lane * 128 + c] + h1 * w2[(64 + lane) * 128 + c]);
        const float got = (float)KC[((size_t)((kv * 2 + b) * 2 + g) * 256 + n) * 128 + c];
        diag_max(ctl, (got - want) * 2.f, lane);
    }
}
template <int MODE  >
__device__ __forceinline__ void diag_gemm(unsigned* ctl, const h16* Abuf, int K, const float* W, int N, const void* Cbuf, float scale, int gw, int NGW, int lane, unsigned salt) {
    for (int sidx = gw; sidx < 8192; sidx += NGW) {
        const unsigned hsh = diag_hash(sidx * 2 + salt); const int row = hsh % M; const int col = (hsh >> 13) % N;
        float want = diag_dot_h(Abuf + (size_t)row * K, W, N, col, K, lane); float got;
        if (MODE == 1) { want = fmaxf(want, 0.f); want *= want; got = (float)((const h16*)Cbuf)[(size_t)row * N + col]; } else got = ((const float*)Cbuf)[(size_t)row * N + col];
        diag_max(ctl, (got - want) * scale, lane);
    }
}

#ifndef DIAG_TMAX
#define DIAG_TMAX 4096
#endif
#ifndef DIAG_TMIN
#define DIAG_TMIN 0
#endif

__device__ __forceinline__ void diag_kmean(const Args& A, unsigned* ctl, int gw, int NGW, int lane) {
    const h16* QKV = (const h16*)(A.ws + WS_QKV); const h16* KM = (const h16*)(A.ws + WS_KMEAN);
    for (int sidx = gw; sidx < 256; sidx += NGW) {
        const int b = sidx >> 7, h = (sidx >> 4) & 7, nb = sidx & 15;
        const h16* Kh = QKV + (size_t)(b * SEQ) * NQKV + C_KM + h * 128;
        float m0 = 0.f, m1 = 0.f; for (int j = 0; j < 256; ++j) { const h16* kr = Kh + (size_t)(nb * 256 + j) * NQKV; m0 += (float)kr[lane]; m1 += (float)kr[64 + lane]; }
        const h16* kp = KM + ((size_t)(b * 8 + h) * 32 + nb) * 128;
        float d = fmaxf(fabsf((float)kp[lane] - m0 * (1.f / 256.f)), fabsf((float)kp[64 + lane] - m1 * (1.f / 256.f)));
#pragma unroll
        for (int o_ = 1; o_ < 64; o_ <<= 1) d = fmaxf(d, __shfl_xor(d, o_));
        diag_max(ctl, d * 100.f, lane, ((unsigned)nb << 8) | (b << 7) | (h << 4));
    }
}
struct OnlineSM { float m, Z, a0, a1; };
__device__ __forceinline__ void osm_key(OnlineSM& st, float qa, float qb, const h16* Krow, const h16* Vrow, int lane) {
    const float sc = wave_sum(qa * (float)Krow[lane] + qb * (float)Krow[64 + lane]);
    const float mn = fmaxf(st.m, sc), corr = expf(st.m - mn), w = expf(sc - mn);
    st.Z = st.Z * corr + w; st.a0 = st.a0 * corr + w * (float)Vrow[lane]; st.a1 = st.a1 * corr + w * (float)Vrow[64 + lane]; st.m = mn;
}
__device__ __forceinline__ void diag_nsa(const Args& A, unsigned* ctl, LAS unsigned char* lds, int gw, int NGW, int wave, int lane) {
    const h16* QKV = (const h16*)(A.ws + WS_QKV); const float* G = (const float*)(A.ws + WS_GATE); const h16* O = (const h16*)(A.ws + WS_O);
    LAS float* pl = (LAS float*)(lds + wave * 4096);
    LAS float* impl = pl + 256;
    for (int sidx = gw; sidx < 16384; sidx += NGW) {
        const unsigned hsh = diag_hash(sidx * 2 + 101); const int b = hsh & 1, g = (hsh >> 1) & 1, hh = (hsh >> 2) & 3;
        int t = DIAG_TMIN + (int)((hsh >> 4) % (unsigned)(DIAG_TMAX - DIAG_TMIN)); if (sidx < 256) t = DIAG_TMIN + (sidx % (DIAG_TMAX - DIAG_TMIN));
        const int cb = t >> 6; const int nvis = t >= 31 ? ((t - 31) >> 4) + 1 : 0;
        const h16* KC = (const h16*)(A.ws + WS_KC) + ((size_t)((0 * 2 + b) * 2 + g) * 256) * 128;
        const h16* VC = (const h16*)(A.ws + WS_KC) + ((size_t)((1 * 2 + b) * 2 + g) * 256) * 128;
        const size_t tokrow = (size_t)(b * SEQ + t);
        if (lane < 64) impl[lane] = 0.f;
        float oc0 = 0.f, oc1 = 0.f, myqa = 0.f, myqb = 0.f;
        for (int h4 = 0; h4 < 4; ++h4) {
            const h16* qp = QKV + tokrow * NQKV + C_QN + (g * 4 + h4) * 128; const float qa = (float)qp[lane], qb = (float)qp[64 + lane];
            if (h4 == hh) { myqa = qa; myqb = qb; }
            float mx = -__builtin_inff();
            for (int n = 0; n < nvis; ++n) { const float sc = wave_sum(qa * (float)KC[n * 128 + lane] + qb * (float)KC[n * 128 + 64 + lane]); if (lane == 0) pl[n] = sc; mx = fmaxf(mx, sc); }
            float Z = 0.f; for (int n = 0; n < nvis; ++n) Z += expf(pl[n] - mx);
            for (int n = lane; n < 256; n += 64) pl[n] = n < nvis ? expf(pl[n] - mx) / Z : 0.f;
            { const int s_ = lane; float v = pl[4 * s_] + pl[4 * s_ + 1] + pl[4 * s_ + 2] + 0.5f * pl[4 * s_ + 3] + (s_ > 0 ? 0.5f * pl[4 * s_ - 1] : 0.f); impl[s_] += v; }
            if (h4 == hh) for (int n = 0; n < nvis; ++n) { const float p = pl[n]; oc0 += p * (float)VC[n * 128 + lane]; oc1 += p * (float)VC[n * 128 + 64 + lane]; }
        }
        const int s_ = lane; const bool causal = s_ <= cb, forced = (s_ == 0) || (s_ == cb) || (s_ == cb - 1);
        const float key = causal ? (forced ? __builtin_inff() : impl[s_]) : -__builtin_inff();
        int rank = 0; for (int j = 0; j < 64; ++j) { const float kj = __shfl(key, j); rank += (kj > key || (kj == key && j < s_)) ? 1 : 0; }
        const unsigned long long selmask = __ballot(rank < 16 && causal);
        OnlineSM ss; ss.m = -__builtin_inff(); ss.Z = 0.f; ss.a0 = 0.f; ss.a1 = 0.f;
        const h16* Ks = QKV + (size_t)(b * SEQ) * NQKV + C_KSEL + g * 128; const h16* Vs = QKV + (size_t)(b * SEQ) * NQKV + C_VSEL + g * 128;
        for (int blk = 0; blk <= cb; ++blk) if ((selmask >> blk) & 1ull) for (int l = 0; l < 64; ++l) { const int kp = 64 * blk + l; if (kp <= t) osm_key(ss, myqa, myqb, Ks + (size_t)kp * NQKV, Vs + (size_t)kp * NQKV, lane); }
        OnlineSM sw; sw.m = -__builtin_inff(); sw.Z = 0.f; sw.a0 = 0.f; sw.a1 = 0.f;
        const h16* Kw = QKV + (size_t)(b * SEQ) * NQKV + C_KWIN + g * 128; const h16* Vw = QKV + (size_t)(b * SEQ) * NQKV + C_VWIN + g * 128;
        for (int kp = (t - 511 > 0 ? t - 511 : 0); kp <= t; ++kp) osm_key(sw, myqa, myqb, Kw + (size_t)kp * NQKV, Vw + (size_t)kp * NQKV, lane);
        const float* gp = G + tokrow * 24 + (g * 4 + hh) * 3;
        const float w0 = gp[0] * oc0 + gp[1] * ss.a0 / ss.Z + gp[2] * sw.a0 / sw.Z, w1 = gp[0] * oc1 + gp[1] * ss.a1 / ss.Z + gp[2] * sw.a1 / sw.Z;
        const h16* op = O + tokrow * DM + (g * 4 + hh) * 128;
        float d = fmaxf(fabsf((float)op[lane] - w0), fabsf((float)op[64 + lane] - w1));
#pragma unroll
        for (int o_ = 1; o_ < 64; o_ <<= 1) d = fmaxf(d, __shfl_xor(d, o_));
        diag_max(ctl, d * 10.f, lane, ((unsigned)t << 8) | (b << 7) | (g << 6) | (hh << 4));
    }
}
__device__ __forceinline__ void diag_moba(const Args& A, unsigned* ctl, int gw, int NGW, int lane) {
    const h16* QKV = (const h16*)(A.ws + WS_QKV); const h16* O = (const h16*)(A.ws + WS_O);
    for (int sidx = gw; sidx < 2048; sidx += NGW) {
        const unsigned hsh = diag_hash(sidx * 2 + 203); const int b = hsh & 1, h = (hsh >> 1) & 7;
        int t = DIAG_TMIN + (int)((hsh >> 4) % (unsigned)(DIAG_TMAX - DIAG_TMIN)); if (sidx < 256) t = DIAG_TMIN + ((sidx * 37) % (DIAG_TMAX - DIAG_TMIN));
        const int cur = t >> 8; const size_t tokrow = (size_t)(b * SEQ + t);
        const h16* qp = QKV + tokrow * NQKV + C_QM + h * 128; const float qa = (float)qp[lane], qb = (float)qp[64 + lane];
        const h16* Kh = QKV + (size_t)(b * SEQ) * NQKV + C_KM + h * 128; const h16* Vh = QKV + (size_t)(b * SEQ) * NQKV + C_VM + h * 128;
        float key = -__builtin_inff();
        for (int n = 0; n < cur; ++n) { float m0 = 0.f, m1 = 0.f; for (int j = 0; j < 256; ++j) { const h16* kr = Kh + (size_t)(n * 256 + j) * NQKV; m0 += (float)kr[lane]; m1 += (float)kr[64 + lane]; }
            const float sc = wave_sum(qa * (m0 * (1.f / 256.f)) + qb * (m1 * (1.f / 256.f))); if (lane == n) key = sc; }
        int rank = 0; for (int j = 0; j < 16; ++j) { const float kj = __shfl(key, j); rank += (kj > key || (kj == key && j < lane)) ? 1 : 0; }
        const unsigned long long selmask = __ballot(lane < cur && rank < 3);
        if (DIAG_SELCMP) { const unsigned long long km = ((const unsigned long long*)(A.ws + 329 * MiB))[(size_t)(b * 8 + h) * SEQ + t];
            unsigned long long want = 0xFull << (4 * cur); for (int n = 0; n < cur; ++n) if ((selmask >> n) & 1ull) want |= 0xFull << (4 * n);
            diag_max(ctl, km == want ? 0.f : 10.f, lane, ((unsigned)t << 8) | (b << 7) | (h << 4)); continue; }
        OnlineSM ss; ss.m = -__builtin_inff(); ss.Z = 0.f; ss.a0 = 0.f; ss.a1 = 0.f;
        for (int n = 0; n < cur; ++n) if ((selmask >> n) & 1ull) for (int j = 0; j < 256; ++j) { const int kp = n * 256 + j; osm_key(ss, qa, qb, Kh + (size_t)kp * NQKV, Vh + (size_t)kp * NQKV, lane); }
        for (int kp = cur * 256; kp <= t; ++kp) osm_key(ss, qa, qb, Kh + (size_t)kp * NQKV, Vh + (size_t)kp * NQKV, lane);
        const h16* op = O + tokrow * DM + 1024 + h * 128;
        float d = fmaxf(fabsf((float)op[lane] - ss.a0 / ss.Z), fabsf((float)op[64 + lane] - ss.a1 / ss.Z));
#pragma unroll
        for (int o_ = 1; o_ < 64; o_ <<= 1) d = fmaxf(d, __shfl_xor(d, o_));
        diag_max(ctl, d * 10.f, lane, ((unsigned)t << 8) | (b << 7) | (h << 4));
    }
}
#endif

__device__ __forceinline__ void run_t_item(const float* c_in, const float* w_ada, const float* b_ada, const float* w_dn, const float* w_up, const float* w_o, unsigned char* ws, LAS unsigned char* L, unsigned t) {
    int tl = threadIdx.x; asm volatile("" : "+v"(tl));
    const int ln = tl & 63, wv = __builtin_amdgcn_readfirstlane(tl >> 6), q16 = ln & 15;
    if (t < (unsigned)NT_GV) { const int r_ = (int)t * 8 + wv; gemv_half(c_in, w_ada, b_ada, (float*)(ws + WS_MOD), 16 + (r_ & 31), r_ >> 5, ln); return; }
    t -= (unsigned)NT_GV;
    LAS float* scr = (LAS float*)(L + wv * 16640);
    int r = (int)t * 8 + wv; const float* W; int ldw, K, sh; h16* WT;
    if (r < 2048) { W = w_dn; ldw = DM; K = DFF; WT = (h16*)(ws + WS_WDN); sh = 5; }
    else if (r < 4096) { r -= 2048; W = w_up; ldw = DFF; K = DM; WT = (h16*)(ws + WS_WUP); sh = 7; }
    else { r -= 4096; W = w_o; ldw = DM; K = DM; WT = (h16*)(ws + WS_WO); sh = 5; }
    const int kb = r >> sh, nb = r & ((1 << sh) - 1);
    transpose_item128<true>(W, ldw, K, WT, 128 * kb, 64 * nb, 64 * nb + 4 * q16, 4 * q16, scr, ln);
}

__global__ void __launch_bounds__(NWAVES * 64, 2) hymba_fwd(Args args) {
    extern __shared__ __attribute__((aligned(16))) unsigned char lds[];
    LAS unsigned char* L = (LAS unsigned char*)lds;
    volatile LAS unsigned* LCTL = (volatile LAS unsigned*)(L + LDSCTL_OFF);
    const int tid = threadIdx.x, lane = tid & 63, wave = __builtin_amdgcn_readfirstlane(tid >> 6);
    const int G = gridDim.x; const int bx = blockIdx.x; const int vcu = (G % 8 == 0) ? (bx % 8) * (G / 8) + bx / 8 : bx;
    const int NGW = G * NWAVES; (void)lane; (void)wave;
    unsigned* ctl = (unsigned*)(args.ws + WS_CTL);
    for (int u = tid; u < (LDS_BYTES - LDSCTL_OFF) / 4; u += NWAVES * 64) ((LAS unsigned*)(L + LDSCTL_OFF))[u] = 0u;
    __syncthreads();
    XcdBarrier bar; bar.bar = ctl + CW_BAR; bar.x = 0; bar.st = nullptr;
    if (MK_N_LAUNCHES == 1) bar = xcd_barrier_post(ctl + CW_BAR, LCTL);
    const int lo = args.ph_lo, hi = args.ph_hi;
#ifndef PH_MASK
#define PH_MASK 0x3ff
#endif
#define IN(k) (((PH_MASK >> (k)) & 1) && lo <= (k) && (k) < hi)
#define SEAM(k) do { if (IN(k) && IN((k) + 1)) xcd_barrier(bar); } while (0)
#define NREP(k) ((REPEAT_PH == (k)) ? 2 : 1)
#define FRESH() int tid_ = threadIdx.x; asm volatile("" : "+v"(tid_)); const int lane_ = tid_ & 63, wave_ = __builtin_amdgcn_readfirstlane(tid_ >> 6); const int gw_ = vcu * NWAVES + wave_; (void)lane_; (void)gw_

    if (IN(0)) { FRESH(); for (int rep = 0; rep < NREP(0); ++rep) p0_prologue(args, L, gw_, NGW, wave_, lane_, rep); }
    SEAM(0);
    if (IN(1)) { FRESH(); for (int rep = 0; rep < NREP(1); ++rep) p1_rows(args, gw_, NGW, lane_); }
    SEAM(1);
    if (IN(2)) {
        pg8::Gemm g{(const h16*)(args.ws + WS_H), (const h16*)(args.ws + WS_WIN), M, NPAD, DM}; pg8::StaticOrder S; S.init(M, NPAD, G, bx, WGM_P2);
        pg8::EpiQKV E{(h16*)(args.ws + WS_QKV), (float*)(args.ws + WS_GATE), (const float*)(args.ws + WS_COS), (const float*)(args.ws + WS_SIN)};
        for (int rep = 0; rep < NREP(2); ++rep) pg8::gemm_phase<pg8::EpiQKV, pg8::StaticOrder, true, true>(L, g, S, E);
        if (T_IN_P4 && T_P2_ITEMS > 0 && IN(4) && (S.nwg % G) != 0 && bx >= (S.nwg % G)) { FRESH();
#pragma unroll 1
            for (int k = 0; k < T_P2_ITEMS; ++k) { __syncthreads(); if (tid_ == 0) LCTL[2] = __hip_atomic_fetch_add(ctl + CW_QUEUE + 8, 1u, __ATOMIC_RELAXED, __HIP_MEMORY_SCOPE_AGENT); __syncthreads();
                const unsigned t = (unsigned)__builtin_amdgcn_readfirstlane((int)LCTL[2]); if (t >= (unsigned)NT_ITEMS) break; run_t_item(args.in[1], args.in[2], args.in[3], args.in[17], args.in[16], args.in[13], args.ws, L, t); } }
    }
    SEAM(2);
#if DIAG
    if (DIAG & 1) { FRESH(); diag_qkv(args, ctl, gw_, NGW, lane_); }
#endif
    if (IN(3)) {
        FRESH();
        for (int rep = 0; rep < NREP(3); ++rep)
        if (P3_SPLITK && G == 256 && NREP(3) == 1) { p3_compress_splitk(args, L, ctl, bx, wave_, lane_); if ((bx & 7) >= 4) p3_kmean_item(args, L, (bx >> 3) * 4 + (bx & 7) - 4, wave_, lane_, ctl); }
        else
        for (int it = bx; it < 256; it += G) { if (it < 128) p3_compress_item(args, L, it, wave_, lane_); else p3_kmean_item(args, L, it - 128, wave_, lane_); }
    }
    const bool p34 = P34_HANDOFF && P3_SPLITK && G == 256 && IN(3) && IN(4) && NREP(3) == 1 && NREP(4) == 1;
    if (!p34) SEAM(3);
#if DIAG
    if (DIAG & 2) { FRESH(); diag_kc(args, ctl, gw_, NGW, lane_); }
#endif
    if (IN(4)) {
        FRESH();
#ifndef Q_DED
#define Q_DED 16
#endif
#ifndef Q_RES
#define Q_RES 200
#endif
#define Q_FETCH(qv) do { __syncthreads(); if (tid_ == 0) { unsigned mode = LCTL[3], item = 0xffffu; \
            if (mode == 0u) { const unsigned t = __hip_atomic_fetch_add(ctl + CW_QUEUE + 8 + rep4, 1u, __ATOMIC_RELAXED, __HIP_MEMORY_SCOPE_AGENT); if (t + Q_RES + 1 >= (unsigned)NT_ITEMS) mode = 1u; if (t < (unsigned)NT_ITEMS) item = 0x4000u | t; } \
            if (item == 0xffffu && mode == 1u) { const unsigned a_ = __hip_atomic_fetch_add(ctl + CW_QUEUE + rep4, 1u, __ATOMIC_RELAXED, __HIP_MEMORY_SCOPE_AGENT); if (a_ < 512u) item = args.order[a_]; else mode = 2u; } \
            if (item == 0xffffu && mode == 2u) { const unsigned t = __hip_atomic_fetch_add(ctl + CW_QUEUE + 8 + rep4, 1u, __ATOMIC_RELAXED, __HIP_MEMORY_SCOPE_AGENT); if (t < (unsigned)NT_ITEMS) item = 0x4000u | t; } \
            LCTL[3] = mode; LCTL[2] = item; } __syncthreads(); qv = (unsigned)__builtin_amdgcn_readfirstlane((int)LCTL[2]); } while (0)
        const h16* QKVp = (const h16*)(args.ws + WS_QKV);
        for (int rep4 = 0; rep4 < NREP(4); ++rep4) {
        if (rep4) xcd_barrier(bar);
        if (tid_ == 0) LCTL[3] = (T_IN_P4 && bx < Q_DED) ? 0u : 1u;
        for (;;) {
            unsigned v; Q_FETCH(v);
            if (v == 0xffffu) break;
            if (T_IN_P4 && (v & 0x4000u)) { run_t_item(args.in[1], args.in[2], args.in[3], args.in[17], args.in[16], args.in[13], args.ws, L, v & 0x3fffu); continue; }
#define MAKE_CTX(cn) int tl_##cn = threadIdx.x; asm volatile("" : "+v"(tl_##cn)); \
            att::Ctx cn; cn.tid = tl_##cn; cn.wid = __builtin_amdgcn_readfirstlane(tl_##cn >> 6); cn.lane = tl_##cn & 63; cn.r32 = cn.lane & 31; cn.hi = cn.lane >> 5; cn.sr = tl_##cn >> 4; cn.sc = (tl_##cn & 15) * 8; \
            cn.kws = KSWZ(cn.sr, cn.sc * 2); cn.vst0 = att::v_st(cn.sr, cn.sc); cn.vst1 = att::v_st(32 + cn.sr, cn.sc); \
            cn.lds = (LAS char*)L; cn.V_lds = cn.lds + att::L_V; cn.K_lds = cn.lds + att::L_K; cn.wsc = (LAS float*)(cn.lds + att::L_WS) + cn.wid * 64; \
            cn.vb0 = (int)(unsigned)(uintptr_t)cn.V_lds + att::v_rd_base(cn.lane)
            MAKE_CTX(c0);
            const bool moba = (v & 0x8000u) != 0u; const int b = (v >> 7) & 1;
            h16x8 qr[8]; f32x16 o[4] = {}; unsigned long long rowmask;
#define P34_WAIT() do { if (p34 && tid_ == 0) { const int slot = moba ? 4 + b * 4 + (int)((v >> 5) & 3) : b * 2 + (int)((v >> 6) & 1); const unsigned bit = 1u << slot, want = moba ? 16u : 32u; \
                if (!(LCTL[5] & bit)) { unsigned sp = 0u; while (__hip_atomic_load(ctl + CW_P34 + 64 * slot, __ATOMIC_RELAXED, __HIP_MEMORY_SCOPE_AGENT) < want) { __builtin_amdgcn_s_sleep(1); if (++sp > (1u << 22)) break; } \
                    __builtin_amdgcn_fence(__ATOMIC_ACQUIRE, "agent"); LCTL[5] |= bit; } } } while (0)
            if (moba) { P34_WAIT(); att::moba_prepare(args, c0, b, (v >> 4) & 7, v & 15, qr, rowmask); }
            else { const int g = (v >> 6) & 1, ci = v & 63; const int hh = c0.wid >> 1, head = g * 4 + hh, t = 64 * ci + (c0.wid & 1) * 32 + c0.r32; const size_t tokrow = (size_t)(b * SEQ + t);
#pragma unroll
                for (int d0 = 0; d0 < 8; ++d0) qr[d0] = *(const h16x8*)(QKVp + tokrow * NQKV + C_QN + head * 128 + d0 * 16 + c0.hi * 8); }
            const int nbr = moba ? 1 : 2;
#pragma unroll 1
            for (int br = 0; br < nbr; ++br) {
                MAKE_CTX(c);
                if (!moba && br == 1) { P34_WAIT(); att::nsa_prepare<true>(args, c, b, (v >> 6) & 1, v & 63, qr, o, rowmask, (h16*)(args.ws + WS_O)); }
                int koff, voff, j_lo, j_hi, wq0, ocol; unsigned W; unsigned long long rm; const int kind = moba ? 0 : 1 - br;
                if (moba) { const int h = (v >> 4) & 7, cj = v & 15; koff = C_KM + h * 128; voff = C_VM + h * 128; j_lo = 0; j_hi = 4 * cj + 4; W = 1u << 30; rm = rowmask; wq0 = 256 * cj + 32 * c.wid; ocol = 1024 + h * 128; }
                else { const int g = (v >> 6) & 1, ci = v & 63; wq0 = 64 * ci + (c.wid & 1) * 32; ocol = (g * 4 + (c.wid >> 1)) * 128; j_hi = ci + 1;
                    if (kind == 0) { koff = C_KSEL + g * 128; voff = C_VSEL + g * 128; j_lo = 0; W = 1u << 30; rm = rowmask; }
                    else { koff = C_KWIN + g * 128; voff = C_VWIN + g * 128; j_lo = ci - 8 < 0 ? 0 : ci - 8; W = 512u; rm = ~0ull; } }
                const h16* Kp_ = QKVp + (size_t)(b * SEQ) * NQKV + koff; const h16* Vp_ = QKVp + (size_t)(b * SEQ) * NQKV + voff;
                h16* Ow_ = (h16*)(args.ws + WS_O) + (size_t)(b * SEQ + wq0) * DM + ocol;
                const float gate = moba ? 1.f : ((const float*)(args.ws + WS_GATE))[(size_t)(b * SEQ + wq0 + c.r32) * 24 + (ocol >> 7) * 3 + 1 + kind];
                { att::SM sm; sm.m = -1e30f; sm.l = 0.f;
                att::run_attn9(c, qr, o, sm, Kp_, Vp_, NQKV, j_lo, j_hi, wq0 + c.r32, W, rm, wq0, wq0 + 31);
                att::finish(c, o, sm, gate); att::store_o(c, o, Ow_, DM, !moba && br == 1); }
            }
#undef P34_WAIT
        }
        }
#undef Q_FETCH
    }
    SEAM(4);
#if DIAG
    if (DIAG & 32) { FRESH(); diag_nsa(args, ctl, L, gw_, NGW, wave_, lane_); }
    if (DIAG & 64) { FRESH(); diag_moba(args, ctl, gw_, NGW, lane_); }
    if (DIAG & 128) { FRESH(); diag_kmean(args, ctl, gw_, NGW, lane_); }
#endif
    const bool fuse6 = FUSE_P6 && G == (M / 256) * (DM / 256) && IN(5) && IN(6);
    if (IN(5)) {
        pg8::Gemm g{(const h16*)(args.ws + WS_O), (const h16*)(args.ws + WS_WO), M, DM, DM}; pg8::StaticOrder S; S.init(M, DM, G, bx);
        if (fuse6) { pg8::EpiNormResNorm E{args.in[0], (h16*)(args.ws + WS_X1), (h16*)(args.ws + WS_H), (float*)(args.ws + WS_SSQ + 1 * MiB), (float*)(args.ws + WS_SSQ + 1 * MiB + 512 * 1024),
                                           ctl + CW_XCH + 2048, ctl + CW_XCH + 4096, args.in[5], args.in[14], (const float*)(args.ws + WS_MOD)};
            pg8::gemm_phase<pg8::EpiNormResNorm, pg8::StaticOrder, true, true>(L, g, S, E); }
        else { pg8::EpiF16SS E{(h16*)(args.ws + WS_OP), DM, (float*)(args.ws + WS_SSQ)};
        for (int rep = 0; rep < NREP(5); ++rep) pg8::gemm_phase<pg8::EpiF16SS, pg8::StaticOrder, true, true>(L, g, S, E); }
    }
    if (!fuse6) SEAM(5);
#if DIAG
    if (DIAG & 4) { FRESH(); diag_gemm<0>(ctl, (const h16*)(args.ws + WS_O), DM, args.in[13], DM, args.ws + WS_OP, 10.f, gw_, NGW, lane_, 5u); }
#endif
    if (IN(6) && !fuse6) { FRESH(); for (int rep = 0; rep < NREP(6); ++rep) p6_rows(args, gw_, NGW, lane_); }
    SEAM(6);
    const bool p78 = P78_HANDOFF && G == (M / 256) * (DM / 256) && IN(7) && IN(8) && NREP(7) == 1 && NREP(8) == 1;
    if (IN(7)) {
        pg8::Gemm g{(const h16*)(args.ws + WS_H), (const h16*)(args.ws + WS_WUP), M, DFF, DM}; pg8::StaticOrder S; S.init(M, DFF, G, bx, WGM_P7);
        pg8::EpiRelu2 E{(h16*)(args.ws + WS_U), DFF};
        for (int rep = 0; rep < NREP(7); ++rep) pg8::gemm_phase<pg8::EpiRelu2, pg8::StaticOrder, true, true>(L, g, S, E);
        if (p78 && threadIdx.x == 0) { pg8::Unit u_; for (int i = 0; S.next(i, u_); ++i) __hip_atomic_fetch_add(ctl + CW_P78 + 64 * u_.pm, 1u, __ATOMIC_RELAXED, __HIP_MEMORY_SCOPE_AGENT); }
    }
    if (!p78) SEAM(7);
#if DIAG
    if (DIAG & 8) { FRESH(); diag_gemm<1>(ctl, (const h16*)(args.ws + WS_H), DM, args.in[16], DFF, args.ws + WS_U, 1.f, gw_, NGW, lane_, 9u); }
#endif
    const bool fuse9 = FUSE_P9 && G == (M / 256) * (DM / 256) && IN(8) && IN(9);
    if (IN(8)) {
        pg8::Gemm g{(const h16*)(args.ws + WS_U), (const h16*)(args.ws + WS_WDN), M, DM, DFF}; pg8::StaticOrder S; S.init(M, DM, G, bx);
        if (p78) { pg8::Unit u_; if (S.next(0, u_) && threadIdx.x == 0) { unsigned sp = 0u;
                while (__hip_atomic_load(ctl + CW_P78 + 64 * u_.pm, __ATOMIC_RELAXED, __HIP_MEMORY_SCOPE_AGENT) < (unsigned)(DFF / 256)) { __builtin_amdgcn_s_sleep(1); if (++sp > (1u << 22)) break; }
                __builtin_amdgcn_fence(__ATOMIC_ACQUIRE, "agent"); }
            __syncthreads(); }
        if (fuse9) { pg8::EpiNormOut E{(const h16*)(args.ws + WS_X1), args.out, (float*)(args.ws + WS_SSQ + 2 * MiB), ctl + CW_XCH, args.in[15], (const float*)(args.ws + WS_MOD) + 5 * DM};
            pg8::gemm_phase<pg8::EpiNormOut, pg8::StaticOrder, true, true>(L, g, S, E); }
        else { pg8::EpiF16SS E{(h16*)(args.ws + WS_F), DM, (float*)(args.ws + WS_SSQ)};
        for (int rep = 0; rep < NREP(8); ++rep) pg8::gemm_phase<pg8::EpiF16SS, pg8::StaticOrder, true, true>(L, g, S, E); }
    }
    if (!fuse9) SEAM(8);
#if DIAG
    if (DIAG & 16) { FRESH(); diag_gemm<0>(ctl, (const h16*)(args.ws + WS_U), DFF, args.in[17], DM, args.ws + WS_F, 1.f, gw_, NGW, lane_, 13u); }
#endif
    if (IN(9) && !fuse9) { FRESH(); p9_rows(args, gw_, NGW, lane_); }
#if DIAG
    { xcd_barrier(bar); FRESH(); const unsigned long long dv = __hip_atomic_load((unsigned long long*)(ctl + CW_DIAG), __ATOMIC_RELAXED, __HIP_MEMORY_SCOPE_AGENT);
      const float mval = __uint_as_float((unsigned)(dv >> 32)); const unsigned pay = (unsigned)dv; const int pt = pay >> 8;
      float Cval = 1000.f * exp2f(ceilf(log2f(fmaxf(mval, 1e-12f))));
      if (DIAG_FIELD == 4) Cval = 10.f * (float)(1u + __hip_atomic_load(ctl + CW_DIAG + 4, __ATOMIC_RELAXED, __HIP_MEMORY_SCOPE_AGENT));
      if (DIAG_FIELD == 1) Cval = 10.f * (float)((pt >> 6) + 1);
      if (DIAG_FIELD == 2) Cval = 10.f * (float)((pt & 63) + 1);
      if (DIAG_FIELD == 3) Cval = 10.f * (float)(((pay >> 4) & 15) + 1);
      for (size_t e = (size_t)gw_ * 64 + lane_; e < (size_t)M * DM; e += (size_t)NGW * 64) args.out[e] = Cval; }
#endif
#undef IN
#undef SEAM
}

static void build_order(unsigned short* order) {
    struct It { int cost; unsigned short v; };
    It items[512]; int n = 0;
    for (int b = 0; b < 2; ++b) for (int g = 0; g < 2; ++g) for (int i = 0; i < 64; ++i) {
        const int ntc = ((4 * i + 2) >> 6) + 1; const int cost = 6 * ntc + 2 * (i + 1) + 2 * (i + 1 < 9 ? i + 1 : 9) + 40;
        items[n].cost = cost; items[n].v = (unsigned short)((b << 7) | (g << 6) | i); ++n; }
    for (int b = 0; b < 2; ++b) for (int h = 0; h < 8; ++h) for (int j = 0; j < 16; ++j) {
        items[n].cost = 2 * 4 * (j + 1) + 18; items[n].v = (unsigned short)(0x8000 | (b << 7) | (h << 4) | j); ++n; }
    for (int i = 1; i < 512; ++i) { It k = items[i]; int j = i - 1; while (j >= 0 && items[j].cost < k.cost) { items[j + 1] = items[j]; --j; } items[j + 1] = k; }
    if (1) { for (int i = 0; i < 512; ++i) order[i] = items[i].v; return; }
    const int NT = NT_ITEMS, TC = 7; long tot = (long)NT * TC; for (int i = 0; i < 512; ++i) tot += items[i].cost;
    const double tend = 0.8 * (double)tot / 256.0; int fr[256]; for (int w = 0; w < 256; ++w) fr[w] = 0;
    int nA = 0, nT = 0; n = 0;
    while (nA < 512 || nT < NT) {
        int w = 0; for (int u = 1; u < 256; ++u) if (fr[u] < fr[w]) w = u;
        const double tgt = 24.0 + (NT - 24) * (double)fr[w] / tend;
        if (nT < NT && (nA >= 512 || (double)nT < tgt)) { order[n++] = (unsigned short)(0x4000 | nT); ++nT; fr[w] += TC; }
        else { order[n++] = items[nA].v; fr[w] += items[nA].cost; ++nA; }
    }
}

extern "C" void kernel_launch(void* const* d_in, const int* in_sizes, int n_in, void* d_out, int out_size, void* d_ws, size_t ws_size, hipStream_t stream) {
    static int grid = 0; static Args a;
    if (grid == 0) {
        if (n_in != 18 || in_sizes[0] != M * DM || out_size != M * DM || ws_size < WS_END) { fprintf(stderr, "kernel_launch: unexpected shapes (n_in %d, in0 %d, out %d, ws %zu)\n", n_in, n_in > 0 ? in_sizes[0] : -1, out_size, ws_size); grid = -1; return; }
        int dev = 0, cus = 0, per_cu = 0;
        if (hipGetDevice(&dev) != hipSuccess || hipDeviceGetAttribute(&cus, hipDeviceAttributeMultiprocessorCount, dev) != hipSuccess) { grid = -1; return; }
        if (hipFuncSetAttribute((const void*)hymba_fwd, hipFuncAttributeMaxDynamicSharedMemorySize, LDS_BYTES) != hipSuccess) { fprintf(stderr, "kernel_launch: hipFuncSetAttribute failed\n"); grid = -1; return; }
        if (hipOccupancyMaxActiveBlocksPerMultiprocessor(&per_cu, (const void*)hymba_fwd, NWAVES * 64, LDS_BYTES) != hipSuccess || per_cu < 1) { fprintf(stderr, "kernel_launch: occupancy query says %d\n", per_cu); }
        (void)hipGetLastError();
        grid = cus;
        memset(&a, 0, sizeof(a));
        build_order(a.order);
    }
    if (grid < 0) return;
    (void)hipMemsetAsync((char*)d_ws + WS_CTL, 0, CTL_ZERO_BYTES, stream);
    for (int i = 0; i < 18; ++i) a.in[i] = (const float*)d_in[i];
    a.out = (float*)d_out; a.ws = (unsigned char*)d_ws;
    if (MK_N_LAUNCHES == 1) {
        a.ph_lo = 0; a.ph_hi = 10;
        void* params[] = {&a};
        hipError_t e = hipLaunchCooperativeKernel((const void*)hymba_fwd, dim3(grid), dim3(NWAVES * 64), params, LDS_BYTES, stream);
        if (e != hipSuccess) fprintf(stderr, "kernel_launch: cooperative launch failed: %s (grid %d)\n", hipGetErrorString(e), grid);
    } else {
        for (int p = 0; p < 10; ++p) { a.ph_lo = p; a.ph_hi = p + 1; hipLaunchKernelGGL(hymba_fwd, dim3(grid), dim3(NWAVES * 64), LDS_BYTES, stream, a); }
    }
}
```

```cpp
#include <hip/hip_runtime.h>
#include <cstdio>
#include <cstdint>
#include <cmath>
#include <cstring>

#ifndef DIAG
#define DIAG 0
#endif
#ifndef DIAG_SELCMP
#define DIAG_SELCMP 1
#endif
#ifndef PROBE_VAR
#define PROBE_VAR 2
#endif
#ifndef REPEAT_PH
#define REPEAT_PH -1
#ifndef T_P2_ITEMS
#define T_P2_ITEMS 6
#endif
#ifndef P0_BAL
#define P0_BAL 1
#endif
#ifndef WGM_P7
#define WGM_P7 2
#endif
#ifndef WGM_P2
#define WGM_P2 4
#endif
#ifndef P34_HANDOFF
#define P34_HANDOFF 1
#endif
#ifndef P78_HANDOFF
#define P78_HANDOFF 1
#endif
#ifndef GV_Q
#define GV_Q 1
#endif
#ifndef P3_SPLITK
#define P3_SPLITK 1
#endif
#ifndef FUSE_P9
#define FUSE_P9 1
#endif
#ifndef FUSE_P6
#define FUSE_P6 1
#endif
#endif
#ifndef MK_N_LAUNCHES
#define MK_N_LAUNCHES 1
#endif

typedef _Float16 h16;
typedef _Float16 h16x2 __attribute__((ext_vector_type(2)));
typedef _Float16 h16x8 __attribute__((ext_vector_type(8)));
typedef float f32x2 __attribute__((ext_vector_type(2)));
typedef float f32x4 __attribute__((ext_vector_type(4)));
typedef float f32x16 __attribute__((ext_vector_type(16)));
typedef unsigned u32x2 __attribute__((ext_vector_type(2)));
typedef unsigned u32x4 __attribute__((ext_vector_type(4)));
typedef short s16x4 __attribute__((ext_vector_type(4)));
typedef short s16x8 __attribute__((ext_vector_type(8)));

#define LAS __attribute__((address_space(3)))
#define GAS __attribute__((address_space(1)))

__device__ __forceinline__ unsigned pk2h(float lo, float hi) { f32x2 v = {lo, hi}; h16x2 h = __builtin_convertvector(v, h16x2); return __builtin_bit_cast(unsigned, h); }

constexpr int BATCH = 2, SEQ = 4096, DM = 2048, M = BATCH * SEQ, DFF = 8192, HD = 128;
constexpr int INCOLS = 5656, NQKV = 5632, NPAD = 5888;
constexpr int C_QN = 0, C_KCMP = 1024, C_VCMP = 1280, C_KSEL = 1536, C_VSEL = 1792, C_KWIN = 2048, C_VWIN = 2304, C_QM = 2560, C_KM = 3584, C_VM = 4608;
constexpr float EPS = 1e-6f;
constexpr float QSCALE = 0.08838834764831845f;
constexpr float LOG2E = 1.4426950408889634f;

constexpr size_t MiB = 1u << 20;
constexpr size_t WS_CTL = 0, CTL_ZERO_BYTES = 1 * MiB;
constexpr size_t WS_MOD = 512 * 1024;
constexpr size_t WS_POSB = 768 * 1024;
constexpr size_t WS_KMEAN = 1 * MiB + 64 * 1024;
constexpr size_t WS_KC = 1 * MiB + 512 * 1024;
constexpr size_t WS_COS = 2 * MiB, WS_SIN = 3 * MiB;
constexpr size_t WS_W1T = 4 * MiB;
constexpr size_t WS_W2T = 6 * MiB;
constexpr size_t WS_GATE = 6 * MiB + 512 * 1024;
constexpr size_t WS_SSQ = 328 * MiB;
constexpr size_t WS_WIN = 8 * MiB;
constexpr size_t WS_WO = 32 * MiB;
constexpr size_t WS_WUP = 40 * MiB;
constexpr size_t WS_WDN = 72 * MiB;
constexpr size_t WS_H = 104 * MiB;
constexpr size_t WS_QKV = 136 * MiB;
constexpr size_t WS_O = 224 * MiB;
constexpr size_t WS_OP = 256 * MiB;
constexpr size_t WS_U = 136 * MiB;
constexpr size_t WS_X1 = 296 * MiB;
constexpr size_t WS_F = 264 * MiB;
constexpr size_t WS_END = 331 * MiB;
constexpr int CW_QUEUE = 64;
constexpr int CW_XCH = 8192;
constexpr int CW_P34 = 16384;
constexpr int CW_P78 = 18432;
constexpr int CW_BAR = 4096;

__device__ __forceinline__ f32x4 unpack4h(u32x2 w) { const unsigned wx = w[0], wy = w[1];
    const h16x2 a = __builtin_bit_cast(h16x2, wx), b = __builtin_bit_cast(h16x2, wy); return (f32x4){(float)a.x, (float)a.y, (float)b.x, (float)b.y}; }

namespace pg8 {
constexpr int BM = 256, BK = 64, HALF = 128, HTB = HALF * BK * 2, STAGE_BYTES = 8 * HTB, NXCD = 8, WGM = 2;
__host__ __device__ __forceinline__ int lds_byte(int r, int c) { const int st = (r >> 4) * 2 + (c >> 5), rr = r & 15, cc = c & 31, ob = rr * 64 + cc * 2; return st * 1024 + (ob ^ (((ob >> 9) & 1) << 5)); }
__host__ __device__ __forceinline__ void stage_rc(int b, int& R, int& C) { const int st = b / 1024, sb = b % 1024, swz = sb ^ (((sb >> 9) & 1) << 5); R = (st >> 1) * 16 + swz / 64; C = (st & 1) * 32 + (swz % 64) / 2; }
__host__ __device__ __forceinline__ int perm32(int rho) { const int n = rho >> 4, i = rho & 15; return 8 * (i >> 2) + 4 * n + (i & 3); }
struct Unit { int pm, pn; };
struct Gemm { const h16* A; const h16* Bt; int M, N, K; };
struct StaticOrder {
    int nM, nN, nwg, G, c, wgm;
    __host__ __device__ void init(int M_, int N_, int G_, int c_, int wgm_ = WGM) { nM = M_ / BM; nN = N_ / BM; nwg = nM * nN; G = G_; c = c_; wgm = wgm_; }
    __host__ __device__ bool next(int i, Unit& u) const {
        const long L = (long)i * G + c; if (L >= nwg) return false;
        int wgid = (int)L; { const int q = nwg / NXCD, r = nwg % NXCD, xcd = wgid % NXCD, off = wgid / NXCD; wgid = (xcd < r ? xcd * (q + 1) : r * (q + 1) + (xcd - r) * q) + off; }
        const int nig = wgm * nN, gid = wgid / nig, fm = gid * wgm, gsz = (nM - fm) < wgm ? (nM - fm) : wgm;
        u.pm = fm + ((wgid % nig) % gsz); u.pn = (wgid % nig) / gsz; return true;
    }
};
template <class Epi, class Sched, bool ALIGN_EPI, bool SP2>
__device__ __forceinline__ void gemm_phase(LAS unsigned char* lds, const Gemm g, const Sched& S, const Epi& E) {
    const int tid = threadIdx.x, wid = __builtin_amdgcn_readfirstlane(tid >> 6), lane = tid & 63, wr = wid >> 2, wc = wid & 3, fr = lane & 15, fq = lane >> 4;
    const int K = g.K, nt = K / BK;
    unsigned voffA[2], voffB[2];
#pragma unroll
    for (int i = 0; i < 2; ++i) { int R, C; stage_rc(tid * 16 + i * 8192, R, C); const int Rb = Epi::PERM ? ((R & ~31) + perm32(R & 31)) : R;
        voffA[i] = (unsigned)(R * K + C) * 2u; voffB[i] = (unsigned)(Rb * K + C) * 2u; }
    const size_t kstep = (size_t)(BK * 2);
    const size_t hstep = (size_t)HALF * K * 2;
    const size_t tstep = 2 * hstep;
    const unsigned ldsw = (unsigned)wid * 1024u;
    const int aoff = lds_byte(wr * 64 + fr, fq * 8), boff = lds_byte(wc * 32 + fr, fq * 8);
#define PG8_SA(b, h) (((b) * 2 + (h)) * HTB)
#define PG8_SB(b, h) ((4 + (b) * 2 + (h)) * HTB)
#define PG8_STAGE(bufoff, gbase, voff) do { _Pragma("unroll") for (int _i = 0; _i < 2; ++_i) \
        __builtin_amdgcn_global_load_lds((const unsigned*)((const char*)(gbase) + (voff)[_i]), (LAS unsigned*)(lds + (bufoff) + ldsw + _i * 8192), 16, 0, 0); } while (0)
#define PG8_LDA(dst, b, h) do { _Pragma("unroll") for (int m = 0; m < 4; ++m) _Pragma("unroll") for (int k = 0; k < 2; ++k) dst[m][k] = *(const LAS h16x8*)(lds + PG8_SA(b, h) + aoff + m * 2048 + k * 1024); } while (0)
#define PG8_LDB(dst, b, h) do { _Pragma("unroll") for (int n = 0; n < 2; ++n) _Pragma("unroll") for (int k = 0; k < 2; ++k) dst[n][k] = *(const LAS h16x8*)(lds + PG8_SB(b, h) + boff + n * 2048 + k * 1024); } while (0)
#define PG8_MMA(ai, bj, At, Bt) do { __builtin_amdgcn_s_setprio(1); _Pragma("unroll") for (int m = 0; m < 4; ++m) _Pragma("unroll") for (int n = 0; n < 2; ++n) _Pragma("unroll") for (int k = 0; k < 2; ++k) \
        acc[ai][bj][m][n] = __builtin_amdgcn_mfma_f32_16x16x32_f16(Bt[n][k], At[m][k], acc[ai][bj][m][n], 0, 0, 0); __builtin_amdgcn_s_setprio(0); } while (0)
#define PG8_WAIT_V(n) asm volatile("s_waitcnt vmcnt(" #n ")" ::: "memory")
#define PG8_WAIT_L(n) asm volatile("s_waitcnt lgkmcnt(" #n ")" ::: "memory")
#define PG8_BAR __builtin_amdgcn_s_barrier()
#define PG8_SCHED __builtin_amdgcn_sched_barrier(0)
    Unit cur, nxt; int ui = 0;
    if (!S.next(0, cur)) return;
    f32x4 acc[2][2][4][2];
#pragma unroll
    for (int a = 0; a < 2; ++a)
#pragma unroll
        for (int b = 0; b < 2; ++b)
#pragma unroll
            for (int m = 0; m < 4; ++m)
#pragma unroll
                for (int n = 0; n < 2; ++n) acc[a][b][m][n] = (f32x4){0.f, 0.f, 0.f, 0.f};
    h16x8 At[4][2], B0[2][2], B1[2][2];
    const char* cA = (const char*)g.A + (size_t)cur.pm * tstep; const char* cB = (const char*)g.Bt + (size_t)cur.pn * tstep;
    if constexpr (SP2) {
        PG8_STAGE(PG8_SB(0, 0), cB, voffB); PG8_STAGE(PG8_SB(0, 1), cB + hstep, voffB); PG8_STAGE(PG8_SA(0, 0), cA, voffA); PG8_STAGE(PG8_SA(0, 1), cA + hstep, voffA);
        if (wr == 1) PG8_BAR;
        PG8_WAIT_V(2); PG8_BAR;
        PG8_STAGE(PG8_SB(1, 0), cB + kstep, voffB); PG8_STAGE(PG8_SA(1, 0), cA + kstep, voffA); PG8_STAGE(PG8_SB(1, 1), cB + hstep + kstep, voffB);
        PG8_WAIT_V(6); PG8_BAR;
    } else {
        PG8_STAGE(PG8_SB(0, 0), cB, voffB); PG8_STAGE(PG8_SA(0, 0), cA, voffA); PG8_STAGE(PG8_SB(0, 1), cB + hstep, voffB); PG8_STAGE(PG8_SA(0, 1), cA + hstep, voffA);
        if (wr == 1) PG8_BAR;
        PG8_WAIT_V(4); PG8_BAR;
        PG8_STAGE(PG8_SB(1, 0), cB + kstep, voffB); PG8_STAGE(PG8_SA(1, 0), cA + kstep, voffA); PG8_STAGE(PG8_SB(1, 1), cB + hstep + kstep, voffB);
        PG8_WAIT_V(6); PG8_BAR;
    }
    for (;;) {
        const bool has_next = S.next(ui + 1, nxt);
        const char* nA = has_next ? (const char*)g.A + (size_t)nxt.pm * tstep : cA; const char* nB = has_next ? (const char*)g.Bt + (size_t)nxt.pn * tstep : cB;
        for (int t = 0; t < nt; t += 2) {
            const bool last = (t == nt - 2);
            const char* a1 = cA + (size_t)(t + 1) * kstep;
            const char* a2 = last ? nA : cA + (size_t)(t + 2) * kstep; const char* b2 = last ? nB : cB + (size_t)(t + 2) * kstep;
            const char* a3 = a2 + kstep; const char* b3 = b2 + kstep;
            if constexpr (SP2) {
            PG8_LDB(B0, 0, 0); PG8_LDB(B1, 0, 1); PG8_SCHED; PG8_LDA(At, 0, 0); PG8_STAGE(PG8_SA(1, 1), a1 + hstep, voffA);
            PG8_WAIT_V(8); PG8_WAIT_L(0); PG8_BAR; PG8_MMA(0, 0, At, B0); PG8_MMA(0, 1, At, B1); PG8_BAR; PG8_SCHED;
            PG8_LDA(At, 0, 1); PG8_STAGE(PG8_SB(0, 0), b2, voffB); PG8_STAGE(PG8_SB(0, 1), b2 + hstep, voffB); PG8_STAGE(PG8_SA(0, 0), a2, voffA);
            PG8_WAIT_V(8); PG8_WAIT_L(0); PG8_BAR; PG8_MMA(1, 0, At, B0); PG8_MMA(1, 1, At, B1); PG8_BAR; PG8_SCHED;
            PG8_LDB(B0, 1, 0); PG8_LDB(B1, 1, 1); PG8_SCHED; PG8_LDA(At, 1, 0); PG8_STAGE(PG8_SA(0, 1), a2 + hstep, voffA);
            PG8_WAIT_V(8); PG8_WAIT_L(0); PG8_BAR; PG8_MMA(0, 0, At, B0); PG8_MMA(0, 1, At, B1); PG8_BAR; PG8_SCHED;
            PG8_LDA(At, 1, 1); PG8_STAGE(PG8_SB(1, 0), b3, voffB); PG8_STAGE(PG8_SB(1, 1), b3 + hstep, voffB); PG8_STAGE(PG8_SA(1, 0), a3, voffA);
            PG8_WAIT_V(8); PG8_WAIT_L(0); PG8_BAR; PG8_MMA(1, 0, At, B0); PG8_MMA(1, 1, At, B1); PG8_BAR; PG8_SCHED;
            } else {
            PG8_LDB(B0, 0, 0); PG8_SCHED; PG8_LDA(At, 0, 0); PG8_STAGE(PG8_SA(1, 1), a1 + hstep, voffA);
            PG8_WAIT_L(8); PG8_BAR; PG8_WAIT_L(0); PG8_MMA(0, 0, At, B0); PG8_BAR; PG8_SCHED;
            PG8_LDB(B1, 0, 1); PG8_STAGE(PG8_SB(0, 0), b2, voffB);
            PG8_BAR; PG8_WAIT_L(0); PG8_MMA(0, 1, At, B1); PG8_BAR;
            PG8_LDA(At, 0, 1); PG8_STAGE(PG8_SA(0, 0), a2, voffA);
            PG8_BAR; PG8_WAIT_L(0); PG8_MMA(1, 0, At, B0); PG8_BAR; PG8_SCHED;
            PG8_STAGE(PG8_SB(0, 1), b2 + hstep, voffB);
            PG8_WAIT_V(6); PG8_BAR; PG8_MMA(1, 1, At, B1); PG8_BAR;
            PG8_LDB(B0, 1, 0); PG8_SCHED; PG8_LDA(At, 1, 0); PG8_STAGE(PG8_SA(0, 1), a2 + hstep, voffA);
            PG8_WAIT_L(8); PG8_BAR; PG8_WAIT_L(0); PG8_MMA(0, 0, At, B0); PG8_BAR; PG8_SCHED;
            PG8_LDB(B1, 1, 1); PG8_STAGE(PG8_SB(1, 0), b3, voffB);
            PG8_BAR; PG8_WAIT_L(0); PG8_MMA(0, 1, At, B1); PG8_BAR;
            PG8_LDA(At, 1, 1); PG8_STAGE(PG8_SA(1, 0), a3, voffA);
            PG8_BAR; PG8_WAIT_L(0); PG8_MMA(1, 0, At, B0); PG8_BAR; PG8_SCHED;
            PG8_STAGE(PG8_SB(1, 1), b3 + hstep, voffB);
            PG8_WAIT_V(6); PG8_BAR; PG8_MMA(1, 1, At, B1); PG8_BAR;
            }
        }
        if constexpr (ALIGN_EPI) { if (wr == 0) PG8_BAR; }
        if constexpr (!Epi::AFTER_DRAIN) E(acc, cur, wr, wc, fr, fq);
        if (!has_next) break;
#pragma unroll
        for (int a = 0; a < 2; ++a)
#pragma unroll
            for (int b = 0; b < 2; ++b)
#pragma unroll
                for (int m = 0; m < 4; ++m)
#pragma unroll
                    for (int n = 0; n < 2; ++n) acc[a][b][m][n] = (f32x4){0.f, 0.f, 0.f, 0.f};
        cur = nxt; cA = nA; cB = nB; ++ui;
        if constexpr (ALIGN_EPI) { if (wr == 1) PG8_BAR; }
    }
    PG8_WAIT_V(0);
    if constexpr (!ALIGN_EPI) { if (wr == 0) PG8_BAR; }
    PG8_BAR;
    if constexpr (Epi::AFTER_DRAIN) E.fused(acc, cur, wr, wc, fr, fq, lds, wid, lane);
#undef PG8_SA
#undef PG8_SB
#undef PG8_STAGE
#undef PG8_LDA
#undef PG8_LDB
#undef PG8_MMA
#undef PG8_WAIT_V
#undef PG8_WAIT_L
#undef PG8_BAR
#undef PG8_SCHED
}

__device__ __forceinline__ bool is_rope_tile(int pn) { return pn < 4 || pn == 4 || pn == 6 || pn == 8 || (pn >= 10 && pn < 18); }
__device__ __forceinline__ bool is_q_tile(int pn) { return pn < 4 || (pn >= 10 && pn < 14); }
struct EpiQKV {
    static constexpr bool PERM = true, AFTER_DRAIN = false;
    h16* QKV; float* G; const float* COS; const float* SIN;
    __device__ __forceinline__ void operator()(const f32x4 (&acc)[2][2][4][2], const Unit& u, int wr, int wc, int fr, int fq) const {
        const int pn = u.pn;
        const int row0 = u.pm * BM + wr * 64 + fr;
        if (pn == 22) {
            if (wc == 0 && fq < 3) {
#pragma unroll
                for (int ai = 0; ai < 2; ++ai)
#pragma unroll
                    for (int m = 0; m < 4; ++m) { const int row = row0 + ai * HALF + m * 16; float* gp = G + (size_t)row * 24 + 8 * fq;
                        f32x4 v0 = acc[ai][0][m][0], v1 = acc[ai][0][m][1];
#pragma unroll
                        for (int e = 0; e < 4; ++e) { v0[e] = 1.f / (1.f + __expf(-v0[e])); v1[e] = 1.f / (1.f + __expf(-v1[e])); }
                        *(f32x4*)gp = v0; *(f32x4*)(gp + 4) = v1; }
            }
            return;
        }
        if (is_rope_tile(pn)) {
            const float sc = is_q_tile(pn) ? QSCALE : 1.f;
            const int a4 = 4 * (4 * wc + fq);
#pragma unroll
            for (int ai = 0; ai < 2; ++ai)
#pragma unroll
                for (int m = 0; m < 4; ++m) { const int row = row0 + ai * HALF + m * 16; const int t = row & (SEQ - 1);
                    const f32x4 c4 = *(const f32x4*)(COS + t * 64 + a4), s4 = *(const f32x4*)(SIN + t * 64 + a4);
                    h16* rowp = QKV + (size_t)row * NQKV + pn * BM + a4;
#pragma unroll
                    for (int bj = 0; bj < 2; ++bj) { const f32x4 x1 = acc[ai][bj][m][0], x2 = acc[ai][bj][m][1];
                        const f32x4 o1 = (x1 * c4 - x2 * s4) * sc, o2 = (x2 * c4 + x1 * s4) * sc;
                        u32x2 w1; w1.x = pk2h(o1[0], o1[1]); w1.y = pk2h(o1[2], o1[3]);
                        u32x2 w2; w2.x = pk2h(o2[0], o2[1]); w2.y = pk2h(o2[2], o2[3]);
                        *(u32x2*)(rowp + bj * HALF) = w1; *(u32x2*)(rowp + bj * HALF + 64) = w2; } }
        } else {
            const int col0 = pn * BM + wc * 32 + 8 * fq;
#pragma unroll
            for (int ai = 0; ai < 2; ++ai)
#pragma unroll
                for (int m = 0; m < 4; ++m) { h16* rowp = QKV + (size_t)(row0 + ai * HALF + m * 16) * NQKV + col0;
#pragma unroll
                    for (int bj = 0; bj < 2; ++bj) { const f32x4 v0 = acc[ai][bj][m][0], v1 = acc[ai][bj][m][1];
                        u32x4 w; w.x = pk2h(v0[0], v0[1]); w.y = pk2h(v0[2], v0[3]); w.z = pk2h(v1[0], v1[1]); w.w = pk2h(v1[2], v1[3]);
                        *(u32x4*)(rowp + bj * HALF) = w; } }
        }
    }
};
struct EpiF16SS {
    static constexpr bool PERM = true, AFTER_DRAIN = false;
    h16* C; int ldc; float* SSQ;
    __device__ __forceinline__ void operator()(const f32x4 (&acc)[2][2][4][2], const Unit& u, int wr, int wc, int fr, int fq) const {
        const int row0 = u.pm * BM + wr * 64 + fr, col0 = u.pn * BM + wc * 32 + 8 * fq;
#pragma unroll
        for (int ai = 0; ai < 2; ++ai)
#pragma unroll
            for (int m = 0; m < 4; ++m) { const int row = row0 + ai * HALF + m * 16; h16* rowp = C + (size_t)row * ldc + col0; float s = 0.f;
#pragma unroll
                for (int bj = 0; bj < 2; ++bj) { const f32x4 v0 = acc[ai][bj][m][0], v1 = acc[ai][bj][m][1];
                    s += ((v0[0] * v0[0] + v0[1] * v0[1]) + (v0[2] * v0[2] + v0[3] * v0[3])) + ((v1[0] * v1[0] + v1[1] * v1[1]) + (v1[2] * v1[2] + v1[3] * v1[3]));
                    u32x4 w; w.x = pk2h(v0[0], v0[1]); w.y = pk2h(v0[2], v0[3]); w.z = pk2h(v1[0], v1[1]); w.w = pk2h(v1[2], v1[3]);
                    *(u32x4*)(rowp + bj * HALF) = w; }
                s += __shfl_xor(s, 16); s += __shfl_xor(s, 32);
                if (fq == 0) SSQ[(size_t)row * 32 + u.pn * 4 + wc] = s; }
    }
};
struct EpiRelu2 {
    static constexpr bool PERM = true, AFTER_DRAIN = false;
    h16* O; int ldc;
    __device__ __forceinline__ void operator()(const f32x4 (&acc)[2][2][4][2], const Unit& u, int wr, int wc, int fr, int fq) const {
        const int row0 = u.pm * BM + wr * 64 + fr, col0 = u.pn * BM + wc * 32 + 8 * fq;
#pragma unroll
        for (int ai = 0; ai < 2; ++ai)
#pragma unroll
            for (int m = 0; m < 4; ++m) { h16* rowp = O + (size_t)(row0 + ai * HALF + m * 16) * ldc + col0;
#pragma unroll
                for (int bj = 0; bj < 2; ++bj) { f32x4 v0 = acc[ai][bj][m][0], v1 = acc[ai][bj][m][1];
#pragma unroll
                    for (int e = 0; e < 4; ++e) { const float a = fmaxf(v0[e], 0.f), b = fmaxf(v1[e], 0.f); v0[e] = a * a; v1[e] = b * b; }
                    u32x4 w; w.x = pk2h(v0[0], v0[1]); w.y = pk2h(v0[2], v0[3]); w.z = pk2h(v1[0], v1[1]); w.w = pk2h(v1[2], v1[3]);
                    { const h16* sp_ = rowp + bj * HALF; asm volatile("global_store_dwordx4 %0, %1, off sc0 sc1\n\ts_nop 2" :: "v"(sp_), "v"(w) : "memory"); } } }
    }
};
__device__ __forceinline__ void row_exchange(const f32x4 (&acc)[2][2][4][2], float* X8, unsigned* cntw, const Unit& u, LAS unsigned char* lds, int wid, int lane, int wr, int wc, int fr, int fq) {
        LAS float* P = (LAS float*)(lds + 4096);
        LAS float* S = (LAS float*)lds;
#pragma unroll
        for (int ai = 0; ai < 2; ++ai)
#pragma unroll
            for (int m = 0; m < 4; ++m) { float s = 0.f;
#pragma unroll
                for (int bj = 0; bj < 2; ++bj) { const f32x4 v0 = acc[ai][bj][m][0], v1 = acc[ai][bj][m][1];
                    s += ((v0[0] * v0[0] + v0[1] * v0[1]) + (v0[2] * v0[2] + v0[3] * v0[3])) + ((v1[0] * v1[0] + v1[1] * v1[1]) + (v1[2] * v1[2] + v1[3] * v1[3])); }
                s += __shfl_xor(s, 16); s += __shfl_xor(s, 32);
                if (fq == 0) P[(ai * HALF + wr * 64 + m * 16 + fr) * 4 + wc] = s; }
        asm volatile("s_waitcnt lgkmcnt(0)" ::: "memory"); __builtin_amdgcn_s_barrier(); asm volatile("" ::: "memory");
        if (lane < 32) { const f32x4 p4 = *(const LAS f32x4*)(P + (wid * 32 + lane) * 4);
            __hip_atomic_store((unsigned*)X8 + (size_t)(u.pm * BM + wid * 32 + lane) * 8 + u.pn, __float_as_uint((p4[0] + p4[1]) + (p4[2] + p4[3])), __ATOMIC_RELAXED, __HIP_MEMORY_SCOPE_AGENT); }
        asm volatile("s_waitcnt vmcnt(0)" ::: "memory");
        if (lane == 0) __hip_atomic_fetch_add(cntw, 1u, __ATOMIC_RELAXED, __HIP_MEMORY_SCOPE_AGENT);
        if (wid == 0) { unsigned sp = 0u;
            while ((unsigned)__builtin_amdgcn_readfirstlane((int)__hip_atomic_load(cntw, __ATOMIC_RELAXED, __HIP_MEMORY_SCOPE_AGENT)) < 64u) { __builtin_amdgcn_s_sleep(1); if (++sp > (1u << 22)) break; }
            __builtin_amdgcn_fence(__ATOMIC_ACQUIRE, "agent"); }
        asm volatile("s_waitcnt vmcnt(0) lgkmcnt(0)" ::: "memory"); __builtin_amdgcn_s_barrier(); asm volatile("" ::: "memory");
        { const float* p = X8 + (size_t)(u.pm * BM + wid * 32 + (lane & 31)) * 8 + (lane >> 5) * 4; f32x4 q0;
            asm volatile("global_load_dwordx4 %0, %1, off sc1\n\ts_waitcnt vmcnt(0)" : "=&v"(q0) : "v"(p) : "memory");
            float ts = (q0[0] + q0[1]) + (q0[2] + q0[3]); ts += __shfl_xor(ts, 32);
            if (lane < 32) S[wid * 32 + lane] = 1.f / sqrtf(ts * (1.f / DM) + EPS); }
        asm volatile("s_waitcnt lgkmcnt(0)" ::: "memory"); __builtin_amdgcn_s_barrier(); asm volatile("" ::: "memory");
}
struct EpiNormOut {
    static constexpr bool PERM = true, AFTER_DRAIN = true;
    const h16* X1; float* OUT; float* SSQ; unsigned* cnt; const float* gpost; const float* gatef;
    __device__ __forceinline__ void fused(const f32x4 (&acc)[2][2][4][2], const Unit& u, int, int, int, int, LAS unsigned char* lds, int, int) const {
        int tid = threadIdx.x; asm volatile("" : "+v"(tid));
        const int wid = __builtin_amdgcn_readfirstlane(tid >> 6), lane = tid & 63, wr = wid >> 2, wc = wid & 3, fr = lane & 15, fq = lane >> 4;
        const int row0 = u.pm * BM + wr * 64 + fr, col0 = u.pn * BM + wc * 32 + 8 * fq;
        row_exchange(acc, SSQ, cnt + 64 * u.pm, u, lds, wid, lane, wr, wc, fr, fq);
        const LAS float* S = (const LAS float*)lds;
        u32x4 xr[2][4][2];
#pragma unroll
        for (int m = 0; m < 4; ++m)
#pragma unroll
            for (int bj = 0; bj < 2; ++bj) xr[0][m][bj] = __builtin_nontemporal_load((const u32x4*)(X1 + ((unsigned)(row0 * DM + col0) + (unsigned)(m * 16 * DM + bj * HALF))));
#pragma unroll
        for (int m = 0; m < 4; ++m)
#pragma unroll
            for (int bj = 0; bj < 2; ++bj) xr[1][m][bj] = __builtin_nontemporal_load((const u32x4*)(X1 + ((unsigned)(row0 * DM + col0) + (unsigned)((HALF + m * 16) * DM + bj * HALF))));
        const float* gfb = gatef + (size_t)(u.pm >> 4) * 6 * DM;
        f32x4 cf[2][2];
#pragma unroll
        for (int bj = 0; bj < 2; ++bj)
#pragma unroll
            for (int n = 0; n < 2; ++n) cf[bj][n] = *(const f32x4*)(gpost + col0 + bj * HALF + 4 * n) * *(const f32x4*)(gfb + col0 + bj * HALF + 4 * n);
        const unsigned eo = (unsigned)(row0 * DM + col0);
#pragma unroll
        for (int ai = 0; ai < 2; ++ai)
#pragma unroll
            for (int m = 0; m < 4; ++m) { const float rstd = S[ai * HALF + wr * 64 + m * 16 + fr]; const unsigned o = eo + (unsigned)((ai * HALF + m * 16) * DM);
#pragma unroll
                for (int bj = 0; bj < 2; ++bj) { u32x4 xw = xr[ai][m][bj]; asm volatile("" : "+v"(xw));
                    const f32x4 x0 = unpack4h((u32x2){xw[0], xw[1]}), x1 = unpack4h((u32x2){xw[2], xw[3]});
                    __builtin_nontemporal_store(x0 + cf[bj][0] * (acc[ai][bj][m][0] * rstd), (f32x4*)(OUT + o + bj * HALF));
                    __builtin_nontemporal_store(x1 + cf[bj][1] * (acc[ai][bj][m][1] * rstd), (f32x4*)(OUT + o + bj * HALF + 4)); }
                asm volatile("" ::: "memory"); }
    }
};
struct EpiNormResNorm {
    static constexpr bool PERM = true, AFTER_DRAIN = true;
    const float* X; h16* X1; h16* H; float* SSQa; float* SSQb; unsigned* cnta; unsigned* cntb; const float* gpost; const float* gpre; const float* mod;
    __device__ __forceinline__ void fused(f32x4 (&acc)[2][2][4][2], const Unit& u, int, int, int, int, LAS unsigned char* lds, int, int) const {
        int tid = threadIdx.x; asm volatile("" : "+v"(tid));
        const int wid = __builtin_amdgcn_readfirstlane(tid >> 6), lane = tid & 63, wr = wid >> 2, wc = wid & 3, fr = lane & 15, fq = lane >> 4;
        const int row0 = u.pm * BM + wr * 64 + fr, col0 = u.pn * BM + wc * 32 + 8 * fq;
        const unsigned eo = (unsigned)(row0 * DM + col0);
        const float* mb = mod + (size_t)(u.pm >> 4) * 6 * DM;
        const LAS float* S = (const LAS float*)lds;
        row_exchange(acc, SSQa, cnta + 64 * u.pm, u, lds, wid, lane, wr, wc, fr, fq);
        { f32x4 cf[2][2];
#pragma unroll
          for (int bj = 0; bj < 2; ++bj)
#pragma unroll
            for (int n = 0; n < 2; ++n) cf[bj][n] = *(const f32x4*)(gpost + col0 + bj * HALF + 4 * n) * *(const f32x4*)(mb + 2 * DM + col0 + bj * HALF + 4 * n);
#pragma unroll
          for (int ai = 0; ai < 2; ++ai) { f32x4 xv[4][2][2];
#pragma unroll
            for (int m = 0; m < 4; ++m)
#pragma unroll
                for (int bj = 0; bj < 2; ++bj)
#pragma unroll
                    for (int n = 0; n < 2; ++n) xv[m][bj][n] = __builtin_nontemporal_load((const f32x4*)(X + (eo + (unsigned)((ai * HALF + m * 16) * DM + bj * HALF + 4 * n))));
#pragma unroll
            for (int m = 0; m < 4; ++m) { const float rstd = S[ai * HALF + wr * 64 + m * 16 + fr]; const unsigned o = eo + (unsigned)((ai * HALF + m * 16) * DM);
#pragma unroll
                for (int bj = 0; bj < 2; ++bj) { f32x4 x0 = xv[m][bj][0], x1 = xv[m][bj][1]; asm volatile("" : "+v"(x0), "+v"(x1));
                    const f32x4 v0 = x0 + cf[bj][0] * (acc[ai][bj][m][0] * rstd), v1 = x1 + cf[bj][1] * (acc[ai][bj][m][1] * rstd);
                    acc[ai][bj][m][0] = v0; acc[ai][bj][m][1] = v1;
                    u32x4 w; w.x = pk2h(v0[0], v0[1]); w.y = pk2h(v0[2], v0[3]); w.z = pk2h(v1[0], v1[1]); w.w = pk2h(v1[2], v1[3]);
                    *(u32x4*)(X1 + o + bj * HALF) = w; }
                asm volatile("" ::: "memory"); } } }
        row_exchange(acc, SSQb, cntb + 64 * u.pm, u, lds, wid, lane, wr, wc, fr, fq);
        { f32x4 ca[2][2], cs[2][2];
#pragma unroll
          for (int bj = 0; bj < 2; ++bj)
#pragma unroll
            for (int n = 0; n < 2; ++n) { const int c = col0 + bj * HALF + 4 * n; ca[bj][n] = *(const f32x4*)(gpre + c) * (*(const f32x4*)(mb + 4 * DM + c) + 1.f); cs[bj][n] = *(const f32x4*)(mb + 3 * DM + c); }
#pragma unroll
          for (int ai = 0; ai < 2; ++ai)
#pragma unroll
            for (int m = 0; m < 4; ++m) { const float rstd = S[ai * HALF + wr * 64 + m * 16 + fr]; const unsigned o = eo + (unsigned)((ai * HALF + m * 16) * DM);
#pragma unroll
                for (int bj = 0; bj < 2; ++bj) { const f32x4 y0 = (acc[ai][bj][m][0] * rstd) * ca[bj][0] + cs[bj][0], y1 = (acc[ai][bj][m][1] * rstd) * ca[bj][1] + cs[bj][1];
                    u32x4 w; w.x = pk2h(y0[0], y0[1]); w.y = pk2h(y0[2], y0[3]); w.z = pk2h(y1[0], y1[1]); w.w = pk2h(y1[2], y1[3]);
                    *(u32x4*)(H + o + bj * HALF) = w; }
                asm volatile("" ::: "memory"); } }
    }
};
}

#define XB_TMO      128
#define XB_XCNT(j)  (256  + 64 * (j))
#define XB_XSUB(j)  (1280 + 64 * (j))
#define XB_XGEN(j)  (2304 + 64 * (j))
#define XB_TOP      3328
#define XB_TOPGEN   3392
#define XCD_BAR_WORDS 3456
#define XB_SPIN_CAP (1u << 20)
__device__ __forceinline__ unsigned xb_ld(unsigned* p)              { return __hip_atomic_load(p, __ATOMIC_RELAXED, __HIP_MEMORY_SCOPE_AGENT); }
__device__ __forceinline__ unsigned xb_add(unsigned* p, unsigned v) { return __hip_atomic_fetch_add(p, v, __ATOMIC_RELAXED, __HIP_MEMORY_SCOPE_AGENT); }
__device__ __forceinline__ unsigned xb_xcc_id() { return (unsigned)__builtin_amdgcn_s_getreg((3 << 11) | 20) & 0xFu; }
#define XB_SPIN(cond, bar) do { unsigned _sp = 0; while (cond) { __builtin_amdgcn_s_sleep(1); \
    if ((++_sp & 255u) == 0u) { if (xb_ld(&(bar)[XB_TMO])) break; if (_sp > XB_SPIN_CAP) { atomicAdd(&(bar)[XB_TMO], 1u); break; } } } } while (0)
struct XcdBarrier { unsigned* bar; unsigned x; volatile LAS unsigned* st; };
__device__ __forceinline__ XcdBarrier xcd_barrier_post(unsigned* bar, volatile LAS unsigned* st) {
    XcdBarrier b; b.bar = bar; b.x = xb_xcc_id(); b.st = st;
    if (threadIdx.x == 0) (void)xb_add(&bar[XB_XCNT(b.x)], 1u);
    return b;
}
__device__ __forceinline__ void xcd_barrier_complete(unsigned* bar, unsigned x, unsigned& nloc, unsigned& nx) {
    const unsigned G = gridDim.x * gridDim.y * gridDim.z;
    unsigned sum, cnt, mine, sp = 0u;
    for (;;) {
        sum = 0u; cnt = 0u; mine = 0u;
#pragma unroll
        for (unsigned j = 0; j < 16; ++j) { const unsigned c = xb_ld(&bar[XB_XCNT(j)]); sum += c; cnt += (c > 0u) ? 1u : 0u; mine = (j == x) ? c : mine; }
        if (sum == G) break;
        __builtin_amdgcn_s_sleep(1);
        if ((++sp & 255u) == 0u) { if (xb_ld(&bar[XB_TMO])) break; if (sp > XB_SPIN_CAP) { atomicAdd(&bar[XB_TMO], 1u); break; } }
    }
    nloc = mine > 0u ? mine : 1u; nx = cnt > 0u ? cnt : 1u;
}
__device__ __forceinline__ void xcd_barrier(const XcdBarrier& b) {
    asm volatile("s_waitcnt vmcnt(0)" ::: "memory");
    __syncthreads();
    if (threadIdx.x == 0) {
        unsigned* bar = b.bar;
        __builtin_amdgcn_s_waitcnt(0);
        unsigned nloc = b.st[0], nx = b.st[1];
        if (nloc == 0u) { xcd_barrier_complete(bar, b.x, nloc, nx); b.st[0] = nloc; b.st[1] = nx; }
        const unsigned old = xb_add(&bar[XB_XSUB(b.x)], 1u);
        const unsigned gen = old / nloc;
        if (old + 1u == (gen + 1u) * nloc) {
            __builtin_amdgcn_fence(__ATOMIC_RELEASE, "agent");
            asm volatile("s_waitcnt vmcnt(0)" ::: "memory");
            const unsigned og = xb_add(&bar[XB_TOP], 1u);
            const unsigned tg = og / nx;
            if (og + 1u == (tg + 1u) * nx) xb_add(&bar[XB_TOPGEN], 1u);
            else XB_SPIN(xb_ld(&bar[XB_TOPGEN]) == tg, bar);
            __builtin_amdgcn_fence(__ATOMIC_ACQUIRE, "agent");
            xb_add(&bar[XB_XGEN(b.x)], 1u);
            asm volatile("s_waitcnt vmcnt(0)" ::: "memory");
        } else {
            XB_SPIN(xb_ld(&bar[XB_XGEN(b.x)]) == gen, bar);
            __builtin_amdgcn_fence(__ATOMIC_ACQUIRE, "agent");
            asm volatile("s_waitcnt vmcnt(0)" ::: "memory");
        }
    }
    __syncthreads();
}

constexpr int RING_BYTES = 131072;
constexpr int LDSCTL_OFF = 143360;
constexpr int LDS_BYTES = 147456;
constexpr int NWAVES = 8;
#ifndef T_IN_P4
#define T_IN_P4 1
#endif
constexpr int NT_GV = (T_IN_P4 && GV_Q) ? 256 : 0, NT_ITEMS = T_IN_P4 ? 576 + NT_GV : 0, NQ_TOTAL = 512 + NT_ITEMS, NQ_MAX = 1088;

struct Args { const float* in[18]; float* out; unsigned char* ws; int ph_lo, ph_hi; unsigned short order[NQ_MAX]; };

__device__ __forceinline__ float wave_sum(float v) {
#pragma unroll
    for (int o = 1; o < 64; o <<= 1) v += __shfl_xor(v, o);
    return v;
}
__device__ __forceinline__ float silu_f(float v) { return v / (1.f + __expf(-v)); }

__device__ __forceinline__ int win_src_col(int n) {
    if (n >= NQKV) { const int k = n - NQKV; return k < 24 ? 2560 + k : -1; }
    const int pn = n >> 8; int j = n & 127; const int hb = n & ~127;
    if (pg8::is_rope_tile(pn)) { const int a = j >> 3, b = j & 7; j = (b < 4) ? 4 * a + b : 64 + 4 * a + (b - 4); }
    return hb + j + (n >= 2560 ? 24 : 0);
}
__device__ __forceinline__ void transpose_item64(const float* W, int ldw, int K, h16* WT, int k0, int n0, int src4, int dl, LAS float* scr, int lane) {
    const int kk = lane >> 4;
    f32x4 v[16];
#pragma unroll
    for (int i = 0; i < 16; ++i) v[i] = src4 >= 0 ? *(const f32x4*)(W + (size_t)(k0 + 4 * i + kk) * ldw + src4) : (f32x4){0.f, 0.f, 0.f, 0.f};
#pragma unroll
    for (int i = 0; i < 16; ++i) { LAS float* p = scr + (4 * i + kk) * 65 + dl; p[0] = v[i].x; p[1] = v[i].y; p[2] = v[i].z; p[3] = v[i].w; }
    asm volatile("s_waitcnt lgkmcnt(0)" ::: "memory");
    const int c = lane & 7;
#pragma unroll
    for (int j = 0; j < 8; ++j) { const int n = (lane >> 3) + 8 * j; const LAS float* sp = scr + (8 * c) * 65 + n;
        u32x4 o; o.x = pk2h(sp[0 * 65], sp[1 * 65]); o.y = pk2h(sp[2 * 65], sp[3 * 65]); o.z = pk2h(sp[4 * 65], sp[5 * 65]); o.w = pk2h(sp[6 * 65], sp[7 * 65]);
        *(u32x4*)(WT + (size_t)(n0 + n) * K + k0 + 8 * c) = o; }
    asm volatile("s_waitcnt lgkmcnt(0)" ::: "memory");
}
template <bool NTL = false>
__device__ __forceinline__ void transpose_item128(const float* W, int ldw, int K, h16* WT, int k0, int n0, int src4, int dl, LAS float* scr, int lane) {
    const int kk = lane >> 4;
    f32x4 v[32];
#pragma unroll
    for (int i = 0; i < 32; ++i) { const f32x4* p = (const f32x4*)(W + (size_t)(k0 + 4 * i + kk) * ldw + src4); v[i] = src4 >= 0 ? (NTL ? __builtin_nontemporal_load(p) : *p) : (f32x4){0.f, 0.f, 0.f, 0.f}; }
    const int c = lane & 7;
#pragma unroll
    for (int hpass = 0; hpass < 2; ++hpass) {
#pragma unroll
        for (int i = 0; i < 16; ++i) { LAS float* p = scr + (4 * i + kk) * 65 + dl; const f32x4 x = v[16 * hpass + i]; p[0] = x.x; p[1] = x.y; p[2] = x.z; p[3] = x.w; }
        asm volatile("s_waitcnt lgkmcnt(0)" ::: "memory");
#pragma unroll
        for (int j = 0; j < 8; ++j) { const int n = (lane >> 3) + 8 * j; const LAS float* sp = scr + (8 * c) * 65 + n;
            u32x4 o; o.x = pk2h(sp[0 * 65], sp[1 * 65]); o.y = pk2h(sp[2 * 65], sp[3 * 65]); o.z = pk2h(sp[4 * 65], sp[5 * 65]); o.w = pk2h(sp[6 * 65], sp[7 * 65]);
            *(u32x4*)(WT + (size_t)(n0 + n) * K + k0 + 64 * hpass + 8 * c) = o; }
        asm volatile("s_waitcnt lgkmcnt(0)" ::: "memory");
    }
}
__device__ __forceinline__ void win_map64(int n0, int q, int& src4, int& dl) {
    if (n0 >= NQKV) { const int k = n0 - NQKV + 4 * q; src4 = (k + 4 <= 24) ? 2560 + k : -1; dl = 4 * q; return; }
    const int pn = n0 >> 8, hb = n0 & ~127, j0 = n0 & 127, add = n0 >= 2560 ? 24 : 0;
    if (pg8::is_rope_tile(pn)) { if (q < 8) { src4 = hb + (j0 >> 1) + 4 * q + add; dl = 8 * q; } else { src4 = hb + 64 + (j0 >> 1) + 4 * (q - 8) + add; dl = 8 * (q - 8) + 4; } }
    else { src4 = n0 + 4 * q + add; dl = 4 * q; }
}

__device__ __forceinline__ void gemv_half(const float* c_in, const float* w_ada, const float* b_ada, float* mod, int cch, int k32, int lane) {
    const int col = cch * 256 + lane * 4; const int kb = k32 * 32;
    const int s0v = __float_as_int(silu_f(c_in[kb + (lane & 31)])), s1v = __float_as_int(silu_f(c_in[DM + kb + (lane & 31)]));
    const float* wp = w_ada + (size_t)kb * (6 * DM) + col;
    f32x4 w[32];
#pragma unroll
    for (int k = 0; k < 32; ++k) w[k] = __builtin_nontemporal_load((const f32x4*)(wp + (size_t)k * (6 * DM)));
    f32x4 a0 = {0.f, 0.f, 0.f, 0.f}, a1 = {0.f, 0.f, 0.f, 0.f};
#pragma unroll
    for (int k = 0; k < 32; ++k) { const float s0 = __int_as_float(__builtin_amdgcn_readlane(s0v, k)), s1 = __int_as_float(__builtin_amdgcn_readlane(s1v, k)); a0 += w[k] * s0; a1 += w[k] * s1; }
    if (k32 == 0) { const f32x4 bv = *(const f32x4*)(b_ada + col); a0 += bv; a1 += bv; }
#pragma unroll
    for (int e = 0; e < 4; ++e) { atomicAdd(mod + col + e, a0[e]); atomicAdd(mod + 6 * DM + col + e, a1[e]); }
}

__device__ __forceinline__ void p0_prologue(const Args& A, LAS unsigned char* lds, int gw, int NGW, int wave, int lane, int rep) {
    unsigned char* ws = A.ws;
    LAS float* scr = (LAS float*)(lds + wave * 16640);
    const float* c_in = A.in[1]; const float* w_ada = A.in[2]; const float* b_ada = A.in[3];
    float* mod = (float*)(ws + WS_MOD); float* posb = (float*)(ws + WS_POSB);
    constexpr int I_GEMV = 48 * 32;
    constexpr int I_DN = (DFF / 128) * (DM / 64), I_UP = (DM / 128) * (DFF / 64), I_IN = (DM / 128) * (NPAD / 64), I_O = (DM / 128) * (DM / 64);
    constexpr int I_W1 = 2 * (4096 / 64) * (128 / 64), I_W2 = 2 * (128 / 64) * (128 / 64), I_ROPE = 4096, I_POSB = 256, I_KMZ = 32;
    constexpr int NITEMS = I_GEMV + (T_IN_P4 ? 0 : I_DN + I_UP + I_O) + I_IN + I_W1 + I_W2 + I_ROPE + I_POSB + I_KMZ;
    const int q16 = lane & 15;
    const bool bal = P0_BAL && T_IN_P4 && NGW == 2048 && rep == 0;
    if (bal && GV_Q) {
        int wi = -1;
        if (gw < 1024) { gemv_half(c_in, w_ada, b_ada, mod, gw & 15, gw >> 4, lane); if (gw < I_IN - 1024) wi = 1024 + gw; } else wi = gw - 1024;
        if (wi >= 0) { const int nblk = NPAD / 64, kb = wi / nblk, nb = wi % nblk; int src4, dl; win_map64(64 * nb, q16, src4, dl); transpose_item128<true>(A.in[6], INCOLS, DM, (h16*)(ws + WS_WIN), 128 * kb, 64 * nb, src4, dl, scr, lane); }
    } else if (bal) {
        if (gw < I_IN) { gemv_half(c_in, w_ada, b_ada, mod, gw % 48, gw / 48, lane);
            const int nblk = NPAD / 64, kb = gw / nblk, nb = gw % nblk; int src4, dl; win_map64(64 * nb, q16, src4, dl); transpose_item128<true>(A.in[6], INCOLS, DM, (h16*)(ws + WS_WIN), 128 * kb, 64 * nb, src4, dl, scr, lane); }
        else {
#pragma unroll 1
            for (int h = gw; h < 2 * I_GEMV; h += 2048 - I_IN) gemv_half(c_in, w_ada, b_ada, mod, h % 48, h / 48, lane); }
    }
    for (int it = gw + (bal ? I_GEMV + I_IN : 0); it < NITEMS; it += NGW) {
        int r = it;
        if (r < I_GEMV) {
            const int cch = r % 48, kch = r / 48; const int col = cch * 256 + lane * 4; const int kb = kch * 64;
            if (GV_Q && T_IN_P4 && cch >= 16) continue;
            f32x4 a0 = {0.f, 0.f, 0.f, 0.f}, a1 = {0.f, 0.f, 0.f, 0.f};
#pragma unroll 16
            for (int k = 0; k < 64; ++k) { const float s0 = silu_f(c_in[kb + k]), s1 = silu_f(c_in[DM + kb + k]);
                const f32x4 w = __builtin_nontemporal_load((const f32x4*)(w_ada + (size_t)(kb + k) * (6 * DM) + col)); a0 += w * s0; a1 += w * s1; }
            if (kch == 0) { const f32x4 bv = *(const f32x4*)(b_ada + col); a0 += bv; a1 += bv; }
#pragma unroll
            for (int e = 0; e < 4; ++e) { atomicAdd(mod + rep * 24576 + col + e, a0[e]); atomicAdd(mod + rep * 24576 + 6 * DM + col + e, a1[e]); }
            continue; }
        r -= I_GEMV;
        if (!T_IN_P4 && r < I_DN) { const int nblk = DM / 64, kb = r / nblk, nb = r % nblk; transpose_item128(A.in[17], DM, DFF, (h16*)(ws + WS_WDN), 128 * kb, 64 * nb, 64 * nb + 4 * q16, 4 * q16, scr, lane); continue; }
        if (!T_IN_P4) r -= I_DN;
        if (!T_IN_P4 && r < I_UP) { const int nblk = DFF / 64, kb = r / nblk, nb = r % nblk; transpose_item128(A.in[16], DFF, DM, (h16*)(ws + WS_WUP), 128 * kb, 64 * nb, 64 * nb + 4 * q16, 4 * q16, scr, lane); continue; }
        if (!T_IN_P4) r -= I_UP;
        if (r < I_IN) { const int nblk = NPAD / 64, kb = r / nblk, nb = r % nblk; int src4, dl; win_map64(64 * nb, q16, src4, dl); transpose_item128<true>(A.in[6], INCOLS, DM, (h16*)(ws + WS_WIN), 128 * kb, 64 * nb, src4, dl, scr, lane); continue; }
        r -= I_IN;
        if (!T_IN_P4 && r < I_O) { const int nblk = DM / 64, kb = r / nblk, nb = r % nblk; transpose_item128(A.in[13], DM, DM, (h16*)(ws + WS_WO), 128 * kb, 64 * nb, 64 * nb + 4 * q16, 4 * q16, scr, lane); continue; }
        if (!T_IN_P4) r -= I_O;
        if (r < I_W1) { const int kv = r / 128, q = r % 128, kb = q / 2, nb = q % 2; transpose_item64(A.in[kv ? 11 : 8], 128, 4096, (h16*)(ws + WS_W1T) + (size_t)kv * 128 * 4096, 64 * kb, 64 * nb, 64 * nb + 4 * q16, 4 * q16, scr, lane); continue; }
        r -= I_W1;
        if (r < I_W2) { const int kv = r / 4, q = r % 4, kb = q / 2, nb = q % 2; transpose_item64(A.in[kv ? 12 : 9], 128, 128, (h16*)(ws + WS_W2T) + (size_t)kv * 128 * 128, 64 * kb, 64 * nb, 64 * nb + 4 * q16, 4 * q16, scr, lane); continue; }
        r -= I_W2;
        if (r < I_POSB) { const int kv = r / 128, kc = r % 128; const float* pos = A.in[kv ? 10 : 7]; const float* w1 = A.in[kv ? 11 : 8];
            f32x2 wv[32];
#pragma unroll
            for (int k = 0; k < 32; ++k) wv[k] = *(const f32x2*)(w1 + (size_t)(kc * 32 + k) * 128 + 2 * lane);
            const int pl = __float_as_int(pos[kc * 32 + (lane & 31)]);
            f32x2 a = {0.f, 0.f};
#pragma unroll
            for (int k = 0; k < 32; ++k) a += wv[k] * __int_as_float(__builtin_amdgcn_readlane(pl, k));
            atomicAdd(posb + rep * 256 + kv * 128 + 2 * lane, a.x); atomicAdd(posb + rep * 256 + kv * 128 + 2 * lane + 1, a.y);
            continue; }
        r -= I_POSB;
        if (r < I_KMZ) { u32x4 z = {0u, 0u, 0u, 0u}; u32x4* p = (u32x4*)(ws + WS_KMEAN + (size_t)r * 4096);
#pragma unroll
          for (int q = 0; q < 4; ++q) p[q * 64 + lane] = z;
          continue; }
        r -= I_KMZ;
        { float* COS = (float*)(ws + WS_COS); float* SIN = (float*)(ws + WS_SIN);
            { const int e = r * 64 + lane; const int t = e >> 6, i = e & 63;
              const float inv = powf(10000.f, -(float)(2 * i) / 128.f); const float ang = (float)t * inv; COS[e] = cosf(ang); SIN[e] = sinf(ang); } }
    }
}

__device__ __forceinline__ void p1_rows(const Args& A, int gw, int NGW, int lane) {
    const float* x = A.in[0]; const float* g1 = A.in[4]; const float* mod = (const float*)(A.ws + WS_MOD); h16* H = (h16*)(A.ws + WS_H);
    for (int row = gw; row < M; row += NGW) {
        const int b = row >> 12; const f32x4* xr = (const f32x4*)(x + (size_t)row * DM) + lane;
        f32x4 v[8]; float s = 0.f;
#pragma unroll
        for (int j = 0; j < 8; ++j) { v[j] = __builtin_nontemporal_load(xr + 64 * j); s += (v[j].x * v[j].x + v[j].y * v[j].y) + (v[j].z * v[j].z + v[j].w * v[j].w); }
        const float rstd = 1.f / sqrtf(wave_sum(s) * (1.f / DM) + EPS);
        u32x2* o8 = (u32x2*)(H + (size_t)row * DM) + lane;
#pragma unroll
        for (int j = 0; j < 8; ++j) { const int col = 4 * lane + 256 * j;
            const f32x4 g = *(const f32x4*)(g1 + col), sh = *(const f32x4*)(mod + b * 6 * DM + col), sc = *(const f32x4*)(mod + b * 6 * DM + DM + col);
            const f32x4 y = (v[j] * rstd * g) * (sc + 1.f) + sh;
            u32x2 w; w.x = pk2h(y.x, y.y); w.y = pk2h(y.z, y.w); o8[64 * j] = w; }
    }
}
__device__ __forceinline__ void p6_rows(const Args& A, int gw, int NGW, int lane) {
    const float* x = A.in[0]; const float* gpost = A.in[5]; const float* gpre = A.in[14]; const float* mod = (const float*)(A.ws + WS_MOD);
    const h16* OP = (const h16*)(A.ws + WS_OP); const float* SSQ = (const float*)(A.ws + WS_SSQ); h16* H = (h16*)(A.ws + WS_H); h16* X1 = (h16*)(A.ws + WS_X1);
    for (int row0 = gw; row0 < M; row0 += 2 * NGW) {
        f32x4 v[2][8]; u32x2 opv[2][8]; float ssp[2];
#pragma unroll
        for (int q = 0; q < 2; ++q) { const int row = row0 + q * NGW;
            ssp[q] = lane < 32 ? SSQ[(size_t)row * 32 + lane] : 0.f;
            const f32x4* xr = (const f32x4*)(x + (size_t)row * DM) + lane; const u32x2* opr = (const u32x2*)(OP + (size_t)row * DM) + lane;
#pragma unroll
            for (int j = 0; j < 8; ++j) { v[q][j] = xr[64 * j]; opv[q][j] = opr[64 * j]; } }
#pragma unroll
        for (int q = 0; q < 2; ++q) { const int row = row0 + q * NGW; const int b = row >> 12; const float* mb = mod + b * 6 * DM;
            const float rstd = 1.f / sqrtf(wave_sum(ssp[q]) * (1.f / DM) + EPS); float s = 0.f;
#pragma unroll
            for (int j = 0; j < 8; ++j) { const int col = 4 * lane + 256 * j;
                const f32x4 g = *(const f32x4*)(gpost + col), gm = *(const f32x4*)(mb + 2 * DM + col);
                v[q][j] = v[q][j] + gm * (unpack4h(opv[q][j]) * rstd * g);
                s += (v[q][j].x * v[q][j].x + v[q][j].y * v[q][j].y) + (v[q][j].z * v[q][j].z + v[q][j].w * v[q][j].w); }
            const float rstd2 = 1.f / sqrtf(wave_sum(s) * (1.f / DM) + EPS);
            u32x2* x1r = (u32x2*)(X1 + (size_t)row * DM) + lane; u32x2* o8 = (u32x2*)(H + (size_t)row * DM) + lane;
#pragma unroll
            for (int j = 0; j < 8; ++j) { const int col = 4 * lane + 256 * j;
                { u32x2 w1; w1.x = pk2h(v[q][j].x, v[q][j].y); w1.y = pk2h(v[q][j].z, v[q][j].w); x1r[64 * j] = w1; }
                const f32x4 g = *(const f32x4*)(gpre + col), sh = *(const f32x4*)(mb + 3 * DM + col), sc = *(const f32x4*)(mb + 4 * DM + col);
                const f32x4 y = (v[q][j] * rstd2 * g) * (sc + 1.f) + sh;
                u32x2 w; w.x = pk2h(y.x, y.y); w.y = pk2h(y.z, y.w); o8[64 * j] = w; } }
    }
}
__device__ __forceinline__ void p9_rows(const Args& A, int gw, int NGW, int lane) {
    const float* gpost = A.in[15]; const float* mod = (const float*)(A.ws + WS_MOD);
    const h16* F = (const h16*)(A.ws + WS_F); const float* SSQ = (const float*)(A.ws + WS_SSQ); const h16* X1 = (const h16*)(A.ws + WS_X1); float* OUT = A.out;
    for (int row0 = gw; row0 < M; row0 += 2 * NGW) {
        u32x2 xv[2][8], fv[2][8]; float ssp[2];
#pragma unroll
        for (int q = 0; q < 2; ++q) { const int row = row0 + q * NGW;
            ssp[q] = lane < 32 ? SSQ[(size_t)row * 32 + lane] : 0.f;
            const u32x2* x1r = (const u32x2*)(X1 + (size_t)row * DM) + lane; const u32x2* fr = (const u32x2*)(F + (size_t)row * DM) + lane;
#pragma unroll
            for (int j = 0; j < 8; ++j) { xv[q][j] = x1r[64 * j]; fv[q][j] = fr[64 * j]; } }
#pragma unroll
        for (int q = 0; q < 2; ++q) { const int row = row0 + q * NGW; const int b = row >> 12; const float* mb = mod + b * 6 * DM;
            const float rstd = 1.f / sqrtf(wave_sum(ssp[q]) * (1.f / DM) + EPS);
            f32x4* outr = (f32x4*)(OUT + (size_t)row * DM) + lane;
#pragma unroll
            for (int j = 0; j < 8; ++j) { const int col = 4 * lane + 256 * j;
                const f32x4 g = *(const f32x4*)(gpost + col), gf = *(const f32x4*)(mb + 5 * DM + col);
                outr[64 * j] = unpack4h(xv[q][j]) + gf * (unpack4h(fv[q][j]) * rstd * g); } }
    }
}

__device__ __forceinline__ void p3_compress_item(const Args& A, LAS unsigned char* lds, int item, int wave, int lane) {
    const int kv = item >> 6, b = (item >> 5) & 1, g = (item >> 4) & 1, rt = item & 15;
    const h16* QKV = (const h16*)(A.ws + WS_QKV); const h16* W1T = (const h16*)(A.ws + WS_W1T) + (size_t)kv * 128 * 4096;
    const h16* W2T = (const h16*)(A.ws + WS_W2T) + (size_t)kv * 128 * 128; const float* posb = (const float*)(A.ws + WS_POSB) + kv * 128;
    h16* OUT = (h16*)(A.ws + WS_KC) + ((size_t)((kv * 2 + b) * 2 + g) * 256) * 128;
    const int colbase = (kv ? C_VCMP : C_KCMP) + g * 128;
    const int i16 = lane & 15, kq = lane >> 4;
    int n = 16 * rt + i16; const int nc = n > 254 ? 254 : n;
    f32x4 acc[8];
#pragma unroll
    for (int nt = 0; nt < 8; ++nt) acc[nt] = (f32x4){0.f, 0.f, 0.f, 0.f};
#pragma unroll 8
    for (int ks = 0; ks < 16; ++ks) {
        const int l = 4 * wave + (ks >> 2), d = ((ks & 3) * 32 + 8 * kq);
        const h16x8 af = *(const h16x8*)(QKV + (size_t)(b * SEQ + 16 * nc + l) * NQKV + colbase + d);
        const int k = 512 * wave + 32 * ks + 8 * kq;
#pragma unroll
        for (int nt = 0; nt < 8; ++nt) { const h16x8 bf = *(const h16x8*)(W1T + (size_t)(16 * nt + i16) * 4096 + k);
            acc[nt] = __builtin_amdgcn_mfma_f32_16x16x32_f16(af, bf, acc[nt], 0, 0, 0); }
    }
    LAS float* red = (LAS float*)lds;
    LAS h16* hid = (LAS h16*)(lds + 65536);
#pragma unroll
    for (int nt = 0; nt < 8; ++nt)
#pragma unroll
        for (int rg = 0; rg < 4; ++rg) red[(wave * 16 + 4 * kq + rg) * 128 + 16 * nt + i16] = acc[nt][rg];
    __syncthreads();
    { const int tid = wave * 64 + lane;
#pragma unroll
      for (int q = 0; q < 4; ++q) { const int e = tid + 512 * q; const int j = e & 127; float s = posb[j];
#pragma unroll
          for (int w = 0; w < 8; ++w) s += red[w * 2048 + e];
          hid[e] = (h16)silu_f(s); } }
    __syncthreads();
    f32x4 o = {0.f, 0.f, 0.f, 0.f};
#pragma unroll
    for (int ks = 0; ks < 4; ++ks) { const h16x8 af = *(const LAS h16x8*)(hid + i16 * 128 + 32 * ks + 8 * kq);
        const h16x8 bf = *(const h16x8*)(W2T + (size_t)(16 * wave + i16) * 128 + 32 * ks + 8 * kq);
        o = __builtin_amdgcn_mfma_f32_16x16x32_f16(af, bf, o, 0, 0, 0); }
#pragma unroll
    for (int rg = 0; rg < 4; ++rg) { const int nn = 16 * rt + 4 * kq + rg; OUT[(size_t)nn * 128 + 16 * wave + i16] = nn > 254 ? (h16)0.f : (h16)o[rg]; }
    __syncthreads();
}
__device__ __forceinline__ void p3_compress_splitk(const Args& A, LAS unsigned char* lds, unsigned* ctl, int it, int wave, int lane) {
    const int kv = it >> 7, mt = (it >> 3) & 15, ks8 = it & 7, b = mt >> 3, g = (mt >> 2) & 1, mq = mt & 3;
    const h16* QKV = (const h16*)(A.ws + WS_QKV); const h16* W1T = (const h16*)(A.ws + WS_W1T) + (size_t)kv * 128 * 4096;
    const h16* W2T = (const h16*)(A.ws + WS_W2T) + (size_t)kv * 128 * 128; const float* posb = (const float*)(A.ws + WS_POSB) + kv * 128;
    h16* OUT = (h16*)(A.ws + WS_KC) + ((size_t)((kv * 2 + b) * 2 + g) * 256) * 128;
    float* PART = (float*)(A.ws + WS_F) + (size_t)((kv * 16 + mt) * 8) * 8192;
    unsigned* cntw = ctl + CW_XCH + 6144 + 64 * (kv * 16 + mt);
    const int colbase = (kv ? C_VCMP : C_KCMP) + g * 128;
    const int i16 = lane & 15, kq = lane >> 4, wr = wave >> 1, wk = wave & 1;
    const int n = 64 * mq + 16 * wr + i16; const int nc = n > 254 ? 254 : n;
    f32x4 acc[8];
#pragma unroll
    for (int nt = 0; nt < 8; ++nt) acc[nt] = (f32x4){0.f, 0.f, 0.f, 0.f};
#pragma unroll
    for (int s_ = 0; s_ < 8; ++s_) {
        const int l = 4 * ks8 + 2 * wk + (s_ >> 2), d = (s_ & 3) * 32 + 8 * kq;
        const h16x8 af = *(const h16x8*)(QKV + (size_t)(b * SEQ + 16 * nc + l) * NQKV + colbase + d);
        const int k = 512 * ks8 + 256 * wk + 32 * s_ + 8 * kq;
#pragma unroll
        for (int nt = 0; nt < 8; ++nt) { const h16x8 bf = *(const h16x8*)(W1T + (size_t)(16 * nt + i16) * 4096 + k);
            acc[nt] = __builtin_amdgcn_mfma_f32_16x16x32_f16(af, bf, acc[nt], 0, 0, 0); }
    }
    LAS float* red = (LAS float*)lds;
    LAS h16* hid = (LAS h16*)(lds + 65536);
#pragma unroll
    for (int nt = 0; nt < 8; ++nt)
#pragma unroll
        for (int rg = 0; rg < 4; ++rg) red[(wave * 16 + 4 * kq + rg) * 128 + 16 * nt + i16] = acc[nt][rg];
    __syncthreads();
    { const int tid = wave * 64 + lane;
#pragma unroll
      for (int q = 0; q < 4; ++q) { const int f = (tid + 512 * q) * 4; const int w2 = f >> 11, rest = f & 2047;
          const f32x4 v = *(const LAS f32x4*)(red + (2 * w2) * 2048 + rest) + *(const LAS f32x4*)(red + (2 * w2 + 1) * 2048 + rest);
          const float* dp = PART + (size_t)ks8 * 8192 + f;
          asm volatile("global_store_dwordx4 %0, %1, off sc0 sc1\n\ts_nop 2" :: "v"(dp), "v"(v) : "memory"); } }
    asm volatile("s_waitcnt vmcnt(0)" ::: "memory");
    if (lane == 0) __hip_atomic_fetch_add(cntw, 1u, __ATOMIC_RELAXED, __HIP_MEMORY_SCOPE_AGENT);
    if (ks8 < 4) {
        if (wave == 0) { unsigned sp = 0u;
            while ((unsigned)__builtin_amdgcn_readfirstlane((int)__hip_atomic_load(cntw, __ATOMIC_RELAXED, __HIP_MEMORY_SCOPE_AGENT)) < 64u) { __builtin_amdgcn_s_sleep(1); if (++sp > (1u << 22)) break; }
            __builtin_amdgcn_fence(__ATOMIC_ACQUIRE, "agent"); }
        __syncthreads();
        { const int tid = wave * 64 + lane; const int e4 = tid * 4; const float* p = PART + (size_t)ks8 * 2048 + e4; f32x4 q0, q1, q2, q3, q4, q5, q6, q7;
          asm volatile("global_load_dwordx4 %0, %8, off sc1\n\tglobal_load_dwordx4 %1, %9, off sc1\n\tglobal_load_dwordx4 %2, %10, off sc1\n\tglobal_load_dwordx4 %3, %11, off sc1\n\t"
                       "global_load_dwordx4 %4, %12, off sc1\n\tglobal_load_dwordx4 %5, %13, off sc1\n\tglobal_load_dwordx4 %6, %14, off sc1\n\tglobal_load_dwordx4 %7, %15, off sc1\n\ts_waitcnt vmcnt(0)"
                       : "=&v"(q0), "=&v"(q1), "=&v"(q2), "=&v"(q3), "=&v"(q4), "=&v"(q5), "=&v"(q6), "=&v"(q7)
                       : "v"(p), "v"(p + 8192), "v"(p + 2 * 8192), "v"(p + 3 * 8192), "v"(p + 4 * 8192), "v"(p + 5 * 8192), "v"(p + 6 * 8192), "v"(p + 7 * 8192) : "memory");
          const f32x4 t = (((q0 + q1) + (q2 + q3)) + ((q4 + q5) + (q6 + q7))) + *(const f32x4*)(posb + (e4 & 127));
          h16* hp = (h16*)nullptr; (void)hp;
          u32x2 hw; hw.x = pk2h(silu_f(t[0]), silu_f(t[1])); hw.y = pk2h(silu_f(t[2]), silu_f(t[3]));
          *(LAS u32x2*)(hid + e4) = hw; }
        __syncthreads();
        f32x4 o = {0.f, 0.f, 0.f, 0.f};
#pragma unroll
        for (int ks = 0; ks < 4; ++ks) { const h16x8 af = *(const LAS h16x8*)(hid + i16 * 128 + 32 * ks + 8 * kq);
            const h16x8 bf = *(const h16x8*)(W2T + (size_t)(16 * wave + i16) * 128 + 32 * ks + 8 * kq);
            o = __builtin_amdgcn_mfma_f32_16x16x32_f16(af, bf, o, 0, 0, 0); }
#pragma unroll
        for (int rg = 0; rg < 4; ++rg) { const int nn = 64 * mq + 16 * ks8 + 4 * kq + rg; const h16 ov = nn > 254 ? (h16)0.f : (h16)o[rg]; h16* op_ = OUT + (size_t)nn * 128 + 16 * wave + i16;
            const unsigned ob = (unsigned)__builtin_bit_cast(unsigned short, ov); asm volatile("global_store_short %0, %1, off sc0 sc1" :: "v"(op_), "v"(ob) : "memory"); }
        asm volatile("s_waitcnt vmcnt(0)" ::: "memory");
    }
    __syncthreads();
    if (ks8 < 4 && wave == 0 && lane == 0) __hip_atomic_fetch_add(ctl + CW_P34 + 64 * (b * 2 + g), 1u, __ATOMIC_RELAXED, __HIP_MEMORY_SCOPE_AGENT);
}
__device__ __forceinline__ void p3_kmean_item(const Args& A, LAS unsigned char* lds, int item, int wave, int lane, unsigned* ctl = nullptr) {
    const int b = item >> 6, nb = (item >> 2) & 15, cq = item & 3;
    const h16* QKV = (const h16*)(A.ws + WS_QKV); h16* KM = (h16*)(A.ws + WS_KMEAN);
    const int tid = wave * 64 + lane, cc = tid & 31, rg = tid >> 5;
    const h16* src = QKV + (size_t)(b * SEQ + nb * 256 + rg * 16) * NQKV + C_KM + cq * 256 + cc * 8;
    h16x8 v[16];
#pragma unroll
    for (int r = 0; r < 16; ++r) v[r] = *(const h16x8*)(src + (size_t)r * NQKV);
    float s8[8];
#pragma unroll
    for (int e = 0; e < 8; ++e) s8[e] = 0.f;
#pragma unroll
    for (int r = 0; r < 16; ++r)
#pragma unroll
        for (int e = 0; e < 8; ++e) s8[e] += (float)v[r][e];
    LAS float* red = (LAS float*)lds;
    *(LAS f32x4*)(red + rg * 256 + cc * 8) = (f32x4){s8[0], s8[1], s8[2], s8[3]}; *(LAS f32x4*)(red + rg * 256 + cc * 8 + 4) = (f32x4){s8[4], s8[5], s8[6], s8[7]};
    __syncthreads();
    if (tid < 256) { float t = 0.f;
#pragma unroll
        for (int g_ = 0; g_ < 16; ++g_) t += red[g_ * 256 + tid];
        const int h = cq * 2 + (tid >> 7), d = tid & 127;
        h16* kp_ = KM + ((size_t)(b * 8 + h) * 32 + nb) * 128 + d; const unsigned kb_ = (unsigned)__builtin_bit_cast(unsigned short, (h16)(t * (1.f / 256.f)));
        asm volatile("global_store_short %0, %1, off sc0 sc1\n\ts_waitcnt vmcnt(0)" :: "v"(kp_), "v"(kb_) : "memory"); }
    __syncthreads();
    if (ctl && tid == 0) __hip_atomic_fetch_add(ctl + CW_P34 + 64 * (4 + b * 4 + cq), 1u, __ATOMIC_RELAXED, __HIP_MEMORY_SCOPE_AGENT);
}

namespace att {
constexpr int SHM_K = 16384, SHM_V = 16384;
constexpr int L_V = 0, L_K = 3 * SHM_V, L_WS = L_K + 3 * SHM_K, L_IMP = L_WS + NWAVES * 256, L_SEL = L_IMP + 64 * 64 * 4, L_END = L_SEL + 64 * 8;
#define KSWZ(row, colB) ((row) * 256 + ((colB) ^ (((row) & 7) << 4)))
#define SBAR() __builtin_amdgcn_sched_barrier(0)
__device__ __forceinline__ int v_st(int k, int c) { const int kk = (k & ~0xC) | ((k & 4) << 1) | ((k & 8) >> 1); return ((kk >> 3) * 4 + (c >> 5)) * 512 + ((kk & 7) * 32 + (c & 31)) * 2; }
__device__ __forceinline__ int v_rd_base(int lane) { return ((lane & 3) << 3) | (((lane >> 2) & 3) << 6) | (((lane >> 4) & 1) << 5) | (((lane >> 5) & 1) << 8); }
constexpr int v_rd_off(int d0, int ks, int half) { return d0 * 512 + ks * 4096 + half * 2048; }
__device__ __forceinline__ int crow(int r, int hi) { return (r & 3) + 8 * (r >> 2) + 4 * hi; }

struct Ctx {
    int tid, wid, lane, r32, hi, sr, sc, kws, vst0, vst1, vb0;
    LAS char* lds; LAS char* V_lds; LAS char* K_lds; LAS float* wsc;
};
struct Stage { h16x8 k0, k1, v0, v1; };

__device__ __forceinline__ void stage_load(Stage& S, const Ctx& c, const h16* Kp, const h16* Vp, int rs, int key0) {
    const char* kb = (const char*)Kp + (size_t)key0 * rs * 2; const char* vb = (const char*)Vp + (size_t)key0 * rs * 2;
    const unsigned lo = (unsigned)(c.sr * rs + c.sc) * 2u, lo2 = lo + (unsigned)(32 * rs) * 2u;
    S.v0 = *(const h16x8*)(vb + lo); S.v1 = *(const h16x8*)(vb + lo2);
    S.k0 = *(const h16x8*)(kb + lo); S.k1 = *(const h16x8*)(kb + lo2);
}
__device__ __forceinline__ void stage_load_k(Stage& S, const Ctx& c, const h16* Kp, int rs, int key0) {
    const char* kb = (const char*)Kp + (size_t)key0 * rs * 2;
    const unsigned lo = (unsigned)(c.sr * rs + c.sc) * 2u, lo2 = lo + (unsigned)(32 * rs) * 2u;
    S.k0 = *(const h16x8*)(kb + lo); S.k1 = *(const h16x8*)(kb + lo2);
}
template <int BUF> __device__ __forceinline__ void stage_write_k(const Stage& S, const Ctx& c) {
    *(LAS h16x8*)(c.K_lds + BUF * SHM_K + c.kws) = S.k0; *(LAS h16x8*)(c.K_lds + BUF * SHM_K + c.kws + 32 * 256) = S.k1;
}
template <int BUF> __device__ __forceinline__ void stage_write(const Stage& S, const Ctx& c) {
    *(LAS h16x8*)(c.V_lds + BUF * SHM_V + c.vst0) = S.v0; *(LAS h16x8*)(c.V_lds + BUF * SHM_V + c.vst1) = S.v1;
    stage_write_k<BUF>(S, c);
}
template <int KB, bool HALF_ONLY>
__device__ __forceinline__ void qkt(f32x16& p0, f32x16& p1, const Ctx& c, const h16x8* qr) {
    p0 = f32x16{}; p1 = f32x16{};
    const LAS char* kb[4];
#pragma unroll
    for (int dd = 0; dd < 4; ++dd) kb[dd] = c.K_lds + KB * SHM_K + KSWZ(c.r32, (dd * 16 + c.hi * 8) * 2);
#pragma unroll
    for (int d0 = 0; d0 < 8; ++d0) { const LAS char* a = kb[d0 & 3] + (d0 >> 2) * 128;
        const h16x8 b0 = *(const LAS h16x8*)(a);
        p0 = __builtin_amdgcn_mfma_f32_32x32x16_f16(b0, qr[d0], p0, 0, 0, 0);
        if (!HALF_ONLY) { const h16x8 b1 = *(const LAS h16x8*)(a + 32 * 256);
            p1 = __builtin_amdgcn_mfma_f32_32x32x16_f16(b1, qr[d0], p1, 0, 0, 0); } }
}
template <int VB>
__device__ __forceinline__ void pv_tile(f32x16* o, int vb0, h16x8 pa0, h16x8 pa1, h16x8 pa2, h16x8 pa3) {
#define TRRD(dst, off) asm volatile("ds_read_b64_tr_b16 %0, %1 offset:%2" : "=&v"(dst) : "v"(vb0), "i"(off) : "memory")
#define MKB(l, h) __builtin_bit_cast(h16x8, (s16x8){l[0], l[1], l[2], l[3], h[0], h[1], h[2], h[3]})
#define PV_D0(d0) do { s16x4 l0, l1, l2, l3, h0, h1, h2, h3; constexpr int b_ = VB * SHM_V + v_rd_off(d0, 0, 0); \
        TRRD(l0, b_); TRRD(h0, b_ + 2048); TRRD(l1, b_ + 4096); TRRD(h1, b_ + 6144); TRRD(l2, b_ + 8192); TRRD(h2, b_ + 10240); TRRD(l3, b_ + 12288); TRRD(h3, b_ + 14336); \
        asm volatile("s_waitcnt lgkmcnt(0)" ::: "memory"); SBAR(); \
        o[d0] = __builtin_amdgcn_mfma_f32_32x32x16_f16(pa0, MKB(l0, h0), o[d0], 0, 0, 0); \
        o[d0] = __builtin_amdgcn_mfma_f32_32x32x16_f16(pa1, MKB(l1, h1), o[d0], 0, 0, 0); \
        o[d0] = __builtin_amdgcn_mfma_f32_32x32x16_f16(pa2, MKB(l2, h2), o[d0], 0, 0, 0); \
        o[d0] = __builtin_amdgcn_mfma_f32_32x32x16_f16(pa3, MKB(l3, h3), o[d0], 0, 0, 0); } while (0)
    PV_D0(0); PV_D0(1); PV_D0(2); PV_D0(3);
#undef PV_D0
#undef MKB
#undef TRRD
}
__device__ __forceinline__ void mask_tile(f32x16& p0, f32x16& p1, int dq, unsigned W, bool rowon) {
    const float NEG = -__builtin_inff();
#pragma unroll
    for (int r = 0; r < 16; ++r) {
        const int c = (r & 3) + 8 * (r >> 2);
        if (!rowon || (unsigned)(dq - c) >= W) p0[r] = NEG;
        if (!rowon || (unsigned)(dq - c - 32) >= W) p1[r] = NEG;
    }
}
__device__ __forceinline__ float rowmax32(const f32x16& p0, const f32x16& p1) {
    float pmax = p0[0];
#pragma unroll
    for (int r = 1; r < 16; ++r) pmax = fmaxf(pmax, p0[r]);
#pragma unroll
    for (int r = 0; r < 16; ++r) pmax = fmaxf(pmax, p1[r]);
    auto rr = __builtin_amdgcn_permlane32_swap(__float_as_uint(pmax), __float_as_uint(pmax), false, false);
    return fmaxf(__uint_as_float(rr[0]), __uint_as_float(rr[1]));
}
__device__ __forceinline__ float rowsum32(const f32x16& p0, const f32x16& p1) {
    float ps = 0.f;
#pragma unroll
    for (int r = 0; r < 16; ++r) ps += p0[r];
#pragma unroll
    for (int r = 0; r < 16; ++r) ps += p1[r];
    auto rr = __builtin_amdgcn_permlane32_swap(__float_as_uint(ps), __float_as_uint(ps), false, false);
    return __uint_as_float(rr[0]) + __uint_as_float(rr[1]);
}
__device__ __forceinline__ void pack_p(const f32x16& p0, const f32x16& p1, h16x8& pa0, h16x8& pa1, h16x8& pa2, h16x8& pa3) {
#define PK4(P, B_, OUT) do { unsigned a0 = pk2h(P[B_+0], P[B_+1]), a1 = pk2h(P[B_+2], P[B_+3]); \
        unsigned b0 = pk2h(P[B_+4], P[B_+5]), b1 = pk2h(P[B_+6], P[B_+7]); \
        auto r0 = __builtin_amdgcn_permlane32_swap(a0, b0, false, false); auto r1 = __builtin_amdgcn_permlane32_swap(a1, b1, false, false); \
        u32x4 w = {r0[0], r1[0], r0[1], r1[1]}; OUT = __builtin_bit_cast(h16x8, w); } while (0)
    PK4(p0, 0, pa0); PK4(p0, 8, pa1); PK4(p1, 0, pa2); PK4(p1, 8, pa3);
#undef PK4
}
constexpr float THR = 8.f;
struct SM { float m, l; };

template <int BUF>
__device__ __forceinline__ void tile_step(const Ctx& c, const h16x8* qr, f32x16* o, SM& sm, int j, int pos, unsigned W, unsigned long long rowmask, int qlo, int qhi) {
    const int kb = 64 * j;
    const bool rowon = (rowmask >> j) & 1ull;
    const bool act = __any(rowon) && (kb <= qhi) && (kb + 63 >= qlo - (int)W + 1);
    if (!act) return;
    f32x16 p0, p1;
    qkt<BUF, false>(p0, p1, c, qr);
    const bool need = (kb + 63 > qlo) || (kb <= qhi - (int)W) || !__all(rowon);
    if (need) mask_tile(p0, p1, pos - kb - 4 * c.hi, W, rowon);
    const float pmax = rowmax32(p0, p1);
    float mn, alpha;
    if (__builtin_expect(__all((pmax - sm.m) <= THR), 1)) { mn = sm.m; alpha = 1.f; }
    else { mn = fmaxf(sm.m, pmax); alpha = __builtin_amdgcn_exp2f((sm.m - mn) * LOG2E); sm.m = mn; }
    const float mnL = -mn * LOG2E;
#pragma unroll
    for (int r = 0; r < 16; ++r) { p0[r] = __builtin_amdgcn_exp2f(fmaf(p0[r], LOG2E, mnL)); p1[r] = __builtin_amdgcn_exp2f(fmaf(p1[r], LOG2E, mnL)); }
    sm.l = sm.l * alpha + rowsum32(p0, p1);
    h16x8 pa0, pa1, pa2, pa3; pack_p(p0, p1, pa0, pa1, pa2, pa3);
    if (__any(alpha < 1.f)) { LAS float* al = c.wsc + 32; if (c.hi == 0) al[c.r32] = alpha; asm volatile("s_waitcnt lgkmcnt(0)" ::: "memory");
#pragma unroll
        for (int d_ = 0; d_ < 4; ++d_)
#pragma unroll
            for (int r = 0; r < 16; ++r) o[d_][r] *= al[crow(r, c.hi)]; }
    SBAR();
    pv_tile<BUF>(o, c.vb0, pa0, pa1, pa2, pa3);
}
__device__ __forceinline__ int next_tile(unsigned long long tiles, int j) {
    const unsigned long long rest = (j >= 63) ? 0ull : (tiles >> (j + 1)) << (j + 1);
    return rest ? (int)__builtin_ctzll(rest) : -1;
}
template <int VAR>
__device__ __forceinline__ void run_attn(const Ctx& c, const h16x8* qr, f32x16* o, SM& sm, const h16* Kp, const h16* Vp, int rs,
                                         unsigned long long tiles, int pos, unsigned W, unsigned long long rowmask, int qlo, int qhi) {
    Stage S;
    int j = (int)__builtin_ctzll(tiles);
#define SLOAD(jj) do { if (VAR == 0) stage_load(S, c, Kp, Vp, rs, 64 * (jj)); } while (0)
#define SWRITE(B) do { if (VAR == 0) stage_write<B>(S, c); } while (0)
#define TSYNC() do { if (VAR != 2) __syncthreads(); } while (0)
    SLOAD(j); SWRITE(0); __syncthreads();
    for (;;) {
        int jn = next_tile(tiles, j);
        if (jn >= 0) SLOAD(jn);
        tile_step<0>(c, qr, o, sm, j, pos, W, rowmask, qlo, qhi);
        if (jn < 0) break;
        SWRITE(1); TSYNC();
        j = jn; jn = next_tile(tiles, j);
        if (jn >= 0) SLOAD(jn);
        tile_step<1>(c, qr, o, sm, j, pos, W, rowmask, qlo, qhi);
        if (jn < 0) break;
        SWRITE(0); TSYNC();
        j = jn;
    }
    __syncthreads();
#undef SLOAD
#undef SWRITE
#undef TSYNC
}

template <int KB, bool HALF_ONLY>
__device__ __forceinline__ void qkt_sk(f32x16& p0, f32x16& p1, const Ctx& c, const h16x8* qr, bool act) {
    if (!act) { const float NEG = -__builtin_inff();
#pragma unroll
        for (int r = 0; r < 16; ++r) { p0[r] = NEG; p1[r] = NEG; } return; }
    qkt<KB, HALF_ONLY>(p0, p1, c, qr);
}
__device__ __forceinline__ void partialSM(f32x16& p0, f32x16& p1, float& m_reg, float& alpha) {
    const float pmax = rowmax32(p0, p1); float mn;
    if (__builtin_expect(__all((pmax - m_reg) <= THR), 1)) { mn = m_reg; alpha = 1.f; }
    else { mn = fmaxf(m_reg, pmax); alpha = __builtin_amdgcn_exp2f((m_reg - mn) * LOG2E); m_reg = mn; }
    const float mnL = -mn * LOG2E;
#pragma unroll
    for (int r = 0; r < 16; ++r) { p0[r] = fmaf(p0[r], LOG2E, mnL); p1[r] = fmaf(p1[r], LOG2E, mnL); }
#pragma unroll
    for (int r = 0; r < 16; ++r) p0[r] = __builtin_amdgcn_exp2f(p0[r]);
}
__device__ __forceinline__ void finishSM(f32x16& p0, f32x16& p1, float alpha, float& l_reg, h16x8& pa0, h16x8& pa1, h16x8& pa2, h16x8& pa3) {
#pragma unroll
    for (int r = 0; r < 16; ++r) p1[r] = __builtin_amdgcn_exp2f(p1[r]);
    l_reg = l_reg * alpha + rowsum32(p0, p1);
    pack_p(p0, p1, pa0, pa1, pa2, pa3);
}
__device__ __forceinline__ void run_attn2(const Ctx& c, const h16x8* qr, f32x16* o, SM& sm, const h16* Kp, const h16* Vp, int rs,
                                          int j_lo, int j_hi, int pos, unsigned W, unsigned long long rowmask, int qlo, int qhi) {
    const int NT = j_hi - j_lo;
    Stage S;
    f32x16 pA0, pA1, pB0, pB1; float alA, alB; h16x8 pa0, pa1, pa2, pa3;
#define KBASE(t) ((j_lo + (t)) * 64)
#define ROWON(t) (((rowmask >> (j_lo + (t))) & 1ull) != 0ull)
#define ACT(t) (__any(ROWON(t)) && KBASE(t) <= qhi && KBASE(t) + 63 >= qlo - (int)W + 1)
#define MASKT(P0_, P1_, t) do { const int kb_ = KBASE(t); const bool ron_ = ROWON(t); \
        if (ACT(t) && ((kb_ + 63 > qlo) || (kb_ <= qhi - (int)W) || !__all(ron_))) mask_tile(P0_, P1_, pos - kb_ - 4 * c.hi, W, ron_); } while (0)
#define RESC(a) do { if (__any((a) < 1.f)) { LAS float* al = c.wsc + 32; if (c.hi == 0) al[c.r32] = (a); asm volatile("s_waitcnt lgkmcnt(0)" ::: "memory"); \
        _Pragma("unroll") for (int d_ = 0; d_ < 4; ++d_) _Pragma("unroll") for (int r = 0; r < 16; ++r) o[d_][r] *= al[crow(r, c.hi)]; } } while (0)
    stage_load(S, c, Kp, Vp, rs, KBASE(0)); stage_write<0>(S, c);
    if (NT > 1) stage_load(S, c, Kp, Vp, rs, KBASE(1));
    __syncthreads();
    SBAR(); qkt_sk<0, false>(pA0, pA1, c, qr, ACT(0));
    MASKT(pA0, pA1, 0); partialSM(pA0, pA1, sm.m, alA);
    if (NT > 1) stage_write<1>(S, c);
    __syncthreads();
#define HALF_STEP(PX0, PX1, alX, PY0, PY1, alY, t, KB, VB, SB) do { \
        SBAR(); qkt_sk<KB, false>(PX0, PX1, c, qr, ACT(t)); \
        finishSM(PY0, PY1, alY, sm.l, pa0, pa1, pa2, pa3); SBAR(); \
        if ((t) + 1 < NT) { stage_load(S, c, Kp, Vp, rs, KBASE((t) + 1)); SBAR(); } \
        if (ACT((t) - 1)) pv_tile<VB>(o, c.vb0, pa0, pa1, pa2, pa3); \
        MASKT(PX0, PX1, (t)); partialSM(PX0, PX1, sm.m, alX); \
        __syncthreads(); \
        if ((t) + 1 < NT) { stage_write<SB>(S, c); } \
        RESC(alX); __syncthreads(); } while (0)
    for (int t = 1; t + 1 < NT; t += 2) {
        HALF_STEP(pB0, pB1, alB, pA0, pA1, alA, t, 1, 0, 0);
        HALF_STEP(pA0, pA1, alA, pB0, pB1, alB, t + 1, 0, 1, 1);
    }
    const bool even = (NT & 1) == 0;
    if (even) { SBAR(); qkt_sk<1, false>(pB0, pB1, c, qr, ACT(NT - 1)); SBAR(); }
    finishSM(pA0, pA1, alA, sm.l, pa0, pa1, pa2, pa3); SBAR();
    if (ACT(even ? NT - 2 : NT - 1)) pv_tile<0>(o, c.vb0, pa0, pa1, pa2, pa3);
    if (even) { MASKT(pB0, pB1, NT - 1); partialSM(pB0, pB1, sm.m, alB); RESC(alB);
        finishSM(pB0, pB1, alB, sm.l, pa0, pa1, pa2, pa3); SBAR(); if (ACT(NT - 1)) pv_tile<1>(o, c.vb0, pa0, pa1, pa2, pa3); }
    __syncthreads();
#undef HALF_STEP
#undef RESC
#undef MASKT
#undef ACT
#undef ROWON
#undef KBASE
}

__device__ __forceinline__ void qkt_rt(f32x16& p0, f32x16& p1, const Ctx& c, const h16x8* qr, int kbo  , float bias = 0.f) {
#pragma unroll
    for (int r = 0; r < 16; ++r) { p0[r] = bias; p1[r] = bias; }
    const LAS char* kb[4];
#pragma unroll
    for (int dd = 0; dd < 4; ++dd) kb[dd] = c.K_lds + kbo + KSWZ(c.r32, (dd * 16 + c.hi * 8) * 2);
#define KFRAG(d0, half) (*(const LAS h16x8*)(kb[(d0) & 3] + ((d0) >> 2) * 128 + (half) * 32 * 256))
#define QK4(A0, A1, A2, A3, g) do { p0 = __builtin_amdgcn_mfma_f32_32x32x16_f16(A0, qr[2 * (g)], p0, 0, 0, 0); p1 = __builtin_amdgcn_mfma_f32_32x32x16_f16(A1, qr[2 * (g)], p1, 0, 0, 0); \
        p0 = __builtin_amdgcn_mfma_f32_32x32x16_f16(A2, qr[2 * (g) + 1], p0, 0, 0, 0); p1 = __builtin_amdgcn_mfma_f32_32x32x16_f16(A3, qr[2 * (g) + 1], p1, 0, 0, 0); } while (0)
    h16x8 a0 = KFRAG(0, 0), a1 = KFRAG(0, 1), a2 = KFRAG(1, 0), a3 = KFRAG(1, 1);
    h16x8 b0 = KFRAG(2, 0), b1 = KFRAG(2, 1), b2 = KFRAG(3, 0), b3 = KFRAG(3, 1);
    SBAR(); QK4(a0, a1, a2, a3, 0); SBAR();
    a0 = KFRAG(4, 0); a1 = KFRAG(4, 1); a2 = KFRAG(5, 0); a3 = KFRAG(5, 1);
    SBAR(); QK4(b0, b1, b2, b3, 1); SBAR();
    b0 = KFRAG(6, 0); b1 = KFRAG(6, 1); b2 = KFRAG(7, 0); b3 = KFRAG(7, 1);
    SBAR(); QK4(a0, a1, a2, a3, 2); SBAR();
    QK4(b0, b1, b2, b3, 3);
#undef QK4
#undef KFRAG
}
__device__ __forceinline__ void stage_write_rt(const Stage& S, const Ctx& c, int kbo, int vbo) {
    *(LAS h16x8*)(c.V_lds + vbo + c.vst0) = S.v0; *(LAS h16x8*)(c.V_lds + vbo + c.vst1) = S.v1;
    *(LAS h16x8*)(c.K_lds + kbo + c.kws) = S.k0; *(LAS h16x8*)(c.K_lds + kbo + c.kws + 32 * 256) = S.k1;
}
template <bool LAG>
__device__ __forceinline__ void run_attn4_impl(const Ctx& c, const h16x8* qr, f32x16* o, SM& sm, const h16* Kp, const h16* Vp, int rs,
                                          int j_lo, int j_hi, int pos, unsigned W, unsigned long long rowmask, int qlo, int qhi) {
    const int NT = j_hi - j_lo;
    constexpr bool lag = LAG;
    Stage S;
    f32x16 p0, p1;
#define KBASE(t) ((j_lo + (t)) * 64)
#define ROWON(t) (((rowmask >> (j_lo + (t))) & 1ull) != 0ull)
#define ACT(t) (__any(ROWON(t)) && KBASE(t) <= qhi && KBASE(t) + 63 >= qlo - (int)W + 1)
#define QK_STEP(t, kbo_) do { if (ACT(t)) { qkt_rt(p0, p1, c, qr, (kbo_)); const int kb_ = KBASE(t); const bool ron_ = ROWON(t); \
            if ((kb_ + 63 > qlo) || (kb_ <= qhi - (int)W) || !__all(ron_)) mask_tile(p0, p1, pos - kb_ - 4 * c.hi, W, ron_); } } while (0)
#define SMPV_STEP(t, vbo_) do { if (ACT(t)) { \
        const float pmax = rowmax32(p0, p1); float mn, alpha; \
        if (__builtin_expect(__all((pmax - sm.m) <= THR), 1)) { mn = sm.m; alpha = 1.f; } \
        else { mn = fmaxf(sm.m, pmax); alpha = __builtin_amdgcn_exp2f((sm.m - mn) * LOG2E); sm.m = mn; } \
        const float mnL = -mn * LOG2E; \
        _Pragma("unroll") for (int r = 0; r < 16; ++r) { p0[r] = __builtin_amdgcn_exp2f(fmaf(p0[r], LOG2E, mnL)); p1[r] = __builtin_amdgcn_exp2f(fmaf(p1[r], LOG2E, mnL)); } \
        sm.l = sm.l * alpha + rowsum32(p0, p1); \
        h16x8 pa0, pa1, pa2, pa3; pack_p(p0, p1, pa0, pa1, pa2, pa3); \
        if (__any(alpha < 1.f)) { LAS float* al = c.wsc + 32; if (c.hi == 0) al[c.r32] = alpha; asm volatile("s_waitcnt lgkmcnt(0)" ::: "memory"); \
            _Pragma("unroll") for (int d_ = 0; d_ < 4; ++d_) _Pragma("unroll") for (int r = 0; r < 16; ++r) o[d_][r] *= al[crow(r, c.hi)]; } \
        SBAR(); pv_tile<0>(o, c.vb0 + (vbo_), pa0, pa1, pa2, pa3); } } while (0)
    stage_load(S, c, Kp, Vp, rs, KBASE(0)); stage_write_rt(S, c, 0, 0);
    __syncthreads();
    int kbo = 0, vbo = 0;
    for (int t = 0; t < NT; ++t) {
        const int kbn = kbo ^ SHM_K, vbn = (vbo == 2 * SHM_V) ? 0 : vbo + SHM_V, vbp = (vbo == 0) ? 2 * SHM_V : vbo - SHM_V;
        if (t + 1 < NT) stage_load(S, c, Kp, Vp, rs, KBASE(t + 1));
        if (!lag) { QK_STEP(t, kbo); SMPV_STEP(t, vbo); }
        else { if (t > 0) SMPV_STEP(t - 1, vbp); QK_STEP(t, kbo); }
        if (t + 1 < NT) stage_write_rt(S, c, kbn, vbn);
        __syncthreads();
        kbo = kbn; vbo = vbn;
    }
    if (lag) { const int vlast = (vbo == 0) ? 2 * SHM_V : vbo - SHM_V; SMPV_STEP(NT - 1, vlast); }
    __syncthreads();
#undef SMPV_STEP
#undef QK_STEP
#undef ACT
#undef ROWON
#undef KBASE
}
__device__ __forceinline__ void run_attn4(const Ctx& c, const h16x8* qr, f32x16* o, SM& sm, const h16* Kp, const h16* Vp, int rs,
                                          int j_lo, int j_hi, int pos, unsigned W, unsigned long long rowmask, int qlo, int qhi) {
    if (c.wid >= 4) run_attn4_impl<true>(c, qr, o, sm, Kp, Vp, rs, j_lo, j_hi, pos, W, rowmask, qlo, qhi);
    else run_attn4_impl<false>(c, qr, o, sm, Kp, Vp, rs, j_lo, j_hi, pos, W, rowmask, qlo, qhi);
}

#define ABAR() do { asm volatile("s_waitcnt lgkmcnt(0)" ::: "memory"); __builtin_amdgcn_s_barrier(); asm volatile("" ::: "memory"); } while (0)
__device__ __forceinline__ void run_attn5(const Ctx& c, const h16x8* qr, f32x16* o, SM& sm, const h16* Kp, const h16* Vp, int rs,
                                          int j_lo, int j_hi, int pos, unsigned W, unsigned long long rowmask, int qlo, int qhi) {
    const int NT = j_hi - j_lo;
    const bool lagw = (c.wid & 1) != 0;
    Stage S;
    f32x16 p0, p1;
#define KBASE(t) ((j_lo + (t)) * 64)
#define ROWON(t) (((rowmask >> (j_lo + (t))) & 1ull) != 0ull)
#define ACT(t) (__any(ROWON(t)) && KBASE(t) <= qhi && KBASE(t) + 63 >= qlo - (int)W + 1)
    stage_load(S, c, Kp, Vp, rs, KBASE(0)); stage_write_rt(S, c, 0, 0);
    if (NT > 1) { stage_load(S, c, Kp, Vp, rs, KBASE(1)); stage_write_rt(S, c, SHM_K, SHM_V); }
    __syncthreads();
    if (lagw) ABAR();
    int bo = 0;
    for (int t = 0; t < NT; ++t) {
        const int bo2 = (bo == 0) ? 2 * SHM_K : bo - SHM_K;
        const bool act = ACT(t);
        if (t + 2 < NT) stage_load(S, c, Kp, Vp, rs, KBASE(t + 2));
        float alpha = 1.f;
        if (act) { qkt_rt(p0, p1, c, qr, bo); const int kb_ = KBASE(t); const bool ron_ = ROWON(t);
            if ((kb_ + 63 > qlo) || (kb_ <= qhi - (int)W) || !__all(ron_)) mask_tile(p0, p1, pos - kb_ - 4 * c.hi, W, ron_);
            const float pmax = rowmax32(p0, p1); float mn;
            if (__builtin_expect(__all((pmax - sm.m) <= THR), 1)) { mn = sm.m; }
            else { mn = fmaxf(sm.m, pmax); alpha = __builtin_amdgcn_exp2f((sm.m - mn) * LOG2E); sm.m = mn; }
            const float mnL = -mn * LOG2E;
#pragma unroll
            for (int r = 0; r < 16; ++r) { p0[r] = __builtin_amdgcn_exp2f(fmaf(p0[r], LOG2E, mnL)); p1[r] = fmaf(p1[r], LOG2E, mnL); } }
        ABAR();
        if (act) {
#pragma unroll
            for (int r = 0; r < 16; ++r) p1[r] = __builtin_amdgcn_exp2f(p1[r]);
            sm.l = sm.l * alpha + rowsum32(p0, p1);
            h16x8 pa0, pa1, pa2, pa3; pack_p(p0, p1, pa0, pa1, pa2, pa3);
            if (__any(alpha < 1.f)) { LAS float* al = c.wsc + 32; if (c.hi == 0) al[c.r32] = alpha; asm volatile("s_waitcnt lgkmcnt(0)" ::: "memory");
#pragma unroll
                for (int d_ = 0; d_ < 4; ++d_)
#pragma unroll
                    for (int r = 0; r < 16; ++r) o[d_][r] *= al[crow(r, c.hi)]; }
            SBAR(); pv_tile<0>(o, c.vb0 + bo, pa0, pa1, pa2, pa3);
        }
        if (t + 2 < NT) stage_write_rt(S, c, bo2, bo2);
        ABAR();
        bo = (bo == 2 * SHM_K) ? 0 : bo + SHM_K;
    }
    if (!lagw) ABAR();
    __syncthreads();
#undef ACT
#undef ROWON
#undef KBASE
}

__device__ __forceinline__ void mask_tile2(f32x16& p0, f32x16& p1, int dq, unsigned W, bool rowon) {
    const float NEG = -__builtin_inff();
    const int dqe = rowon ? dq : -1;
    if (W >= (1u << 30)) {
#pragma unroll
        for (int r = 0; r < 16; ++r) { const int c = (r & 3) + 8 * (r >> 2); if (c > dqe) p0[r] = NEG; if (c + 32 > dqe) p1[r] = NEG; }
    } else {
#pragma unroll
        for (int r = 0; r < 16; ++r) { const int c = (r & 3) + 8 * (r >> 2); if ((unsigned)(dqe - c) >= W) p0[r] = NEG; if ((unsigned)(dqe - c - 32) >= W) p1[r] = NEG; }
    }
}
__device__ __forceinline__ void pv_rt(f32x16* o, int vb, h16x8 pa0, h16x8 pa1, h16x8 pa2, h16x8 pa3) {
#define TRRD(dst, off) asm volatile("ds_read_b64_tr_b16 %0, %1 offset:%2" : "=&v"(dst) : "v"(vb), "i"(off) : "memory")
#define MKB(l, h) __builtin_bit_cast(h16x8, (s16x8){l[0], l[1], l[2], l[3], h[0], h[1], h[2], h[3]})
#define RD8(L0, H0, L1, H1, L2, H2, L3, H3, d0) do { constexpr int b_ = v_rd_off(d0, 0, 0); \
        TRRD(L0, b_); TRRD(H0, b_ + 2048); TRRD(L1, b_ + 4096); TRRD(H1, b_ + 6144); TRRD(L2, b_ + 8192); TRRD(H2, b_ + 10240); TRRD(L3, b_ + 12288); TRRD(H3, b_ + 14336); } while (0)
#define MM4(L0, H0, L1, H1, L2, H2, L3, H3, d0) do { \
        o[d0] = __builtin_amdgcn_mfma_f32_32x32x16_f16(pa0, MKB(L0, H0), o[d0], 0, 0, 0); o[d0] = __builtin_amdgcn_mfma_f32_32x32x16_f16(pa1, MKB(L1, H1), o[d0], 0, 0, 0); \
        o[d0] = __builtin_amdgcn_mfma_f32_32x32x16_f16(pa2, MKB(L2, H2), o[d0], 0, 0, 0); o[d0] = __builtin_amdgcn_mfma_f32_32x32x16_f16(pa3, MKB(L3, H3), o[d0], 0, 0, 0); } while (0)
    s16x4 al0, ah0, al1, ah1, al2, ah2, al3, ah3, bl0, bh0, bl1, bh1, bl2, bh2, bl3, bh3;
    RD8(al0, ah0, al1, ah1, al2, ah2, al3, ah3, 0);
    RD8(bl0, bh0, bl1, bh1, bl2, bh2, bl3, bh3, 1);
    asm volatile("s_waitcnt lgkmcnt(8)" ::: "memory"); SBAR();
    MM4(al0, ah0, al1, ah1, al2, ah2, al3, ah3, 0); SBAR();
    RD8(al0, ah0, al1, ah1, al2, ah2, al3, ah3, 2);
    asm volatile("s_waitcnt lgkmcnt(8)" ::: "memory"); SBAR();
    MM4(bl0, bh0, bl1, bh1, bl2, bh2, bl3, bh3, 1); SBAR();
    RD8(bl0, bh0, bl1, bh1, bl2, bh2, bl3, bh3, 3);
    asm volatile("s_waitcnt lgkmcnt(8)" ::: "memory"); SBAR();
    MM4(al0, ah0, al1, ah1, al2, ah2, al3, ah3, 2); SBAR();
    asm volatile("s_waitcnt lgkmcnt(0)" ::: "memory"); SBAR();
    MM4(bl0, bh0, bl1, bh1, bl2, bh2, bl3, bh3, 3);
#undef MM4
#undef RD8
#undef MKB
#undef TRRD
}
__device__ __forceinline__ void run_attn6(const Ctx& c, const h16x8* qr, f32x16* o, SM& sm, const h16* Kp, const h16* Vp, int rs,
                                          int j_lo, int j_hi, int pos, unsigned W, unsigned long long rowmask, int qlo, int qhi) {
    const int NT = j_hi - j_lo;
    Stage S;
#define KBASE(t) ((j_lo + (t)) * 64)
#define ROWON(t) (((rowmask >> (j_lo + (t))) & 1ull) != 0ull)
#define ACT(t) (__any(ROWON(t)) && KBASE(t) <= qhi && KBASE(t) + 63 >= qlo - (int)W + 1)
    stage_load(S, c, Kp, Vp, rs, KBASE(0)); stage_write_rt(S, c, 0, 0);
    __syncthreads();
    int bo = 0;
    for (int t = 0; t < NT; ++t) {
        if (t + 1 < NT) stage_load(S, c, Kp, Vp, rs, KBASE(t + 1));
        if (ACT(t)) {
            const bool ron_ = ROWON(t);
            f32x16 p0, p1; qkt_rt(p0, p1, c, qr, bo, ron_ ? 0.f : -__builtin_inff());
            { const int kb_ = KBASE(t);
              if ((kb_ + 63 > qlo) || (kb_ <= qhi - (int)W)) mask_tile2(p0, p1, pos - kb_ - 4 * c.hi, W, ron_); }
            const float pmax = rowmax32(p0, p1); float mn, alpha;
            if (__builtin_expect(__all((pmax - sm.m) <= THR), 1)) { mn = sm.m; alpha = 1.f; }
            else { mn = fmaxf(sm.m, pmax); alpha = __builtin_amdgcn_exp2f((sm.m - mn) * LOG2E); sm.m = mn; }
            const float mnL = -mn * LOG2E;
#pragma unroll
            for (int r = 0; r < 16; ++r) { p0[r] = __builtin_amdgcn_exp2f(fmaf(p0[r], LOG2E, mnL)); p1[r] = __builtin_amdgcn_exp2f(fmaf(p1[r], LOG2E, mnL)); }
            sm.l = sm.l * alpha + rowsum32(p0, p1);
            h16x8 pa0, pa1, pa2, pa3; pack_p(p0, p1, pa0, pa1, pa2, pa3);
            if (__any(alpha < 1.f)) { LAS float* al = c.wsc + 32; if (c.hi == 0) al[c.r32] = alpha; asm volatile("s_waitcnt lgkmcnt(0)" ::: "memory");
#pragma unroll
                for (int d_ = 0; d_ < 4; ++d_)
#pragma unroll
                    for (int r = 0; r < 16; ++r) o[d_][r] *= al[crow(r, c.hi)]; }
            SBAR(); pv_rt(o, c.vb0 + bo, pa0, pa1, pa2, pa3);
        }
        if (t + 1 < NT) stage_write_rt(S, c, bo ^ SHM_K, bo ^ SHM_V);
        __syncthreads();
        bo ^= SHM_K;
    }
#undef ACT
#undef ROWON
#undef KBASE
}


struct DmaOff { unsigned k0, k1, v0, v1; };
__device__ __forceinline__ DmaOff dma_offsets(const Ctx& c, int rs) {
    DmaOff d;
#pragma unroll
    for (int i = 0; i < 2; ++i) { const int o = (2 * c.wid + i) * 1024 + 16 * c.lane;
        const int row = o >> 8, phys = (o & 255) >> 4, logical = phys ^ (row & 7);
        const unsigned ko = (unsigned)(row * rs + logical * 8);
        const int st = o >> 9, kh = st >> 2, cq = st & 3, kk = kh * 8 + ((o & 511) >> 6), c8 = ((o & 63) >> 4) * 8;
        const int k = (kk & ~0xC) | ((kk & 4) << 1) | ((kk & 8) >> 1);
        const unsigned vo = (unsigned)(k * rs + cq * 32 + c8);
        if (i == 0) { d.k0 = ko; d.v0 = vo; } else { d.k1 = ko; d.v1 = vo; } }
    return d;
}
__device__ __forceinline__ void stage_dma(const Ctx& c, const DmaOff& d, const h16* Kp, const h16* Vp, int rs, int key0, int slot) {
    const h16* kb = Kp + (size_t)key0 * rs; const h16* vb = Vp + (size_t)key0 * rs;
    LAS char* kd = (LAS char*)c.K_lds + slot + c.wid * 2048; LAS char* vd = (LAS char*)c.V_lds + slot + c.wid * 2048;
    __builtin_amdgcn_global_load_lds((const unsigned*)(kb + d.k0), (LAS unsigned*)(kd), 16, 0, 0);
    __builtin_amdgcn_global_load_lds((const unsigned*)(kb + d.k1), (LAS unsigned*)(kd + 1024), 16, 0, 0);
    __builtin_amdgcn_global_load_lds((const unsigned*)(vb + d.v0), (LAS unsigned*)(vd), 16, 0, 0);
    __builtin_amdgcn_global_load_lds((const unsigned*)(vb + d.v1), (LAS unsigned*)(vd + 1024), 16, 0, 0);
}
typedef short v4i16_t __attribute__((ext_vector_type(4)));
__device__ __forceinline__ s16x4 vtr(const LAS char* p) { return __builtin_bit_cast(s16x4, __builtin_amdgcn_ds_read_tr16_b64_v4i16((LAS v4i16_t*)p)); }
__device__ __forceinline__ void run_attn9(const Ctx& c, const h16x8* qr, f32x16* o, SM& sm, const h16* Kp, const h16* Vp, int rs,
                                          int j_lo, int j_hi, int pos, unsigned W, unsigned long long rowmask, int qlo, int qhi) {
    const int NT = j_hi - j_lo;
    const DmaOff dmo = dma_offsets(c, rs);
    f32x16 X0, X1;
    u32x4 pwA0, pwA1, pwA2, pwA3, pwB0, pwB1, pwB2, pwB3;
    float l_reg = 0.f, m_reg = -1e30f;
#define KBASE(t) ((j_lo + (t)) * 64)
#define ROWON(t) (((rowmask >> (j_lo + (t))) & 1ull) != 0ull)
    const LAS char* kq[4];
#pragma unroll
    for (int dd = 0; dd < 4; ++dd) kq[dd] = c.K_lds + KSWZ(c.r32, (dd * 16 + c.hi * 8) * 2);
    const LAS char* vq = c.V_lds + v_rd_base(c.lane);
#define KFR(kbo, i) (*(const LAS h16x8*)(kq[((i) >> 1) & 3] + (kbo) + ((i) >> 3) * 128 + ((i) & 1) * 32 * 256))
#define VLO(vbo, j) vtr(vq + (vbo) + v_rd_off((j) >> 2, (j) & 3, 0))
#define VHI(vbo, j) vtr(vq + (vbo) + v_rd_off((j) >> 2, (j) & 3, 1))
#define MKB(l, h) __builtin_bit_cast(h16x8, (s16x8){l[0], l[1], l[2], l[3], h[0], h[1], h[2], h[3]})
    const f32x16 zero16 = {};
#define GA(i, kbo) do { \
        if ((i) & 1) X1 = __builtin_amdgcn_mfma_f32_32x32x16_f16(kf[(i) & 3], qr[(i) >> 1], (i) == 1 ? zero16 : X1, 0, 0, 0); \
        else X0 = __builtin_amdgcn_mfma_f32_32x32x16_f16(kf[(i) & 3], qr[(i) >> 1], (i) == 0 ? zero16 : X0, 0, 0, 0); \
        if ((i) + 4 < 16) kf[(i) & 3] = KFR(kbo, (i) + 4); \
        SBAR(); } while (0)
#define GB(j, HP, vbo, mnL_, PP0, PP1, PP2, PP3, PN0, PN1, PN2, PN3) do { \
        if (HP) { const u32x4 pwj_ = ((j) & 3) == 0 ? PP0 : ((j) & 3) == 1 ? PP1 : ((j) & 3) == 2 ? PP2 : PP3; \
            o[(j) >> 2] = __builtin_amdgcn_mfma_f32_32x32x16_f16(__builtin_bit_cast(h16x8, pwj_), MKB(vl[(j) & 3], vh[(j) & 3]), o[(j) >> 2], 0, 0, 0); \
            if ((j) + 4 < 16) { vl[(j) & 3] = VLO(vbo, (j) + 4); vh[(j) & 3] = VHI(vbo, (j) + 4); } } \
        { const float e0_ = __builtin_amdgcn_exp2f(fmaf((j) < 8 ? X0[(2 * (j)) & 15] : X1[(2 * (j)) & 15], LOG2E, mnL_)); \
          const float e1_ = __builtin_amdgcn_exp2f(fmaf((j) < 8 ? X0[(2 * (j) + 1) & 15] : X1[(2 * (j) + 1) & 15], LOG2E, mnL_)); \
          sacc += e0_; sacc += e1_; const unsigned cv_ = pk2h(e0_, e1_); \
          constexpr int jj_ = (j) >> 2, sub_ = (j) & 3; \
          if (sub_ == 0) ca0 = cv_; else if (sub_ == 1) ca1 = cv_; else if (sub_ == 2) cb0 = cv_; else { \
              auto r0_ = __builtin_amdgcn_permlane32_swap(ca0, cb0, false, false); auto r1_ = __builtin_amdgcn_permlane32_swap(ca1, cv_, false, false); \
              const u32x4 w_ = {r0_[0], r1_[0], r0_[1], r1_[1]}; if (jj_ == 0) PN0 = w_; else if (jj_ == 1) PN1 = w_; else if (jj_ == 2) PN2 = w_; else PN3 = w_; } } \
        SBAR(); } while (0)
#define STEP(t, HP, PP0, PP1, PP2, PP3, PN0, PN1, PN2, PN3) do { \
        const int kbo_ = bo, vbo_ = bop; \
        if ((t) + 1 < NT) stage_dma(c, dmo, Kp, Vp, rs, KBASE((t) + 1), bon); \
        h16x8 kf[4]; kf[0] = KFR(kbo_, 0); kf[1] = KFR(kbo_, 1); kf[2] = KFR(kbo_, 2); kf[3] = KFR(kbo_, 3); \
        SBAR(); \
        GA(0, kbo_); GA(1, kbo_); GA(2, kbo_); GA(3, kbo_); GA(4, kbo_); GA(5, kbo_); GA(6, kbo_); GA(7, kbo_); \
        GA(8, kbo_); GA(9, kbo_); GA(10, kbo_); GA(11, kbo_); GA(12, kbo_); GA(13, kbo_); GA(14, kbo_); GA(15, kbo_); \
        s16x4 vl[4], vh[4]; \
        if (HP) { vl[0] = VLO(vbo_, 0); vh[0] = VHI(vbo_, 0); vl[1] = VLO(vbo_, 1); vh[1] = VHI(vbo_, 1); vl[2] = VLO(vbo_, 2); vh[2] = VHI(vbo_, 2); vl[3] = VLO(vbo_, 3); vh[3] = VHI(vbo_, 3); } \
        const bool ron_ = ROWON(t); \
        { const int kb_ = KBASE(t); if ((kb_ + 63 > qlo) || (kb_ <= qhi - (int)W)) mask_tile2(X0, X1, pos - kb_ - 4 * c.hi, W, true); } \
        const float pmax_ = ron_ ? rowmax32(X0, X1) : -__builtin_inff(); float mn_, alpha; \
        if (__builtin_expect(__all((pmax_ - m_reg) <= THR), 1)) { mn_ = m_reg; alpha = 1.f; } \
        else { mn_ = fmaxf(m_reg, pmax_); alpha = __builtin_amdgcn_exp2f((m_reg - mn_) * LOG2E); m_reg = mn_; } \
        const float mnL_ = ron_ ? -mn_ * LOG2E : -__builtin_inff(); \
        float sacc = 0.f; unsigned ca0 = 0u, ca1 = 0u, cb0 = 0u; \
        SBAR(); \
        GB(0, HP, vbo_, mnL_, PP0, PP1, PP2, PP3, PN0, PN1, PN2, PN3); GB(1, HP, vbo_, mnL_, PP0, PP1, PP2, PP3, PN0, PN1, PN2, PN3); \
        GB(2, HP, vbo_, mnL_, PP0, PP1, PP2, PP3, PN0, PN1, PN2, PN3); GB(3, HP, vbo_, mnL_, PP0, PP1, PP2, PP3, PN0, PN1, PN2, PN3); \
        GB(4, HP, vbo_, mnL_, PP0, PP1, PP2, PP3, PN0, PN1, PN2, PN3); GB(5, HP, vbo_, mnL_, PP0, PP1, PP2, PP3, PN0, PN1, PN2, PN3); \
        GB(6, HP, vbo_, mnL_, PP0, PP1, PP2, PP3, PN0, PN1, PN2, PN3); GB(7, HP, vbo_, mnL_, PP0, PP1, PP2, PP3, PN0, PN1, PN2, PN3); \
        GB(8, HP, vbo_, mnL_, PP0, PP1, PP2, PP3, PN0, PN1, PN2, PN3); GB(9, HP, vbo_, mnL_, PP0, PP1, PP2, PP3, PN0, PN1, PN2, PN3); \
        GB(10, HP, vbo_, mnL_, PP0, PP1, PP2, PP3, PN0, PN1, PN2, PN3); GB(11, HP, vbo_, mnL_, PP0, PP1, PP2, PP3, PN0, PN1, PN2, PN3); \
        GB(12, HP, vbo_, mnL_, PP0, PP1, PP2, PP3, PN0, PN1, PN2, PN3); GB(13, HP, vbo_, mnL_, PP0, PP1, PP2, PP3, PN0, PN1, PN2, PN3); \
        GB(14, HP, vbo_, mnL_, PP0, PP1, PP2, PP3, PN0, PN1, PN2, PN3); GB(15, HP, vbo_, mnL_, PP0, PP1, PP2, PP3, PN0, PN1, PN2, PN3); \
        { auto rr_ = __builtin_amdgcn_permlane32_swap(__float_as_uint(sacc), __float_as_uint(sacc), false, false); l_reg = l_reg * alpha + (__uint_as_float(rr_[0]) + __uint_as_float(rr_[1])); } \
        if (__any(alpha < 1.f)) { LAS float* al = c.wsc + 32; if (c.hi == 0) al[c.r32] = alpha; asm volatile("s_waitcnt lgkmcnt(0)" ::: "memory"); \
            _Pragma("unroll") for (int d_ = 0; d_ < 4; ++d_) _Pragma("unroll") for (int r = 0; r < 16; ++r) o[d_][r] *= al[crow(r, c.hi)]; } \
        asm volatile("s_waitcnt vmcnt(0)" ::: "memory"); __syncthreads(); \
        bop = bo; bo = bon; bon = (bon == 2 * SHM_K) ? 0 : bon + SHM_K; } while (0)
    __syncthreads();
    stage_dma(c, dmo, Kp, Vp, rs, KBASE(0), 0);
    asm volatile("s_waitcnt vmcnt(0)" ::: "memory"); __syncthreads();
    int bo = 0, bop = 0, bon = SHM_K;
    STEP(0, 0, pwB0, pwB1, pwB2, pwB3, pwA0, pwA1, pwA2, pwA3);
    int t = 1;
    for (; t + 1 < NT; t += 2) { STEP(t, 1, pwA0, pwA1, pwA2, pwA3, pwB0, pwB1, pwB2, pwB3); STEP(t + 1, 1, pwB0, pwB1, pwB2, pwB3, pwA0, pwA1, pwA2, pwA3); }
    if (t < NT) { STEP(t, 1, pwA0, pwA1, pwA2, pwA3, pwB0, pwB1, pwB2, pwB3);
        SBAR(); pv_rt(o, c.vb0 + bop, __builtin_bit_cast(h16x8, pwB0), __builtin_bit_cast(h16x8, pwB1), __builtin_bit_cast(h16x8, pwB2), __builtin_bit_cast(h16x8, pwB3)); }
    else { SBAR(); pv_rt(o, c.vb0 + bop, __builtin_bit_cast(h16x8, pwA0), __builtin_bit_cast(h16x8, pwA1), __builtin_bit_cast(h16x8, pwA2), __builtin_bit_cast(h16x8, pwA3)); }
    sm.m = m_reg; sm.l = l_reg;
    __syncthreads();
#undef STEP
#undef GB
#undef GA
#undef MKB
#undef VHI
#undef VLO
#undef KFR
#undef ROWON
#undef KBASE
}
__device__ __forceinline__ void finish(const Ctx& c, f32x16* o, SM& sm, float gate) {
    LAS float* li = c.wsc;
    const float s = sm.l > 0.f ? gate / sm.l : 0.f;
    if (c.hi == 0) li[c.r32] = s;
    asm volatile("s_waitcnt lgkmcnt(0)" ::: "memory");
#pragma unroll
    for (int r = 0; r < 16; ++r) { const float sr_ = li[crow(r, c.hi)];
#pragma unroll
        for (int d0 = 0; d0 < 4; ++d0) o[d0][r] *= sr_; }
    asm volatile("s_waitcnt lgkmcnt(0)" ::: "memory");
    sm.m = -1e30f; sm.l = 0.f;
}
__device__ __forceinline__ void store_o(const Ctx& c, f32x16* o, h16* Ow  , int ldo, bool acc) {
    LAS h16* stg = (LAS h16*)(c.lds + c.wid * 8192);
#pragma unroll
    for (int r = 0; r < 16; ++r) { const int orow = crow(r, c.hi);
#pragma unroll
        for (int d0 = 0; d0 < 4; ++d0) { stg[orow * 128 + d0 * 32 + c.r32] = (h16)o[d0][r]; o[d0][r] = 0.f; } }
    asm volatile("s_waitcnt lgkmcnt(0)" ::: "memory");
    const int rq = c.lane >> 4, ch = c.lane & 15;
    u32x4 own[8];
#pragma unroll
    for (int it = 0; it < 8; ++it) own[it] = *(const LAS u32x4*)(stg + (it * 4 + rq) * 128 + ch * 8);
    if (acc) {
        u32x4 old[8];
        const h16* p0 = Ow + (size_t)rq * ldo + ch * 8;
#define LD16(k) "global_load_dwordx4 %" #k ", %8, off sc1\n\t"
        const h16* a0 = p0, * a1 = p0 + (size_t)4 * ldo, * a2 = p0 + (size_t)8 * ldo, * a3 = p0 + (size_t)12 * ldo, * a4 = p0 + (size_t)16 * ldo, * a5 = p0 + (size_t)20 * ldo, * a6 = p0 + (size_t)24 * ldo, * a7 = p0 + (size_t)28 * ldo;
        asm volatile("global_load_dwordx4 %0, %8, off sc1\n\tglobal_load_dwordx4 %1, %9, off sc1\n\tglobal_load_dwordx4 %2, %10, off sc1\n\tglobal_load_dwordx4 %3, %11, off sc1\n\t"
                     "global_load_dwordx4 %4, %12, off sc1\n\tglobal_load_dwordx4 %5, %13, off sc1\n\tglobal_load_dwordx4 %6, %14, off sc1\n\tglobal_load_dwordx4 %7, %15, off sc1\n\ts_waitcnt vmcnt(0)"
                     : "=&v"(old[0]), "=&v"(old[1]), "=&v"(old[2]), "=&v"(old[3]), "=&v"(old[4]), "=&v"(old[5]), "=&v"(old[6]), "=&v"(old[7])
                     : "v"(a0), "v"(a1), "v"(a2), "v"(a3), "v"(a4), "v"(a5), "v"(a6), "v"(a7) : "memory");
#undef LD16
#pragma unroll
        for (int it = 0; it < 8; ++it) {
#pragma unroll
            for (int e = 0; e < 4; ++e) { const unsigned wa = own[it][e], wb = old[it][e]; const h16x2 ha = __builtin_bit_cast(h16x2, wa), hb = __builtin_bit_cast(h16x2, wb);
                own[it][e] = pk2h((float)ha.x + (float)hb.x, (float)ha.y + (float)hb.y); } }
    }
#pragma unroll
    for (int it = 0; it < 8; ++it) *(u32x4*)(Ow + (size_t)(it * 4 + rq) * ldo + ch * 8) = own[it];
}

__device__ __forceinline__ void nsa_prepare(const Args& A, const Ctx& c, int b, int g, int ci, h16x8* qr, f32x16* o, unsigned long long& rowmask, h16* O) {
    const h16* QKV = (const h16*)(A.ws + WS_QKV); const float* G = (const float*)(A.ws + WS_GATE);
    const h16* KC = (const h16*)(A.ws + WS_KC) + ((size_t)((0 * 2 + b) * 2 + g) * 256) * 128;
    const h16* VC = (const h16*)(A.ws + WS_KC) + ((size_t)((1 * 2 + b) * 2 + g) * 256) * 128;
    const int hh = c.wid >> 1, head = g * 4 + hh, sub = (c.wid & 1) * 32, t0 = 64 * ci;
    const int qidx = sub + c.r32, t = t0 + qidx; const size_t tokrow = (size_t)(b * SEQ + t);
#pragma unroll
    for (int d0 = 0; d0 < 8; ++d0) qr[d0] = *(const h16x8*)(QKV + tokrow * NQKV + C_QN + head * 128 + d0 * 16 + c.hi * 8);
    const float g0 = G[tokrow * 24 + head * 3];
    LAS float* impH = (LAS float*)((hh < 2 ? c.K_lds : c.V_lds) + SHM_K * (1 + (hh & 1)));
#define IMPP(s_) impH[qidx * 64 + (((s_) + 2 * qidx) & 63)]
    LAS float* rlH = (LAS float*)(c.lds + L_IMP);
    LAS unsigned long long* selm = (LAS unsigned long long*)(c.lds + L_SEL);
    h16* Ow = O + (size_t)(b * SEQ + t0 + sub) * DM + head * 128;
    __syncthreads();
    { LAS f32x4* z = (LAS f32x4*)(impH + qidx * 64 + 32 * c.hi);
#pragma unroll
      for (int e = 0; e < 8; ++e) z[e] = (f32x4){0.f, 0.f, 0.f, 0.f}; }
    const int posc = (t - 31) >> 4;
    const int ntc = ((4 * ci + 2) >> 6) + 1;
    const unsigned WC = 1u << 30;
    float m = -1e30f, l = 0.f;
    Stage S; stage_load(S, c, KC, VC, 128, 0);
    for (int j = 0; j < ntc; ++j) {
        __syncthreads();
        stage_write<0>(S, c); __syncthreads();
        if (j + 1 < ntc) stage_load(S, c, KC, VC, 128, 64 * (j + 1));
        f32x16 p0, p1; qkt<0, false>(p0, p1, c, qr);
        mask_tile2(p0, p1, posc - 64 * j - 4 * c.hi, WC, true);
        const float pmax = rowmax32(p0, p1); const float mn = fmaxf(m, pmax); const float alpha = __builtin_amdgcn_exp2f((m - mn) * LOG2E); m = mn;
        if (__any(alpha < 1.f)) {
            LAS float* al = c.wsc + 32; if (c.hi == 0) al[c.r32] = alpha; asm volatile("s_waitcnt lgkmcnt(0)" ::: "memory");
#pragma unroll
            for (int d_ = 0; d_ < 4; ++d_)
#pragma unroll
                for (int r = 0; r < 16; ++r) o[d_][r] *= al[crow(r, c.hi)];
            for (int k = 0; k < 8 * j + 1; ++k) IMPP(2 * k + c.hi) *= alpha; }
        const float mL = -mn * LOG2E;
#pragma unroll
        for (int r = 0; r < 16; ++r) { p0[r] = __builtin_amdgcn_exp2f(fmaf(p0[r], LOG2E, mL)); p1[r] = __builtin_amdgcn_exp2f(fmaf(p1[r], LOG2E, mL)); }
        l = l * alpha + rowsum32(p0, p1);
        {
            const int sb = 16 * j + c.hi;
#pragma unroll
            for (int gq = 0; gq < 4; ++gq) { IMPP(sb + 2 * gq) += p0[4 * gq] + p0[4 * gq + 1] + p0[4 * gq + 2] + 0.5f * p0[4 * gq + 3];
                IMPP(sb + 8 + 2 * gq) += p1[4 * gq] + p1[4 * gq + 1] + p1[4 * gq + 2] + 0.5f * p1[4 * gq + 3]; }
            asm volatile("s_waitcnt lgkmcnt(0)" ::: "memory");
#pragma unroll
            for (int gq = 0; gq < 4; ++gq) { IMPP(sb + 2 * gq + 1) += 0.5f * p0[4 * gq + 3];
                if (sb + 8 + 2 * gq + 1 < 64) IMPP(sb + 8 + 2 * gq + 1) += 0.5f * p1[4 * gq + 3]; }
        }
        h16x8 pa0, pa1, pa2, pa3; pack_p(p0, p1, pa0, pa1, pa2, pa3);
        SBAR();
        pv_tile<0>(o, c.vb0, pa0, pa1, pa2, pa3);
    }
    {
        LAS float* li = c.wsc; const float rli = l > 0.f ? 1.f / l : 0.f;
        if (c.hi == 0) { li[c.r32] = rli * g0; rlH[hh * 64 + qidx] = rli; }
        asm volatile("s_waitcnt lgkmcnt(0)" ::: "memory");
#pragma unroll
        for (int r = 0; r < 16; ++r) { const float sr_ = li[crow(r, c.hi)];
#pragma unroll
            for (int d0 = 0; d0 < 4; ++d0) o[d0][r] *= sr_; }
    }
    __syncthreads();
    {
        const int s = c.lane;
        const LAS float* i0 = (const LAS float*)(c.K_lds + SHM_K), * i1 = (const LAS float*)(c.K_lds + 2 * SHM_K), * i2 = (const LAS float*)(c.V_lds + SHM_V), * i3 = (const LAS float*)(c.V_lds + 2 * SHM_V);
        for (int qq = 0; qq < 8; ++qq) { const int q = c.wid * 8 + qq; const int ps = q * 64 + ((s + 2 * q) & 63);
            const float my = ((i0[ps] * rlH[q] + i1[ps] * rlH[64 + q]) + i2[ps] * rlH[128 + q]) + i3[ps] * rlH[192 + q];
            const bool valid = (s >= 1 && s <= ci - 2);
            bool pick = valid;
            if (ci - 2 > 13) {
                const unsigned key = valid ? __float_as_uint(my) + 1u : 0u; unsigned T = 0u;
                for (int bit = 31; bit >= 0; --bit) { const unsigned trial = T | (1u << bit); if (__popcll(__ballot(key >= trial)) >= 13) T = trial; }
                const unsigned long long gt = __ballot(key > T), eq = __ballot(key == T);
                const int need = 13 - __popcll(gt); const int rk = __popcll(eq & ((1ull << s) - 1ull));
                pick = (key > T) || (key == T && rk < need);
            }
            const bool sel = (s == 0) || (s == ci) || (s == ci - 1) || pick;
            const unsigned long long bm = __ballot(sel && s <= ci);
            if (c.lane == 0) selm[q] = bm; }
        __syncthreads();
    }
    rowmask = selm[qidx];
#undef IMPP
    store_o(c, o, Ow, DM, false);
}
__device__ __forceinline__ void moba_prepare(const Args& A, const Ctx& c, int b, int h, int cj, h16x8* qr, unsigned long long& rowmask) {
    const h16* QKV = (const h16*)(A.ws + WS_QKV);
    const h16* KMT = (const h16*)(A.ws + WS_KMEAN) + (size_t)(b * 8 + h) * 32 * 128;
    const int wq0 = 256 * cj + 32 * c.wid, t = wq0 + c.r32; const size_t tokrow = (size_t)(b * SEQ + t);
#pragma unroll
    for (int d0 = 0; d0 < 8; ++d0) qr[d0] = *(const h16x8*)(QKV + tokrow * NQKV + C_QM + h * 128 + d0 * 16 + c.hi * 8);
    rowmask = 0xFull << (4 * cj);
    if (cj > 0) {
        __syncthreads();
        { const h16x8 kk = *(const h16x8*)(KMT + (size_t)c.sr * 128 + c.sc); *(LAS h16x8*)(c.K_lds + c.kws) = kk; }
        __syncthreads();
        f32x16 p0, p1; qkt<0, true>(p0, p1, c, qr);
        float S[16];
#pragma unroll
        for (int r = 0; r < 8; ++r) { auto rr = __builtin_amdgcn_permlane32_swap(__float_as_uint(p0[r]), __float_as_uint(p0[r]), false, false);
            const int n = (r & 3) + 8 * (r >> 2); S[n] = __uint_as_float(rr[0]); S[n + 4] = __uint_as_float(rr[1]); }
#pragma unroll
        for (int n = 0; n < 16; ++n) S[n] = (n < cj) ? S[n] : -__builtin_inff();
#pragma unroll
        for (int n = 0; n < 16; ++n) { int cnt = 0;
#pragma unroll
            for (int mm = 0; mm < 16; ++mm) { if (mm < n) cnt += (S[mm] >= S[n]) ? 1 : 0; else if (mm > n) cnt += (S[mm] > S[n]) ? 1 : 0; }
            const unsigned long long bits = (n < cj && cnt < 3) ? (0xFull << (4 * n)) : 0ull; rowmask |= bits; }
        __syncthreads();
    }
}
#undef SBAR
}


#if DIAG
constexpr int CW_DIAG = 96;
#ifndef DIAG_FIELD
#define DIAG_FIELD 4
#endif
__device__ __forceinline__ void diag_max(unsigned* ctl, float v, int lane, unsigned payload = 0u) { if (lane == 0 && fabsf(v) > 2.0f) atomicAdd(ctl + CW_DIAG + 4, 1u); if (lane == 0) atomicMax((unsigned long long*)(ctl + CW_DIAG), ((unsigned long long)__float_as_uint(fabsf(v)) << 32) | payload); }
__device__ __forceinline__ float diag_dot_h(const h16* a, const float* W, int ldw, int col, int K, int lane) {
    float s = 0.f; for (int k = lane; k < K; k += 64) s += (float)a[k] * W[(size_t)k * ldw + col]; return wave_sum(s); }
__device__ __forceinline__ unsigned diag_hash(unsigned x) { x ^= x >> 16; x *= 0x7feb352du; x ^= x >> 15; x *= 0x846ca68bu; x ^= x >> 16; return x; }
__device__ __forceinline__ void diag_qkv(const Args& A, unsigned* ctl, int gw, int NGW, int lane) {
    const h16* H = (const h16*)(A.ws + WS_H); const h16* QKV = (const h16*)(A.ws + WS_QKV); const float* G = (const float*)(A.ws + WS_GATE);
    const float* COS = (const float*)(A.ws + WS_COS); const float* SIN = (const float*)(A.ws + WS_SIN); const float* W = A.in[6];
    for (int sidx = gw; sidx < 8192; sidx += NGW) {
        const unsigned hsh = diag_hash(sidx * 2 + 1); const int row = hsh % M; const int cs = (hsh >> 13) % INCOLS; const int t = row & (SEQ - 1);
        const h16* hr = H + (size_t)row * DM;
        if (cs >= 2560 && cs < 2584) { const float raw = diag_dot_h(hr, W, INCOLS, cs, DM, lane); diag_max(ctl, G[(size_t)row * 24 + cs - 2560] - 1.f / (1.f + expf(-raw)), lane); continue; }
        const int n = cs < 2560 ? cs : cs - 24; const int pn = n >> 8; const int add = cs < 2560 ? 0 : 24;
        const float got = (float)QKV[(size_t)row * NQKV + n];
        float want;
        if (pg8::is_rope_tile(pn)) { const int d = n & 127, hb = n & ~127; const float rd = diag_dot_h(hr, W, INCOLS, cs, DM, lane), rp = diag_dot_h(hr, W, INCOLS, hb + (d ^ 64) + add, DM, lane);
            const int i = d & 63; const float c = COS[t * 64 + i], s_ = SIN[t * 64 + i];
            want = d < 64 ? rd * c - rp * s_ : rd * c + rp * s_; if (pg8::is_q_tile(pn)) want *= QSCALE; }
        else want = diag_dot_h(hr, W, INCOLS, cs, DM, lane);
        diag_max(ctl, got - want, lane);
    }
}
__device__ __forceinline__ void diag_kc(const Args& A, unsigned* ctl, int gw, int NGW, int lane) {
    const h16* QKV = (const h16*)(A.ws + WS_QKV); const h16* KC = (const h16*)(A.ws + WS_KC);
    for (int sidx = gw; sidx < 256; sidx += NGW) {
        const unsigned hsh = diag_hash(sidx * 2 + 77); const int kv = hsh & 1, b = (hsh >> 1) & 1, g = (hsh >> 2) & 1, n = (hsh >> 3) % 255, c = (hsh >> 12) & 127;
        const float* pos = A.in[kv ? 10 : 7]; const float* w1 = A.in[kv ? 11 : 8]; const float* w2 = A.in[kv ? 12 : 9];
        const int colbase = (kv ? C_VCMP : C_KCMP) + g * 128;
        float h0 = 0.f, h1 = 0.f;
        for (int k = 0; k < 4096; ++k) { const int l = k >> 7, d = k & 127; const float a = (float)QKV[(size_t)(b * SEQ + 16 * n + l) * NQKV + colbase + d] + pos[k];
            h0 += a * w1[(size_t)k * 128 + lane]; h1 += a * w1[(size_t)k * 128 + 64 + lane]; }
        h0 = h0 / (1.f + expf(-h0)); h1 = h1 / (1.f + expf(-h1));
        const float want = wave_sum(h0 * w2[lane * 128 + c] + h1 * w2[(64 + lane) * 128 + c]);
        const float got = (float)KC[((size_t)((kv * 2 + b) * 2 + g) * 256 + n) * 128 + c];
        diag_max(ctl, (got - want) * 2.f, lane);
    }
}
template <int MODE  >
__device__ __forceinline__ void diag_gemm(unsigned* ctl, const h16* Abuf, int K, const float* W, int N, const void* Cbuf, float scale, int gw, int NGW, int lane, unsigned salt) {
    for (int sidx = gw; sidx < 8192; sidx += NGW) {
        const unsigned hsh = diag_hash(sidx * 2 + salt); const int row = hsh % M; const int col = (hsh >> 13) % N;
        float want = diag_dot_h(Abuf + (size_t)row * K, W, N, col, K, lane); float got;
        if (MODE == 1) { want = fmaxf(want, 0.f); want *= want; got = (float)((const h16*)Cbuf)[(size_t)row * N + col]; } else got = ((const float*)Cbuf)[(size_t)row * N + col];
        diag_max(ctl, (got - want) * scale, lane);
    }
}

#ifndef DIAG_TMAX
#define DIAG_TMAX 4096
#endif
#ifndef DIAG_TMIN
#define DIAG_TMIN 0
#endif

__device__ __forceinline__ void diag_kmean(const Args& A, unsigned* ctl, int gw, int NGW, int lane) {
    const h16* QKV = (const h16*)(A.ws + WS_QKV); const h16* KM = (const h16*)(A.ws + WS_KMEAN);
    for (int sidx = gw; sidx < 256; sidx += NGW) {
        const int b = sidx >> 7, h = (sidx >> 4) & 7, nb = sidx & 15;
        const h16* Kh = QKV + (size_t)(b * SEQ) * NQKV + C_KM + h * 128;
        float m0 = 0.f, m1 = 0.f; for (int j = 0; j < 256; ++j) { const h16* kr = Kh + (size_t)(nb * 256 + j) * NQKV; m0 += (float)kr[lane]; m1 += (float)kr[64 + lane]; }
        const h16* kp = KM + ((size_t)(b * 8 + h) * 32 + nb) * 128;
        float d = fmaxf(fabsf((float)kp[lane] - m0 * (1.f / 256.f)), fabsf((float)kp[64 + lane] - m1 * (1.f / 256.f)));
#pragma unroll
        for (int o_ = 1; o_ < 64; o_ <<= 1) d = fmaxf(d, __shfl_xor(d, o_));
        diag_max(ctl, d * 100.f, lane, ((unsigned)nb << 8) | (b << 7) | (h << 4));
    }
}
struct OnlineSM { float m, Z, a0, a1; };
__device__ __forceinline__ void osm_key(OnlineSM& st, float qa, float qb, const h16* Krow, const h16* Vrow, int lane) {
    const float sc = wave_sum(qa * (float)Krow[lane] + qb * (float)Krow[64 + lane]);
    const float mn = fmaxf(st.m, sc), corr = expf(st.m - mn), w = expf(sc - mn);
    st.Z = st.Z * corr + w; st.a0 = st.a0 * corr + w * (float)Vrow[lane]; st.a1 = st.a1 * corr + w * (float)Vrow[64 + lane]; st.m = mn;
}
__device__ __forceinline__ void diag_nsa(const Args& A, unsigned* ctl, LAS unsigned char* lds, int gw, int NGW, int wave, int lane) {
    const h16* QKV = (const h16*)(A.ws + WS_QKV); const float* G = (const float*)(A.ws + WS_GATE); const h16* O = (const h16*)(A.ws + WS_O);
    LAS float* pl = (LAS float*)(lds + wave * 4096);
    LAS float* impl = pl + 256;
    for (int sidx = gw; sidx < 16384; sidx += NGW) {
        const unsigned hsh = diag_hash(sidx * 2 + 101); const int b = hsh & 1, g = (hsh >> 1) & 1, hh = (hsh >> 2) & 3;
        int t = DIAG_TMIN + (int)((hsh >> 4) % (unsigned)(DIAG_TMAX - DIAG_TMIN)); if (sidx < 256) t = DIAG_TMIN + (sidx % (DIAG_TMAX - DIAG_TMIN));
        const int cb = t >> 6; const int nvis = t >= 31 ? ((t - 31) >> 4) + 1 : 0;
        const h16* KC = (const h16*)(A.ws + WS_KC) + ((size_t)((0 * 2 + b) * 2 + g) * 256) * 128;
        const h16* VC = (const h16*)(A.ws + WS_KC) + ((size_t)((1 * 2 + b) * 2 + g) * 256) * 128;
        const size_t tokrow = (size_t)(b * SEQ + t);
        if (lane < 64) impl[lane] = 0.f;
        float oc0 = 0.f, oc1 = 0.f, myqa = 0.f, myqb = 0.f;
        for (int h4 = 0; h4 < 4; ++h4) {
            const h16* qp = QKV + tokrow * NQKV + C_QN + (g * 4 + h4) * 128; const float qa = (float)qp[lane], qb = (float)qp[64 + lane];
            if (h4 == hh) { myqa = qa; myqb = qb; }
            float mx = -__builtin_inff();
            for (int n = 0; n < nvis; ++n) { const float sc = wave_sum(qa * (float)KC[n * 128 + lane] + qb * (float)KC[n * 128 + 64 + lane]); if (lane == 0) pl[n] = sc; mx = fmaxf(mx, sc); }
            float Z = 0.f; for (int n = 0; n < nvis; ++n) Z += expf(pl[n] - mx);
            for (int n = lane; n < 256; n += 64) pl[n] = n < nvis ? expf(pl[n] - mx) / Z : 0.f;
            { const int s_ = lane; float v = pl[4 * s_] + pl[4 * s_ + 1] + pl[4 * s_ + 2] + 0.5f * pl[4 * s_ + 3] + (s_ > 0 ? 0.5f * pl[4 * s_ - 1] : 0.f); impl[s_] += v; }
            if (h4 == hh) for (int n = 0; n < nvis; ++n) { const float p = pl[n]; oc0 += p * (float)VC[n * 128 + lane]; oc1 += p * (float)VC[n * 128 + 64 + lane]; }
        }
        const int s_ = lane; const bool causal = s_ <= cb, forced = (s_ == 0) || (s_ == cb) || (s_ == cb - 1);
        const float key = causal ? (forced ? __builtin_inff() : impl[s_]) : -__builtin_inff();
        int rank = 0; for (int j = 0; j < 64; ++j) { const float kj = __shfl(key, j); rank += (kj > key || (kj == key && j < s_)) ? 1 : 0; }
        const unsigned long long selmask = __ballot(rank < 16 && causal);
        OnlineSM ss; ss.m = -__builtin_inff(); ss.Z = 0.f; ss.a0 = 0.f; ss.a1 = 0.f;
        const h16* Ks = QKV + (size_t)(b * SEQ) * NQKV + C_KSEL + g * 128; const h16* Vs = QKV + (size_t)(b * SEQ) * NQKV + C_VSEL + g * 128;
        for (int blk = 0; blk <= cb; ++blk) if ((selmask >> blk) & 1ull) for (int l = 0; l < 64; ++l) { const int kp = 64 * blk + l; if (kp <= t) osm_key(ss, myqa, myqb, Ks + (size_t)kp * NQKV, Vs + (size_t)kp * NQKV, lane); }
        OnlineSM sw; sw.m = -__builtin_inff(); sw.Z = 0.f; sw.a0 = 0.f; sw.a1 = 0.f;
        const h16* Kw = QKV + (size_t)(b * SEQ) * NQKV + C_KWIN + g * 128; const h16* Vw = QKV + (size_t)(b * SEQ) * NQKV + C_VWIN + g * 128;
        for (int kp = (t - 511 > 0 ? t - 511 : 0); kp <= t; ++kp) osm_key(sw, myqa, myqb, Kw + (size_t)kp * NQKV, Vw + (size_t)kp * NQKV, lane);
        const float* gp = G + tokrow * 24 + (g * 4 + hh) * 3;
        const float w0 = gp[0] * oc0 + gp[1] * ss.a0 / ss.Z + gp[2] * sw.a0 / sw.Z, w1 = gp[0] * oc1 + gp[1] * ss.a1 / ss.Z + gp[2] * sw.a1 / sw.Z;
        const h16* op = O + tokrow * DM + (g * 4 + hh) * 128;
        float d = fmaxf(fabsf((float)op[lane] - w0), fabsf((float)op[64 + lane] - w1));
#pragma unroll
        for (int o_ = 1; o_ < 64; o_ <<= 1) d = fmaxf(d, __shfl_xor(d, o_));
        diag_max(ctl, d * 10.f, lane, ((unsigned)t << 8) | (b << 7) | (g << 6) | (hh << 4));
    }
}
__device__ __forceinline__ void diag_moba(const Args& A, unsigned* ctl, int gw, int NGW, int lane) {
    const h16* QKV = (const h16*)(A.ws + WS_QKV); const h16* O = (const h16*)(A.ws + WS_O);
    for (int sidx = gw; sidx < 2048; sidx += NGW) {
        const unsigned hsh = diag_hash(sidx * 2 + 203); const int b = hsh & 1, h = (hsh >> 1) & 7;
        int t = DIAG_TMIN + (int)((hsh >> 4) % (unsigned)(DIAG_TMAX - DIAG_TMIN)); if (sidx < 256) t = DIAG_TMIN + ((sidx * 37) % (DIAG_TMAX - DIAG_TMIN));
        const int cur = t >> 8; const size_t tokrow = (size_t)(b * SEQ + t);
        const h16* qp = QKV + tokrow * NQKV + C_QM + h * 128; const float qa = (float)qp[lane], qb = (float)qp[64 + lane];
        const h16* Kh = QKV + (size_t)(b * SEQ) * NQKV + C_KM + h * 128; const h16* Vh = QKV + (size_t)(b * SEQ) * NQKV + C_VM + h * 128;
        float key = -__builtin_inff();
        for (int n = 0; n < cur; ++n) { float m0 = 0.f, m1 = 0.f; for (int j = 0; j < 256; ++j) { const h16* kr = Kh + (size_t)(n * 256 + j) * NQKV; m0 += (float)kr[lane]; m1 += (float)kr[64 + lane]; }
            const float sc = wave_sum(qa * (m0 * (1.f / 256.f)) + qb * (m1 * (1.f / 256.f))); if (lane == n) key = sc; }
        int rank = 0; for (int j = 0; j < 16; ++j) { const float kj = __shfl(key, j); rank += (kj > key || (kj == key && j < lane)) ? 1 : 0; }
        const unsigned long long selmask = __ballot(lane < cur && rank < 3);
        if (DIAG_SELCMP) { const unsigned long long km = ((const unsigned long long*)(A.ws + 329 * MiB))[(size_t)(b * 8 + h) * SEQ + t];
            unsigned long long want = 0xFull << (4 * cur); for (int n = 0; n < cur; ++n) if ((selmask >> n) & 1ull) want |= 0xFull << (4 * n);
            diag_max(ctl, km == want ? 0.f : 10.f, lane, ((unsigned)t << 8) | (b << 7) | (h << 4)); continue; }
        OnlineSM ss; ss.m = -__builtin_inff(); ss.Z = 0.f; ss.a0 = 0.f; ss.a1 = 0.f;
        for (int n = 0; n < cur; ++n) if ((selmask >> n) & 1ull) for (int j = 0; j < 256; ++j) { const int kp = n * 256 + j; osm_key(ss, qa, qb, Kh + (size_t)kp * NQKV, Vh + (size_t)kp * NQKV, lane); }
        for (int kp = cur * 256; kp <= t; ++kp) osm_key(ss, qa, qb, Kh + (size_t)kp * NQKV, Vh + (size_t)kp * NQKV, lane);
        const h16* op = O + tokrow * DM + 1024 + h * 128;
        float d = fmaxf(fabsf((float)op[lane] - ss.a0 / ss.Z), fabsf((float)op[64 + lane] - ss.a1 / ss.Z));
#pragma unroll
        for (int o_ = 1; o_ < 64; o_ <<= 1) d = fmaxf(d, __shfl_xor(d, o_));
        diag_max(ctl, d * 10.f, lane, ((unsigned)t << 8) | (b << 7) | (h << 4));
    }
}
#endif

__device__ __forceinline__ void run_t_item(const float* c_in, const float* w_ada, const float* b_ada, const float* w_dn, const float* w_up, const float* w_o, unsigned char* ws, LAS unsigned char* L, unsigned t) {
    int tl = threadIdx.x; asm volatile("" : "+v"(tl));
    const int ln = tl & 63, wv = __builtin_amdgcn_readfirstlane(tl >> 6), q16 = ln & 15;
    if (t < (unsigned)NT_GV) { const int r_ = (int)t * 8 + wv; gemv_half(c_in, w_ada, b_ada, (float*)(ws + WS_MOD), 16 + (r_ & 31), r_ >> 5, ln); return; }
    t -= (unsigned)NT_GV;
    LAS float* scr = (LAS float*)(L + wv * 16640);
    int r = (int)t * 8 + wv; const float* W; int ldw, K, sh; h16* WT;
    if (r < 2048) { W = w_dn; ldw = DM; K = DFF; WT = (h16*)(ws + WS_WDN); sh = 5; }
    else if (r < 4096) { r -= 2048; W = w_up; ldw = DFF; K = DM; WT = (h16*)(ws + WS_WUP); sh = 7; }
    else { r -= 4096; W = w_o; ldw = DM; K = DM; WT = (h16*)(ws + WS_WO); sh = 5; }
    const int kb = r >> sh, nb = r & ((1 << sh) - 1);
    transpose_item128<true>(W, ldw, K, WT, 128 * kb, 64 * nb, 64 * nb + 4 * q16, 4 * q16, scr, ln);
}

__global__ void __launch_bounds__(NWAVES * 64, 2) hymba_fwd(Args args) {
    extern __shared__ __attribute__((aligned(16))) unsigned char lds[];
    LAS unsigned char* L = (LAS unsigned char*)lds;
    volatile LAS unsigned* LCTL = (volatile LAS unsigned*)(L + LDSCTL_OFF);
    const int tid = threadIdx.x, lane = tid & 63, wave = __builtin_amdgcn_readfirstlane(tid >> 6);
    const int G = gridDim.x; const int bx = blockIdx.x; const int vcu = (G % 8 == 0) ? (bx % 8) * (G / 8) + bx / 8 : bx;
    const int NGW = G * NWAVES; (void)lane; (void)wave;
    unsigned* ctl = (unsigned*)(args.ws + WS_CTL);
    for (int u = tid; u < (LDS_BYTES - LDSCTL_OFF) / 4; u += NWAVES * 64) ((LAS unsigned*)(L + LDSCTL_OFF))[u] = 0u;
    __syncthreads();
    XcdBarrier bar; bar.bar = ctl + CW_BAR; bar.x = 0; bar.st = nullptr;
    if (MK_N_LAUNCHES == 1) bar = xcd_barrier_post(ctl + CW_BAR, LCTL);
    const int lo = args.ph_lo, hi = args.ph_hi;
#ifndef PH_MASK
#define PH_MASK 0x3ff
#endif
#define IN(k) (((PH_MASK >> (k)) & 1) && lo <= (k) && (k) < hi)
#define SEAM(k) do { if (IN(k) && IN((k) + 1)) xcd_barrier(bar); } while (0)
#define NREP(k) ((REPEAT_PH == (k)) ? 2 : 1)
#define FRESH() int tid_ = threadIdx.x; asm volatile("" : "+v"(tid_)); const int lane_ = tid_ & 63, wave_ = __builtin_amdgcn_readfirstlane(tid_ >> 6); const int gw_ = vcu * NWAVES + wave_; (void)lane_; (void)gw_

    if (IN(0)) { FRESH(); for (int rep = 0; rep < NREP(0); ++rep) p0_prologue(args, L, gw_, NGW, wave_, lane_, rep); }
    SEAM(0);
    if (IN(1)) { FRESH(); for (int rep = 0; rep < NREP(1); ++rep) p1_rows(args, gw_, NGW, lane_); }
    SEAM(1);
    if (IN(2)) {
        pg8::Gemm g{(const h16*)(args.ws + WS_H), (const h16*)(args.ws + WS_WIN), M, NPAD, DM}; pg8::StaticOrder S; S.init(M, NPAD, G, bx, WGM_P2);
        pg8::EpiQKV E{(h16*)(args.ws + WS_QKV), (float*)(args.ws + WS_GATE), (const float*)(args.ws + WS_COS), (const float*)(args.ws + WS_SIN)};
        for (int rep = 0; rep < NREP(2); ++rep) pg8::gemm_phase<pg8::EpiQKV, pg8::StaticOrder, true, true>(L, g, S, E);
        if (T_IN_P4 && T_P2_ITEMS > 0 && IN(4) && (S.nwg % G) != 0 && bx >= (S.nwg % G)) { FRESH();
#pragma unroll 1
            for (int k = 0; k < T_P2_ITEMS; ++k) { __syncthreads(); if (tid_ == 0) LCTL[2] = __hip_atomic_fetch_add(ctl + CW_QUEUE + 8, 1u, __ATOMIC_RELAXED, __HIP_MEMORY_SCOPE_AGENT); __syncthreads();
                const unsigned t = (unsigned)__builtin_amdgcn_readfirstlane((int)LCTL[2]); if (t >= (unsigned)NT_ITEMS) break; run_t_item(args.in[1], args.in[2], args.in[3], args.in[17], args.in[16], args.in[13], args.ws, L, t); } }
    }
    SEAM(2);
#if DIAG
    if (DIAG & 1) { FRESH(); diag_qkv(args, ctl, gw_, NGW, lane_); }
#endif
    if (IN(3)) {
        FRESH();
        for (int rep = 0; rep < NREP(3); ++rep)
        if (P3_SPLITK && G == 256 && NREP(3) == 1) { p3_compress_splitk(args, L, ctl, bx, wave_, lane_); if ((bx & 7) >= 4) p3_kmean_item(args, L, (bx >> 3) * 4 + (bx & 7) - 4, wave_, lane_, ctl); }
        else
        for (int it = bx; it < 256; it += G) { if (it < 128) p3_compress_item(args, L, it, wave_, lane_); else p3_kmean_item(args, L, it - 128, wave_, lane_); }
    }
    const bool p34 = P34_HANDOFF && P3_SPLITK && G == 256 && IN(3) && IN(4) && NREP(3) == 1 && NREP(4) == 1;
    if (!p34) SEAM(3);
#if DIAG
    if (DIAG & 2) { FRESH(); diag_kc(args, ctl, gw_, NGW, lane_); }
#endif
    if (IN(4)) {
        FRESH();
#ifndef Q_DED
#define Q_DED 16
#endif
#ifndef Q_RES
#define Q_RES 200
#endif
#define Q_FETCH(qv) do { __syncthreads(); if (tid_ == 0) { unsigned mode = LCTL[3], item = 0xffffu; \
            if (mode == 0u) { const unsigned t = __hip_atomic_fetch_add(ctl + CW_QUEUE + 8 + rep4, 1u, __ATOMIC_RELAXED, __HIP_MEMORY_SCOPE_AGENT); if (t + Q_RES + 1 >= (unsigned)NT_ITEMS) mode = 1u; if (t < (unsigned)NT_ITEMS) item = 0x4000u | t; } \
            if (item == 0xffffu && mode == 1u) { const unsigned a_ = __hip_atomic_fetch_add(ctl + CW_QUEUE + rep4, 1u, __ATOMIC_RELAXED, __HIP_MEMORY_SCOPE_AGENT); if (a_ < 512u) item = args.order[a_]; else mode = 2u; } \
            if (item == 0xffffu && mode == 2u) { const unsigned t = __hip_atomic_fetch_add(ctl + CW_QUEUE + 8 + rep4, 1u, __ATOMIC_RELAXED, __HIP_MEMORY_SCOPE_AGENT); if (t < (unsigned)NT_ITEMS) item = 0x4000u | t; } \
            LCTL[3] = mode; LCTL[2] = item; } __syncthreads(); qv = (unsigned)__builtin_amdgcn_readfirstlane((int)LCTL[2]); } while (0)
        const h16* QKVp = (const h16*)(args.ws + WS_QKV);
        for (int rep4 = 0; rep4 < NREP(4); ++rep4) {
        if (rep4) xcd_barrier(bar);
        if (tid_ == 0) LCTL[3] = (T_IN_P4 && bx < Q_DED) ? 0u : 1u;
        for (;;) {
            unsigned v; Q_FETCH(v);
            if (v == 0xffffu) break;
            if (T_IN_P4 && (v & 0x4000u)) { run_t_item(args.in[1], args.in[2], args.in[3], args.in[17], args.in[16], args.in[13], args.ws, L, v & 0x3fffu); continue; }
#define MAKE_CTX(cn) int tl_##cn = threadIdx.x; asm volatile("" : "+v"(tl_##cn)); \
            att::Ctx cn; cn.tid = tl_##cn; cn.wid = __builtin_amdgcn_readfirstlane(tl_##cn >> 6); cn.lane = tl_##cn & 63; cn.r32 = cn.lane & 31; cn.hi = cn.lane >> 5; cn.sr = tl_##cn >> 4; cn.sc = (tl_##cn & 15) * 8; \
            cn.kws = KSWZ(cn.sr, cn.sc * 2); cn.vst0 = att::v_st(cn.sr, cn.sc); cn.vst1 = att::v_st(32 + cn.sr, cn.sc); \
            cn.lds = (LAS char*)L; cn.V_lds = cn.lds + att::L_V; cn.K_lds = cn.lds + att::L_K; cn.wsc = (LAS float*)(cn.lds + att::L_WS) + cn.wid * 64; \
            cn.vb0 = (int)(unsigned)(uintptr_t)cn.V_lds + att::v_rd_base(cn.lane)
            MAKE_CTX(c0);
            const bool moba = (v & 0x8000u) != 0u; const int b = (v >> 7) & 1;
            h16x8 qr[8]; f32x16 o[4] = {}; unsigned long long rowmask;
            if (p34 && tid_ == 0) { const int slot = moba ? 4 + b * 4 + (int)((v >> 5) & 3) : b * 2 + (int)((v >> 6) & 1); const unsigned bit = 1u << slot, want = moba ? 16u : 32u;
                if (!(LCTL[5] & bit)) { unsigned sp = 0u; while (__hip_atomic_load(ctl + CW_P34 + 64 * slot, __ATOMIC_RELAXED, __HIP_MEMORY_SCOPE_AGENT) < want) { __builtin_amdgcn_s_sleep(1); if (++sp > (1u << 22)) break; }
                    __builtin_amdgcn_fence(__ATOMIC_ACQUIRE, "agent"); LCTL[5] |= bit; } }
            if (moba) att::moba_prepare(args, c0, b, (v >> 4) & 7, v & 15, qr, rowmask);
            else att::nsa_prepare(args, c0, b, (v >> 6) & 1, v & 63, qr, o, rowmask, (h16*)(args.ws + WS_O));
            const int nbr = moba ? 1 : 2;
#pragma unroll 1
            for (int br = 0; br < nbr; ++br) {
                MAKE_CTX(c);
                int koff, voff, j_lo, j_hi, wq0, ocol; unsigned W; unsigned long long rm;
                if (moba) { const int h = (v >> 4) & 7, cj = v & 15; koff = C_KM + h * 128; voff = C_VM + h * 128; j_lo = 0; j_hi = 4 * cj + 4; W = 1u << 30; rm = rowmask; wq0 = 256 * cj + 32 * c.wid; ocol = 1024 + h * 128; }
                else { const int g = (v >> 6) & 1, ci = v & 63; wq0 = 64 * ci + (c.wid & 1) * 32; ocol = (g * 4 + (c.wid >> 1)) * 128; j_hi = ci + 1;
                    if (br == 0) { koff = C_KSEL + g * 128; voff = C_VSEL + g * 128; j_lo = 0; W = 1u << 30; rm = rowmask; }
                    else { koff = C_KWIN + g * 128; voff = C_VWIN + g * 128; j_lo = ci - 8 < 0 ? 0 : ci - 8; W = 512u; rm = ~0ull; } }
                const h16* Kp_ = QKVp + (size_t)(b * SEQ) * NQKV + koff; const h16* Vp_ = QKVp + (size_t)(b * SEQ) * NQKV + voff;
                h16* Ow_ = (h16*)(args.ws + WS_O) + (size_t)(b * SEQ + wq0) * DM + ocol;
                const float gate = moba ? 1.f : ((const float*)(args.ws + WS_GATE))[(size_t)(b * SEQ + wq0 + c.r32) * 24 + (ocol >> 7) * 3 + 1 + br];
                { att::SM sm; sm.m = -1e30f; sm.l = 0.f;
                att::run_attn9(c, qr, o, sm, Kp_, Vp_, NQKV, j_lo, j_hi, wq0 + c.r32, W, rm, wq0, wq0 + 31);
                att::finish(c, o, sm, gate); att::store_o(c, o, Ow_, DM, !moba); }
            }
        }
        }
#undef Q_FETCH
    }
    SEAM(4);
#if DIAG
    if (DIAG & 32) { FRESH(); diag_nsa(args, ctl, L, gw_, NGW, wave_, lane_); }
    if (DIAG & 64) { FRESH(); diag_moba(args, ctl, gw_, NGW, lane_); }
    if (DIAG & 128) { FRESH(); diag_kmean(args, ctl, gw_, NGW, lane_); }
#endif
    const bool fuse6 = FUSE_P6 && G == (M / 256) * (DM / 256) && IN(5) && IN(6);
    if (IN(5)) {
        pg8::Gemm g{(const h16*)(args.ws + WS_O), (const h16*)(args.ws + WS_WO), M, DM, DM}; pg8::StaticOrder S; S.init(M, DM, G, bx);
        if (fuse6) { pg8::EpiNormResNorm E{args.in[0], (h16*)(args.ws + WS_X1), (h16*)(args.ws + WS_H), (float*)(args.ws + WS_SSQ + 1 * MiB), (float*)(args.ws + WS_SSQ + 1 * MiB + 512 * 1024),
                                           ctl + CW_XCH + 2048, ctl + CW_XCH + 4096, args.in[5], args.in[14], (const float*)(args.ws + WS_MOD)};
            pg8::gemm_phase<pg8::EpiNormResNorm, pg8::StaticOrder, true, true>(L, g, S, E); }
        else { pg8::EpiF16SS E{(h16*)(args.ws + WS_OP), DM, (float*)(args.ws + WS_SSQ)};
        for (int rep = 0; rep < NREP(5); ++rep) pg8::gemm_phase<pg8::EpiF16SS, pg8::StaticOrder, true, true>(L, g, S, E); }
    }
    if (!fuse6) SEAM(5);
#if DIAG
    if (DIAG & 4) { FRESH(); diag_gemm<0>(ctl, (const h16*)(args.ws + WS_O), DM, args.in[13], DM, args.ws + WS_OP, 10.f, gw_, NGW, lane_, 5u); }
#endif
    if (IN(6) && !fuse6) { FRESH(); for (int rep = 0; rep < NREP(6); ++rep) p6_rows(args, gw_, NGW, lane_); }
    SEAM(6);
    const bool p78 = P78_HANDOFF && G == (M / 256) * (DM / 256) && IN(7) && IN(8) && NREP(7) == 1 && NREP(8) == 1;
    if (IN(7)) {
        pg8::Gemm g{(const h16*)(args.ws + WS_H), (const h16*)(args.ws + WS_WUP), M, DFF, DM}; pg8::StaticOrder S; S.init(M, DFF, G, bx, WGM_P7);
        pg8::EpiRelu2 E{(h16*)(args.ws + WS_U), DFF};
        for (int rep = 0; rep < NREP(7); ++rep) pg8::gemm_phase<pg8::EpiRelu2, pg8::StaticOrder, true, true>(L, g, S, E);
        if (p78 && threadIdx.x == 0) { pg8::Unit u_; for (int i = 0; S.next(i, u_); ++i) __hip_atomic_fetch_add(ctl + CW_P78 + 64 * u_.pm, 1u, __ATOMIC_RELAXED, __HIP_MEMORY_SCOPE_AGENT); }
    }
    if (!p78) SEAM(7);
#if DIAG
    if (DIAG & 8) { FRESH(); diag_gemm<1>(ctl, (const h16*)(args.ws + WS_H), DM, args.in[16], DFF, args.ws + WS_U, 1.f, gw_, NGW, lane_, 9u); }
#endif
    const bool fuse9 = FUSE_P9 && G == (M / 256) * (DM / 256) && IN(8) && IN(9);
    if (IN(8)) {
        pg8::Gemm g{(const h16*)(args.ws + WS_U), (const h16*)(args.ws + WS_WDN), M, DM, DFF}; pg8::StaticOrder S; S.init(M, DM, G, bx);
        if (p78) { pg8::Unit u_; if (S.next(0, u_) && threadIdx.x == 0) { unsigned sp = 0u;
                while (__hip_atomic_load(ctl + CW_P78 + 64 * u_.pm, __ATOMIC_RELAXED, __HIP_MEMORY_SCOPE_AGENT) < (unsigned)(DFF / 256)) { __builtin_amdgcn_s_sleep(1); if (++sp > (1u << 22)) break; }
                __builtin_amdgcn_fence(__ATOMIC_ACQUIRE, "agent"); }
            __syncthreads(); }
        if (fuse9) { pg8::EpiNormOut E{(const h16*)(args.ws + WS_X1), args.out, (float*)(args.ws + WS_SSQ + 2 * MiB), ctl + CW_XCH, args.in[15], (const float*)(args.ws + WS_MOD) + 5 * DM};
            pg8::gemm_phase<pg8::EpiNormOut, pg8::StaticOrder, true, true>(L, g, S, E); }
        else { pg8::EpiF16SS E{(h16*)(args.ws + WS_F), DM, (float*)(args.ws + WS_SSQ)};
        for (int rep = 0; rep < NREP(8); ++rep) pg8::gemm_phase<pg8::EpiF16SS, pg8::StaticOrder, true, true>(L, g, S, E); }
    }
    if (!fuse9) SEAM(8);
#if DIAG
    if (DIAG & 16) { FRESH(); diag_gemm<0>(ctl, (const h16*)(args.ws + WS_U), DFF, args.in[17], DM, args.ws + WS_F, 1.f, gw_, NGW, lane_, 13u); }
#endif
    if (IN(9) && !fuse9) { FRESH(); p9_rows(args, gw_, NGW, lane_); }
#if DIAG
    { xcd_barrier(bar); FRESH(); const unsigned long long dv = __hip_atomic_load((unsigned long long*)(ctl + CW_DIAG), __ATOMIC_RELAXED, __HIP_MEMORY_SCOPE_AGENT);
      const float mval = __uint_as_float((unsigned)(dv >> 32)); const unsigned pay = (unsigned)dv; const int pt = pay >> 8;
      float Cval = 1000.f * exp2f(ceilf(log2f(fmaxf(mval, 1e-12f))));
      if (DIAG_FIELD == 4) Cval = 10.f * (float)(1u + __hip_atomic_load(ctl + CW_DIAG + 4, __ATOMIC_RELAXED, __HIP_MEMORY_SCOPE_AGENT));
      if (DIAG_FIELD == 1) Cval = 10.f * (float)((pt >> 6) + 1);
      if (DIAG_FIELD == 2) Cval = 10.f * (float)((pt & 63) + 1);
      if (DIAG_FIELD == 3) Cval = 10.f * (float)(((pay >> 4) & 15) + 1);
      for (size_t e = (size_t)gw_ * 64 + lane_; e < (size_t)M * DM; e += (size_t)NGW * 64) args.out[e] = Cval; }
#endif
#undef IN
#undef SEAM
}

static void build_order(unsigned short* order) {
    struct It { int cost; unsigned short v; };
    It items[512]; int n = 0;
    for (int b = 0; b < 2; ++b) for (int g = 0; g < 2; ++g) for (int i = 0; i < 64; ++i) {
        const int ntc = ((4 * i + 2) >> 6) + 1; const int cost = 6 * ntc + 2 * (i + 1) + 2 * (i + 1 < 9 ? i + 1 : 9) + 40;
        items[n].cost = cost; items[n].v = (unsigned short)((b << 7) | (g << 6) | i); ++n; }
    for (int b = 0; b < 2; ++b) for (int h = 0; h < 8; ++h) for (int j = 0; j < 16; ++j) {
        items[n].cost = 2 * 4 * (j + 1) + 18; items[n].v = (unsigned short)(0x8000 | (b << 7) | (h << 4) | j); ++n; }
    for (int i = 1; i < 512; ++i) { It k = items[i]; int j = i - 1; while (j >= 0 && items[j].cost < k.cost) { items[j + 1] = items[j]; --j; } items[j + 1] = k; }
    if (1) { for (int i = 0; i < 512; ++i) order[i] = items[i].v; return; }
    const int NT = NT_ITEMS, TC = 7; long tot = (long)NT * TC; for (int i = 0; i < 512; ++i) tot += items[i].cost;
    const double tend = 0.8 * (double)tot / 256.0; int fr[256]; for (int w = 0; w < 256; ++w) fr[w] = 0;
    int nA = 0, nT = 0; n = 0;
    while (nA < 512 || nT < NT) {
        int w = 0; for (int u = 1; u < 256; ++u) if (fr[u] < fr[w]) w = u;
        const double tgt = 24.0 + (NT - 24) * (double)fr[w] / tend;
        if (nT < NT && (nA >= 512 || (double)nT < tgt)) { order[n++] = (unsigned short)(0x4000 | nT); ++nT; fr[w] += TC; }
        else { order[n++] = items[nA].v; fr[w] += items[nA].cost; ++nA; }
    }
}

extern "C" void kernel_launch(void* const* d_in, const int* in_sizes, int n_in, void* d_out, int out_size, void* d_ws, size_t ws_size, hipStream_t stream) {
    static int grid = 0; static Args a;
    if (grid == 0) {
        if (n_in != 18 || in_sizes[0] != M * DM || out_size != M * DM || ws_size < WS_END) { fprintf(stderr, "kernel_launch: unexpected shapes (n_in %d, in0 %d, out %d, ws %zu)\n", n_in, n_in > 0 ? in_sizes[0] : -1, out_size, ws_size); grid = -1; return; }
        int dev = 0, cus = 0, per_cu = 0;
        if (hipGetDevice(&dev) != hipSuccess || hipDeviceGetAttribute(&cus, hipDeviceAttributeMultiprocessorCount, dev) != hipSuccess) { grid = -1; return; }
        if (hipFuncSetAttribute((const void*)hymba_fwd, hipFuncAttributeMaxDynamicSharedMemorySize, LDS_BYTES) != hipSuccess) { fprintf(stderr, "kernel_launch: hipFuncSetAttribute failed\n"); grid = -1; return; }
        if (hipOccupancyMaxActiveBlocksPerMultiprocessor(&per_cu, (const void*)hymba_fwd, NWAVES * 64, LDS_BYTES) != hipSuccess || per_cu < 1) { fprintf(stderr, "kernel_launch: occupancy query says %d\n", per_cu); }
        (void)hipGetLastError();
        grid = cus;
        memset(&a, 0, sizeof(a));
        build_order(a.order);
    }
    if (grid < 0) return;
    (void)hipMemsetAsync((char*)d_ws + WS_CTL, 0, CTL_ZERO_BYTES, stream);
    for (int i = 0; i < 18; ++i) a.in[i] = (const float*)d_in[i];
    a.out = (float*)d_out; a.ws = (unsigned char*)d_ws;
    if (MK_N_LAUNCHES == 1) {
        a.ph_lo = 0; a.ph_hi = 10;
        void* params[] = {&a};
        hipError_t e = hipLaunchCooperativeKernel((const void*)hymba_fwd, dim3(grid), dim3(NWAVES * 64), params, LDS_BYTES, stream);
        if (e != hipSuccess) fprintf(stderr, "kernel_launch: cooperative launch failed: %s (grid %d)\n", hipGetErrorString(e), grid);
    } else {
        for (int p = 0; p < 10; ++p) { a.ph_lo = p; a.ph_hi = p + 1; hipLaunchKernelGGL(hymba_fwd, dim3(grid), dim3(NWAVES * 64), LDS_BYTES, stream, a); }
    }
}
```

```cpp
#include <hip/hip_runtime.h>
#include <cstdio>
#include <cstdint>
#include <cmath>
#include <cstring>

#ifndef DIAG
#define DIAG 0
#endif
#ifndef DIAG_SELCMP
#define DIAG_SELCMP 1
#endif
#ifndef PROBE_VAR
#define PROBE_VAR 2
#endif
#ifndef REPEAT_PH
#define REPEAT_PH -1
#ifndef T_P2_ITEMS
#define T_P2_ITEMS 6
#endif
#ifndef P0_BAL
#define P0_BAL 1
#endif
#ifndef WGM_P7
#define WGM_P7 2
#endif
#ifndef WGM_P2
#define WGM_P2 4
#endif
#ifndef P34_HANDOFF
#define P34_HANDOFF 1
#endif
#ifndef P78_HANDOFF
#define P78_HANDOFF 1
#endif
#ifndef GV_Q
#define GV_Q 1
#endif
#ifndef P3_SPLITK
#define P3_SPLITK 1
#endif
#ifndef FUSE_P9
#define FUSE_P9 1
#endif
#ifndef FUSE_P6
#define FUSE_P6 1
#endif
#endif
#ifndef MK_N_LAUNCHES
#define MK_N_LAUNCHES 1
#endif

typedef _Float16 h16;
typedef _Float16 h16x2 __attribute__((ext_vector_type(2)));
typedef _Float16 h16x8 __attribute__((ext_vector_type(8)));
typedef float f32x2 __attribute__((ext_vector_type(2)));
typedef float f32x4 __attribute__((ext_vector_type(4)));
typedef float f32x16 __attribute__((ext_vector_type(16)));
typedef unsigned u32x2 __attribute__((ext_vector_type(2)));
typedef unsigned u32x4 __attribute__((ext_vector_type(4)));
typedef short s16x4 __attribute__((ext_vector_type(4)));
typedef short s16x8 __attribute__((ext_vector_type(8)));

#define LAS __attribute__((address_space(3)))
#define GAS __attribute__((address_space(1)))

__device__ __forceinline__ unsigned pk2h(float lo, float hi) { f32x2 v = {lo, hi}; h16x2 h = __builtin_convertvector(v, h16x2); return __builtin_bit_cast(unsigned, h); }

constexpr int BATCH = 2, SEQ = 4096, DM = 2048, M = BATCH * SEQ, DFF = 8192, HD = 128;
constexpr int INCOLS = 5656, NQKV = 5632, NPAD = 5888;
constexpr int C_QN = 0, C_KCMP = 1024, C_VCMP = 1280, C_KSEL = 1536, C_VSEL = 1792, C_KWIN = 2048, C_VWIN = 2304, C_QM = 2560, C_KM = 3584, C_VM = 4608;
constexpr float EPS = 1e-6f;
constexpr float QSCALE = 0.08838834764831845f;
constexpr float LOG2E = 1.4426950408889634f;

constexpr size_t MiB = 1u << 20;
constexpr size_t WS_CTL = 0, CTL_ZERO_BYTES = 1 * MiB;
constexpr size_t WS_MOD = 512 * 1024;
constexpr size_t WS_POSB = 768 * 1024;
constexpr size_t WS_KMEAN = 1 * MiB + 64 * 1024;
constexpr size_t WS_KC = 1 * MiB + 512 * 1024;
constexpr size_t WS_COS = 2 * MiB, WS_SIN = 3 * MiB;
constexpr size_t WS_W1T = 4 * MiB;
constexpr size_t WS_W2T = 6 * MiB;
constexpr size_t WS_GATE = 6 * MiB + 512 * 1024;
constexpr size_t WS_SSQ = 328 * MiB;
constexpr size_t WS_WIN = 8 * MiB;
constexpr size_t WS_WO = 32 * MiB;
constexpr size_t WS_WUP = 40 * MiB;
constexpr size_t WS_WDN = 72 * MiB;
constexpr size_t WS_H = 104 * MiB;
constexpr size_t WS_QKV = 136 * MiB;
constexpr size_t WS_O = 224 * MiB;
constexpr size_t WS_OP = 256 * MiB;
constexpr size_t WS_U = 136 * MiB;
constexpr size_t WS_X1 = 296 * MiB;
constexpr size_t WS_F = 264 * MiB;
constexpr size_t WS_END = 331 * MiB;
constexpr int CW_QUEUE = 64;
constexpr int CW_XCH = 8192;
constexpr int CW_P34 = 16384;
constexpr int CW_P78 = 18432;
constexpr int CW_BAR = 4096;

__device__ __forceinline__ f32x4 unpack4h(u32x2 w) { const unsigned wx = w[0], wy = w[1];
    const h16x2 a = __builtin_bit_cast(h16x2, wx), b = __builtin_bit_cast(h16x2, wy); return (f32x4){(float)a.x, (float)a.y, (float)b.x, (float)b.y}; }

namespace pg8 {
constexpr int BM = 256, BK = 64, HALF = 128, HTB = HALF * BK * 2, STAGE_BYTES = 8 * HTB, NXCD = 8, WGM = 2;
__host__ __device__ __forceinline__ int lds_byte(int r, int c) { const int st = (r >> 4) * 2 + (c >> 5), rr = r & 15, cc = c & 31, ob = rr * 64 + cc * 2; return st * 1024 + (ob ^ (((ob >> 9) & 1) << 5)); }
__host__ __device__ __forceinline__ void stage_rc(int b, int& R, int& C) { const int st = b / 1024, sb = b % 1024, swz = sb ^ (((sb >> 9) & 1) << 5); R = (st >> 1) * 16 + swz / 64; C = (st & 1) * 32 + (swz % 64) / 2; }
__host__ __device__ __forceinline__ int perm32(int rho) { const int n = rho >> 4, i = rho & 15; return 8 * (i >> 2) + 4 * n + (i & 3); }
struct Unit { int pm, pn; };
struct Gemm { const h16* A; const h16* Bt; int M, N, K; };
struct StaticOrder {
    int nM, nN, nwg, G, c, wgm;
    __host__ __device__ void init(int M_, int N_, int G_, int c_, int wgm_ = WGM) { nM = M_ / BM; nN = N_ / BM; nwg = nM * nN; G = G_; c = c_; wgm = wgm_; }
    __host__ __device__ bool next(int i, Unit& u) const {
        const long L = (long)i * G + c; if (L >= nwg) return false;
        int wgid = (int)L; { const int q = nwg / NXCD, r = nwg % NXCD, xcd = wgid % NXCD, off = wgid / NXCD; wgid = (xcd < r ? xcd * (q + 1) : r * (q + 1) + (xcd - r) * q) + off; }
        const int nig = wgm * nN, gid = wgid / nig, fm = gid * wgm, gsz = (nM - fm) < wgm ? (nM - fm) : wgm;
        u.pm = fm + ((wgid % nig) % gsz); u.pn = (wgid % nig) / gsz; return true;
    }
};
template <class Epi, class Sched, bool ALIGN_EPI, bool SP2>
__device__ __forceinline__ void gemm_phase(LAS unsigned char* lds, const Gemm g, const Sched& S, const Epi& E) {
    const int tid = threadIdx.x, wid = __builtin_amdgcn_readfirstlane(tid >> 6), lane = tid & 63, wr = wid >> 2, wc = wid & 3, fr = lane & 15, fq = lane >> 4;
    const int K = g.K, nt = K / BK;
    unsigned voffA[2], voffB[2];
#pragma unroll
    for (int i = 0; i < 2; ++i) { int R, C; stage_rc(tid * 16 + i * 8192, R, C); const int Rb = Epi::PERM ? ((R & ~31) + perm32(R & 31)) : R;
        voffA[i] = (unsigned)(R * K + C) * 2u; voffB[i] = (unsigned)(Rb * K + C) * 2u; }
    const size_t kstep = (size_t)(BK * 2);
    const size_t hstep = (size_t)HALF * K * 2;
    const size_t tstep = 2 * hstep;
    const unsigned ldsw = (unsigned)wid * 1024u;
    const int aoff = lds_byte(wr * 64 + fr, fq * 8), boff = lds_byte(wc * 32 + fr, fq * 8);
#define PG8_SA(b, h) (((b) * 2 + (h)) * HTB)
#define PG8_SB(b, h) ((4 + (b) * 2 + (h)) * HTB)
#define PG8_STAGE(bufoff, gbase, voff) do { _Pragma("unroll") for (int _i = 0; _i < 2; ++_i) \
        __builtin_amdgcn_global_load_lds((const unsigned*)((const char*)(gbase) + (voff)[_i]), (LAS unsigned*)(lds + (bufoff) + ldsw + _i * 8192), 16, 0, 0); } while (0)
#define PG8_LDA(dst, b, h) do { _Pragma("unroll") for (int m = 0; m < 4; ++m) _Pragma("unroll") for (int k = 0; k < 2; ++k) dst[m][k] = *(const LAS h16x8*)(lds + PG8_SA(b, h) + aoff + m * 2048 + k * 1024); } while (0)
#define PG8_LDB(dst, b, h) do { _Pragma("unroll") for (int n = 0; n < 2; ++n) _Pragma("unroll") for (int k = 0; k < 2; ++k) dst[n][k] = *(const LAS h16x8*)(lds + PG8_SB(b, h) + boff + n * 2048 + k * 1024); } while (0)
#define PG8_MMA(ai, bj, At, Bt) do { __builtin_amdgcn_s_setprio(1); _Pragma("unroll") for (int m = 0; m < 4; ++m) _Pragma("unroll") for (int n = 0; n < 2; ++n) _Pragma("unroll") for (int k = 0; k < 2; ++k) \
        acc[ai][bj][m][n] = __builtin_amdgcn_mfma_f32_16x16x32_f16(Bt[n][k], At[m][k], acc[ai][bj][m][n], 0, 0, 0); __builtin_amdgcn_s_setprio(0); } while (0)
#define PG8_WAIT_V(n) asm volatile("s_waitcnt vmcnt(" #n ")" ::: "memory")
#define PG8_WAIT_L(n) asm volatile("s_waitcnt lgkmcnt(" #n ")" ::: "memory")
#define PG8_BAR __builtin_amdgcn_s_barrier()
#define PG8_SCHED __builtin_amdgcn_sched_barrier(0)
    Unit cur, nxt; int ui = 0;
    if (!S.next(0, cur)) return;
    f32x4 acc[2][2][4][2];
#pragma unroll
    for (int a = 0; a < 2; ++a)
#pragma unroll
        for (int b = 0; b < 2; ++b)
#pragma unroll
            for (int m = 0; m < 4; ++m)
#pragma unroll
                for (int n = 0; n < 2; ++n) acc[a][b][m][n] = (f32x4){0.f, 0.f, 0.f, 0.f};
    h16x8 At[4][2], B0[2][2], B1[2][2];
    const char* cA = (const char*)g.A + (size_t)cur.pm * tstep; const char* cB = (const char*)g.Bt + (size_t)cur.pn * tstep;
    if constexpr (SP2) {
        PG8_STAGE(PG8_SB(0, 0), cB, voffB); PG8_STAGE(PG8_SB(0, 1), cB + hstep, voffB); PG8_STAGE(PG8_SA(0, 0), cA, voffA); PG8_STAGE(PG8_SA(0, 1), cA + hstep, voffA);
        if (wr == 1) PG8_BAR;
        PG8_WAIT_V(2); PG8_BAR;
        PG8_STAGE(PG8_SB(1, 0), cB + kstep, voffB); PG8_STAGE(PG8_SA(1, 0), cA + kstep, voffA); PG8_STAGE(PG8_SB(1, 1), cB + hstep + kstep, voffB);
        PG8_WAIT_V(6); PG8_BAR;
    } else {
        PG8_STAGE(PG8_SB(0, 0), cB, voffB); PG8_STAGE(PG8_SA(0, 0), cA, voffA); PG8_STAGE(PG8_SB(0, 1), cB + hstep, voffB); PG8_STAGE(PG8_SA(0, 1), cA + hstep, voffA);
        if (wr == 1) PG8_BAR;
        PG8_WAIT_V(4); PG8_BAR;
        PG8_STAGE(PG8_SB(1, 0), cB + kstep, voffB); PG8_STAGE(PG8_SA(1, 0), cA + kstep, voffA); PG8_STAGE(PG8_SB(1, 1), cB + hstep + kstep, voffB);
        PG8_WAIT_V(6); PG8_BAR;
    }
    for (;;) {
        const bool has_next = S.next(ui + 1, nxt);
        const char* nA = has_next ? (const char*)g.A + (size_t)nxt.pm * tstep : cA; const char* nB = has_next ? (const char*)g.Bt + (size_t)nxt.pn * tstep : cB;
        for (int t = 0; t < nt; t += 2) {
            const bool last = (t == nt - 2);
            const char* a1 = cA + (size_t)(t + 1) * kstep;
            const char* a2 = last ? nA : cA + (size_t)(t + 2) * kstep; const char* b2 = last ? nB : cB + (size_t)(t + 2) * kstep;
            const char* a3 = a2 + kstep; const char* b3 = b2 + kstep;
            if constexpr (SP2) {
            PG8_LDB(B0, 0, 0); PG8_LDB(B1, 0, 1); PG8_SCHED; PG8_LDA(At, 0, 0); PG8_STAGE(PG8_SA(1, 1), a1 + hstep, voffA);
            PG8_WAIT_V(8); PG8_WAIT_L(0); PG8_BAR; PG8_MMA(0, 0, At, B0); PG8_MMA(0, 1, At, B1); PG8_BAR; PG8_SCHED;
            PG8_LDA(At, 0, 1); PG8_STAGE(PG8_SB(0, 0), b2, voffB); PG8_STAGE(PG8_SB(0, 1), b2 + hstep, voffB); PG8_STAGE(PG8_SA(0, 0), a2, voffA);
            PG8_WAIT_V(8); PG8_WAIT_L(0); PG8_BAR; PG8_MMA(1, 0, At, B0); PG8_MMA(1, 1, At, B1); PG8_BAR; PG8_SCHED;
            PG8_LDB(B0, 1, 0); PG8_LDB(B1, 1, 1); PG8_SCHED; PG8_LDA(At, 1, 0); PG8_STAGE(PG8_SA(0, 1), a2 + hstep, voffA);
            PG8_WAIT_V(8); PG8_WAIT_L(0); PG8_BAR; PG8_MMA(0, 0, At, B0); PG8_MMA(0, 1, At, B1); PG8_BAR; PG8_SCHED;
            PG8_LDA(At, 1, 1); PG8_STAGE(PG8_SB(1, 0), b3, voffB); PG8_STAGE(PG8_SB(1, 1), b3 + hstep, voffB); PG8_STAGE(PG8_SA(1, 0), a3, voffA);
            PG8_WAIT_V(8); PG8_WAIT_L(0); PG8_BAR; PG8_MMA(1, 0, At, B0); PG8_MMA(1, 1, At, B1); PG8_BAR; PG8_SCHED;
            } else {
            PG8_LDB(B0, 0, 0); PG8_SCHED; PG8_LDA(At, 0, 0); PG8_STAGE(PG8_SA(1, 1), a1 + hstep, voffA);
            PG8_WAIT_L(8); PG8_BAR; PG8_WAIT_L(0); PG8_MMA(0, 0, At, B0); PG8_BAR; PG8_SCHED;
            PG8_LDB(B1, 0, 1); PG8_STAGE(PG8_SB(0, 0), b2, voffB);
            PG8_BAR; PG8_WAIT_L(0); PG8_MMA(0, 1, At, B1); PG8_BAR;
            PG8_LDA(At, 0, 1); PG8_STAGE(PG8_SA(0, 0), a2, voffA);
            PG8_BAR; PG8_WAIT_L(0); PG8_MMA(1, 0, At, B0); PG8_BAR; PG8_SCHED;
            PG8_STAGE(PG8_SB(0, 1), b2 + hstep, voffB);
            PG8_WAIT_V(6); PG8_BAR; PG8_MMA(1, 1, At, B1); PG8_BAR;
            PG8_LDB(B0, 1, 0); PG8_SCHED; PG8_LDA(At, 1, 0); PG8_STAGE(PG8_SA(0, 1), a2 + hstep, voffA);
            PG8_WAIT_L(8); PG8_BAR; PG8_WAIT_L(0); PG8_MMA(0, 0, At, B0); PG8_BAR; PG8_SCHED;
            PG8_LDB(B1, 1, 1); PG8_STAGE(PG8_SB(1, 0), b3, voffB);
            PG8_BAR; PG8_WAIT_L(0); PG8_MMA(0, 1, At, B1); PG8_BAR;
            PG8_LDA(At, 1, 1); PG8_STAGE(PG8_SA(1, 0), a3, voffA);
            PG8_BAR; PG8_WAIT_L(0); PG8_MMA(1, 0, At, B0); PG8_BAR; PG8_SCHED;
            PG8_STAGE(PG8_SB(1, 1), b3 + hstep, voffB);
            PG8_WAIT_V(6); PG8_BAR; PG8_MMA(1, 1, At, B1); PG8_BAR;
            }
        }
        if constexpr (ALIGN_EPI) { if (wr == 0) PG8_BAR; }
        if constexpr (!Epi::AFTER_DRAIN) E(acc, cur, wr, wc, fr, fq);
        if (!has_next) break;
#pragma unroll
        for (int a = 0; a < 2; ++a)
#pragma unroll
            for (int b = 0; b < 2; ++b)
#pragma unroll
                for (int m = 0; m < 4; ++m)
#pragma unroll
                    for (int n = 0; n < 2; ++n) acc[a][b][m][n] = (f32x4){0.f, 0.f, 0.f, 0.f};
        cur = nxt; cA = nA; cB = nB; ++ui;
        if constexpr (ALIGN_EPI) { if (wr == 1) PG8_BAR; }
    }
    PG8_WAIT_V(0);
    if constexpr (!ALIGN_EPI) { if (wr == 0) PG8_BAR; }
    PG8_BAR;
    if constexpr (Epi::AFTER_DRAIN) E.fused(acc, cur, wr, wc, fr, fq, lds, wid, lane);
#undef PG8_SA
#undef PG8_SB
#undef PG8_STAGE
#undef PG8_LDA
#undef PG8_LDB
#undef PG8_MMA
#undef PG8_WAIT_V
#undef PG8_WAIT_L
#undef PG8_BAR
#undef PG8_SCHED
}

__device__ __forceinline__ bool is_rope_tile(int pn) { return pn < 4 || pn == 4 || pn == 6 || pn == 8 || (pn >= 10 && pn < 18); }
__device__ __forceinline__ bool is_q_tile(int pn) { return pn < 4 || (pn >= 10 && pn < 14); }
struct EpiQKV {
    static constexpr bool PERM = true, AFTER_DRAIN = false;
    h16* QKV; float* G; const float* COS; const float* SIN;
    __device__ __forceinline__ void operator()(const f32x4 (&acc)[2][2][4][2], const Unit& u, int wr, int wc, int fr, int fq) const {
        const int pn = u.pn;
        const int row0 = u.pm * BM + wr * 64 + fr;
        if (pn == 22) {
            if (wc == 0 && fq < 3) {
#pragma unroll
                for (int ai = 0; ai < 2; ++ai)
#pragma unroll
                    for (int m = 0; m < 4; ++m) { const int row = row0 + ai * HALF + m * 16; float* gp = G + (size_t)row * 24 + 8 * fq;
                        f32x4 v0 = acc[ai][0][m][0], v1 = acc[ai][0][m][1];
#pragma unroll
                        for (int e = 0; e < 4; ++e) { v0[e] = 1.f / (1.f + __expf(-v0[e])); v1[e] = 1.f / (1.f + __expf(-v1[e])); }
                        *(f32x4*)gp = v0; *(f32x4*)(gp + 4) = v1; }
            }
            return;
        }
        if (is_rope_tile(pn)) {
            const float sc = is_q_tile(pn) ? QSCALE : 1.f;
            const int a4 = 4 * (4 * wc + fq);
#pragma unroll
            for (int ai = 0; ai < 2; ++ai)
#pragma unroll
                for (int m = 0; m < 4; ++m) { const int row = row0 + ai * HALF + m * 16; const int t = row & (SEQ - 1);
                    const f32x4 c4 = *(const f32x4*)(COS + t * 64 + a4), s4 = *(const f32x4*)(SIN + t * 64 + a4);
                    h16* rowp = QKV + (size_t)row * NQKV + pn * BM + a4;
#pragma unroll
                    for (int bj = 0; bj < 2; ++bj) { const f32x4 x1 = acc[ai][bj][m][0], x2 = acc[ai][bj][m][1];
                        const f32x4 o1 = (x1 * c4 - x2 * s4) * sc, o2 = (x2 * c4 + x1 * s4) * sc;
                        u32x2 w1; w1.x = pk2h(o1[0], o1[1]); w1.y = pk2h(o1[2], o1[3]);
                        u32x2 w2; w2.x = pk2h(o2[0], o2[1]); w2.y = pk2h(o2[2], o2[3]);
                        const auto r0 = __builtin_amdgcn_permlane16_swap(w1.x, w2.x, false, false); const auto r1 = __builtin_amdgcn_permlane16_swap(w1.y, w2.y, false, false);
                        const u32x4 wq = {r0[0], r1[0], r0[1], r1[1]};
                        *(u32x4*)(rowp + bj * HALF + ((fq & 1) ? 60 : 0)) = wq; } }
        } else {
            const int col0 = pn * BM + wc * 32 + 8 * fq;
#pragma unroll
            for (int ai = 0; ai < 2; ++ai)
#pragma unroll
                for (int m = 0; m < 4; ++m) { h16* rowp = QKV + (size_t)(row0 + ai * HALF + m * 16) * NQKV + col0;
#pragma unroll
                    for (int bj = 0; bj < 2; ++bj) { const f32x4 v0 = acc[ai][bj][m][0], v1 = acc[ai][bj][m][1];
                        u32x4 w; w.x = pk2h(v0[0], v0[1]); w.y = pk2h(v0[2], v0[3]); w.z = pk2h(v1[0], v1[1]); w.w = pk2h(v1[2], v1[3]);
                        *(u32x4*)(rowp + bj * HALF) = w; } }
        }
    }
};
struct EpiF16SS {
    static constexpr bool PERM = true, AFTER_DRAIN = false;
    h16* C; int ldc; float* SSQ;
    __device__ __forceinline__ void operator()(const f32x4 (&acc)[2][2][4][2], const Unit& u, int wr, int wc, int fr, int fq) const {
        const int row0 = u.pm * BM + wr * 64 + fr, col0 = u.pn * BM + wc * 32 + 8 * fq;
#pragma unroll
        for (int ai = 0; ai < 2; ++ai)
#pragma unroll
            for (int m = 0; m < 4; ++m) { const int row = row0 + ai * HALF + m * 16; h16* rowp = C + (size_t)row * ldc + col0; float s = 0.f;
#pragma unroll
                for (int bj = 0; bj < 2; ++bj) { const f32x4 v0 = acc[ai][bj][m][0], v1 = acc[ai][bj][m][1];
                    s += ((v0[0] * v0[0] + v0[1] * v0[1]) + (v0[2] * v0[2] + v0[3] * v0[3])) + ((v1[0] * v1[0] + v1[1] * v1[1]) + (v1[2] * v1[2] + v1[3] * v1[3]));
                    u32x4 w; w.x = pk2h(v0[0], v0[1]); w.y = pk2h(v0[2], v0[3]); w.z = pk2h(v1[0], v1[1]); w.w = pk2h(v1[2], v1[3]);
                    *(u32x4*)(rowp + bj * HALF) = w; }
                s += __shfl_xor(s, 16); s += __shfl_xor(s, 32);
                if (fq == 0) SSQ[(size_t)row * 32 + u.pn * 4 + wc] = s; }
    }
};
struct EpiRelu2 {
    static constexpr bool PERM = true, AFTER_DRAIN = false;
    h16* O; int ldc;
    __device__ __forceinline__ void operator()(const f32x4 (&acc)[2][2][4][2], const Unit& u, int wr, int wc, int fr, int fq) const {
        const int row0 = u.pm * BM + wr * 64 + fr, col0 = u.pn * BM + wc * 32 + 8 * fq;
#pragma unroll
        for (int ai = 0; ai < 2; ++ai)
#pragma unroll
            for (int m = 0; m < 4; ++m) { h16* rowp = O + (size_t)(row0 + ai * HALF + m * 16) * ldc + col0;
#pragma unroll
                for (int bj = 0; bj < 2; ++bj) { f32x4 v0 = acc[ai][bj][m][0], v1 = acc[ai][bj][m][1];
#pragma unroll
                    for (int e = 0; e < 4; ++e) { const float a = fmaxf(v0[e], 0.f), b = fmaxf(v1[e], 0.f); v0[e] = a * a; v1[e] = b * b; }
                    u32x4 w; w.x = pk2h(v0[0], v0[1]); w.y = pk2h(v0[2], v0[3]); w.z = pk2h(v1[0], v1[1]); w.w = pk2h(v1[2], v1[3]);
                    { const h16* sp_ = rowp + bj * HALF; asm volatile("global_store_dwordx4 %0, %1, off sc0 sc1\n\ts_nop 2" :: "v"(sp_), "v"(w) : "memory"); } } }
    }
};
__device__ __forceinline__ void row_exchange(const f32x4 (&acc)[2][2][4][2], float* X8, unsigned* cntw, const Unit& u, LAS unsigned char* lds, int wid, int lane, int wr, int wc, int fr, int fq) {
        LAS float* P = (LAS float*)(lds + 4096);
        LAS float* S = (LAS float*)lds;
#pragma unroll
        for (int ai = 0; ai < 2; ++ai)
#pragma unroll
            for (int m = 0; m < 4; ++m) { float s = 0.f;
#pragma unroll
                for (int bj = 0; bj < 2; ++bj) { const f32x4 v0 = acc[ai][bj][m][0], v1 = acc[ai][bj][m][1];
                    s += ((v0[0] * v0[0] + v0[1] * v0[1]) + (v0[2] * v0[2] + v0[3] * v0[3])) + ((v1[0] * v1[0] + v1[1] * v1[1]) + (v1[2] * v1[2] + v1[3] * v1[3])); }
                s += __shfl_xor(s, 16); s += __shfl_xor(s, 32);
                if (fq == 0) P[(ai * HALF + wr * 64 + m * 16 + fr) * 4 + wc] = s; }
        asm volatile("s_waitcnt lgkmcnt(0)" ::: "memory"); __builtin_amdgcn_s_barrier(); asm volatile("" ::: "memory");
        if (lane < 32) { const f32x4 p4 = *(const LAS f32x4*)(P + (wid * 32 + lane) * 4);
            __hip_atomic_store((unsigned*)X8 + (size_t)(u.pm * BM + wid * 32 + lane) * 8 + u.pn, __float_as_uint((p4[0] + p4[1]) + (p4[2] + p4[3])), __ATOMIC_RELAXED, __HIP_MEMORY_SCOPE_AGENT); }
        asm volatile("s_waitcnt vmcnt(0)" ::: "memory");
        if (lane == 0) __hip_atomic_fetch_add(cntw, 1u, __ATOMIC_RELAXED, __HIP_MEMORY_SCOPE_AGENT);
        if (wid == 0) { unsigned sp = 0u;
            while ((unsigned)__builtin_amdgcn_readfirstlane((int)__hip_atomic_load(cntw, __ATOMIC_RELAXED, __HIP_MEMORY_SCOPE_AGENT)) < 64u) { __builtin_amdgcn_s_sleep(1); if (++sp > (1u << 22)) break; }
            __builtin_amdgcn_fence(__ATOMIC_ACQUIRE, "agent"); }
        asm volatile("s_waitcnt vmcnt(0) lgkmcnt(0)" ::: "memory"); __builtin_amdgcn_s_barrier(); asm volatile("" ::: "memory");
        { const float* p = X8 + (size_t)(u.pm * BM + wid * 32 + (lane & 31)) * 8 + (lane >> 5) * 4; f32x4 q0;
            asm volatile("global_load_dwordx4 %0, %1, off sc1\n\ts_waitcnt vmcnt(0)" : "=&v"(q0) : "v"(p) : "memory");
            float ts = (q0[0] + q0[1]) + (q0[2] + q0[3]); ts += __shfl_xor(ts, 32);
            if (lane < 32) S[wid * 32 + lane] = 1.f / sqrtf(ts * (1.f / DM) + EPS); }
        asm volatile("s_waitcnt lgkmcnt(0)" ::: "memory"); __builtin_amdgcn_s_barrier(); asm volatile("" ::: "memory");
}
struct EpiNormOut {
    static constexpr bool PERM = true, AFTER_DRAIN = true;
    const h16* X1; float* OUT; float* SSQ; unsigned* cnt; const float* gpost; const float* gatef;
    __device__ __forceinline__ void fused(const f32x4 (&acc)[2][2][4][2], const Unit& u, int, int, int, int, LAS unsigned char* lds, int, int) const {
        int tid = threadIdx.x; asm volatile("" : "+v"(tid));
        const int wid = __builtin_amdgcn_readfirstlane(tid >> 6), lane = tid & 63, wr = wid >> 2, wc = wid & 3, fr = lane & 15, fq = lane >> 4;
        const int row0 = u.pm * BM + wr * 64 + fr, col0 = u.pn * BM + wc * 32 + 8 * fq;
        row_exchange(acc, SSQ, cnt + 64 * u.pm, u, lds, wid, lane, wr, wc, fr, fq);
        const LAS float* S = (const LAS float*)lds;
        u32x4 xr[2][4][2];
#pragma unroll
        for (int m = 0; m < 4; ++m)
#pragma unroll
            for (int bj = 0; bj < 2; ++bj) xr[0][m][bj] = __builtin_nontemporal_load((const u32x4*)(X1 + ((unsigned)(row0 * DM + col0) + (unsigned)(m * 16 * DM + bj * HALF))));
#pragma unroll
        for (int m = 0; m < 4; ++m)
#pragma unroll
            for (int bj = 0; bj < 2; ++bj) xr[1][m][bj] = __builtin_nontemporal_load((const u32x4*)(X1 + ((unsigned)(row0 * DM + col0) + (unsigned)((HALF + m * 16) * DM + bj * HALF))));
        const float* gfb = gatef + (size_t)(u.pm >> 4) * 6 * DM;
        f32x4 cf[2][2];
#pragma unroll
        for (int bj = 0; bj < 2; ++bj)
#pragma unroll
            for (int n = 0; n < 2; ++n) cf[bj][n] = *(const f32x4*)(gpost + col0 + bj * HALF + 4 * n) * *(const f32x4*)(gfb + col0 + bj * HALF + 4 * n);
        const unsigned eo = (unsigned)(row0 * DM + col0);
#pragma unroll
        for (int ai = 0; ai < 2; ++ai)
#pragma unroll
            for (int m = 0; m < 4; ++m) { const float rstd = S[ai * HALF + wr * 64 + m * 16 + fr]; const unsigned o = eo + (unsigned)((ai * HALF + m * 16) * DM);
#pragma unroll
                for (int bj = 0; bj < 2; ++bj) { u32x4 xw = xr[ai][m][bj]; asm volatile("" : "+v"(xw));
                    const f32x4 x0 = unpack4h((u32x2){xw[0], xw[1]}), x1 = unpack4h((u32x2){xw[2], xw[3]});
                    __builtin_nontemporal_store(x0 + cf[bj][0] * (acc[ai][bj][m][0] * rstd), (f32x4*)(OUT + o + bj * HALF));
                    __builtin_nontemporal_store(x1 + cf[bj][1] * (acc[ai][bj][m][1] * rstd), (f32x4*)(OUT + o + bj * HALF + 4)); }
                asm volatile("" ::: "memory"); }
    }
};
struct EpiNormResNorm {
    static constexpr bool PERM = true, AFTER_DRAIN = true;
    const float* X; h16* X1; h16* H; float* SSQa; float* SSQb; unsigned* cnta; unsigned* cntb; const float* gpost; const float* gpre; const float* mod;
    __device__ __forceinline__ void fused(f32x4 (&acc)[2][2][4][2], const Unit& u, int, int, int, int, LAS unsigned char* lds, int, int) const {
        int tid = threadIdx.x; asm volatile("" : "+v"(tid));
        const int wid = __builtin_amdgcn_readfirstlane(tid >> 6), lane = tid & 63, wr = wid >> 2, wc = wid & 3, fr = lane & 15, fq = lane >> 4;
        const int row0 = u.pm * BM + wr * 64 + fr, col0 = u.pn * BM + wc * 32 + 8 * fq;
        const unsigned eo = (unsigned)(row0 * DM + col0);
        const float* mb = mod + (size_t)(u.pm >> 4) * 6 * DM;
        const LAS float* S = (const LAS float*)lds;
        row_exchange(acc, SSQa, cnta + 64 * u.pm, u, lds, wid, lane, wr, wc, fr, fq);
        { f32x4 cf[2][2];
#pragma unroll
          for (int bj = 0; bj < 2; ++bj)
#pragma unroll
            for (int n = 0; n < 2; ++n) cf[bj][n] = *(const f32x4*)(gpost + col0 + bj * HALF + 4 * n) * *(const f32x4*)(mb + 2 * DM + col0 + bj * HALF + 4 * n);
#pragma unroll
          for (int ai = 0; ai < 2; ++ai) { f32x4 xv[4][2][2];
#pragma unroll
            for (int m = 0; m < 4; ++m)
#pragma unroll
                for (int bj = 0; bj < 2; ++bj)
#pragma unroll
                    for (int n = 0; n < 2; ++n) xv[m][bj][n] = __builtin_nontemporal_load((const f32x4*)(X + (eo + (unsigned)((ai * HALF + m * 16) * DM + bj * HALF + 4 * n))));
#pragma unroll
            for (int m = 0; m < 4; ++m) { const float rstd = S[ai * HALF + wr * 64 + m * 16 + fr]; const unsigned o = eo + (unsigned)((ai * HALF + m * 16) * DM);
#pragma unroll
                for (int bj = 0; bj < 2; ++bj) { f32x4 x0 = xv[m][bj][0], x1 = xv[m][bj][1]; asm volatile("" : "+v"(x0), "+v"(x1));
                    const f32x4 v0 = x0 + cf[bj][0] * (acc[ai][bj][m][0] * rstd), v1 = x1 + cf[bj][1] * (acc[ai][bj][m][1] * rstd);
                    acc[ai][bj][m][0] = v0; acc[ai][bj][m][1] = v1;
                    u32x4 w; w.x = pk2h(v0[0], v0[1]); w.y = pk2h(v0[2], v0[3]); w.z = pk2h(v1[0], v1[1]); w.w = pk2h(v1[2], v1[3]);
                    *(u32x4*)(X1 + o + bj * HALF) = w; }
                asm volatile("" ::: "memory"); } } }
        row_exchange(acc, SSQb, cntb + 64 * u.pm, u, lds, wid, lane, wr, wc, fr, fq);
        { f32x4 ca[2][2], cs[2][2];
#pragma unroll
          for (int bj = 0; bj < 2; ++bj)
#pragma unroll
            for (int n = 0; n < 2; ++n) { const int c = col0 + bj * HALF + 4 * n; ca[bj][n] = *(const f32x4*)(gpre + c) * (*(const f32x4*)(mb + 4 * DM + c) + 1.f); cs[bj][n] = *(const f32x4*)(mb + 3 * DM + c); }
#pragma unroll
          for (int ai = 0; ai < 2; ++ai)
#pragma unroll
            for (int m = 0; m < 4; ++m) { const float rstd = S[ai * HALF + wr * 64 + m * 16 + fr]; const unsigned o = eo + (unsigned)((ai * HALF + m * 16) * DM);
#pragma unroll
                for (int bj = 0; bj < 2; ++bj) { const f32x4 y0 = (acc[ai][bj][m][0] * rstd) * ca[bj][0] + cs[bj][0], y1 = (acc[ai][bj][m][1] * rstd) * ca[bj][1] + cs[bj][1];
                    u32x4 w; w.x = pk2h(y0[0], y0[1]); w.y = pk2h(y0[2], y0[3]); w.z = pk2h(y1[0], y1[1]); w.w = pk2h(y1[2], y1[3]);
                    *(u32x4*)(H + o + bj * HALF) = w; }
                asm volatile("" ::: "memory"); } }
    }
};
}

#define XB_TMO      128
#define XB_XCNT(j)  (256  + 64 * (j))
#define XB_XSUB(j)  (1280 + 64 * (j))
#define XB_XGEN(j)  (2304 + 64 * (j))
#define XB_TOP      3328
#define XB_TOPGEN   3392
#define XCD_BAR_WORDS 3456
#define XB_SPIN_CAP (1u << 20)
__device__ __forceinline__ unsigned xb_ld(unsigned* p)              { return __hip_atomic_load(p, __ATOMIC_RELAXED, __HIP_MEMORY_SCOPE_AGENT); }
__device__ __forceinline__ unsigned xb_add(unsigned* p, unsigned v) { return __hip_atomic_fetch_add(p, v, __ATOMIC_RELAXED, __HIP_MEMORY_SCOPE_AGENT); }
__device__ __forceinline__ unsigned xb_xcc_id() { return (unsigned)__builtin_amdgcn_s_getreg((3 << 11) | 20) & 0xFu; }
#define XB_SPIN(cond, bar) do { unsigned _sp = 0; while (cond) { __builtin_amdgcn_s_sleep(1); \
    if ((++_sp & 255u) == 0u) { if (xb_ld(&(bar)[XB_TMO])) break; if (_sp > XB_SPIN_CAP) { atomicAdd(&(bar)[XB_TMO], 1u); break; } } } } while (0)
struct XcdBarrier { unsigned* bar; unsigned x; volatile LAS unsigned* st; };
__device__ __forceinline__ XcdBarrier xcd_barrier_post(unsigned* bar, volatile LAS unsigned* st) {
    XcdBarrier b; b.bar = bar; b.x = xb_xcc_id(); b.st = st;
    if (threadIdx.x == 0) (void)xb_add(&bar[XB_XCNT(b.x)], 1u);
    return b;
}
__device__ __forceinline__ void xcd_barrier_complete(unsigned* bar, unsigned x, unsigned& nloc, unsigned& nx) {
    const unsigned G = gridDim.x * gridDim.y * gridDim.z;
    unsigned sum, cnt, mine, sp = 0u;
    for (;;) {
        sum = 0u; cnt = 0u; mine = 0u;
#pragma unroll
        for (unsigned j = 0; j < 16; ++j) { const unsigned c = xb_ld(&bar[XB_XCNT(j)]); sum += c; cnt += (c > 0u) ? 1u : 0u; mine = (j == x) ? c : mine; }
        if (sum == G) break;
        __builtin_amdgcn_s_sleep(1);
        if ((++sp & 255u) == 0u) { if (xb_ld(&bar[XB_TMO])) break; if (sp > XB_SPIN_CAP) { atomicAdd(&bar[XB_TMO], 1u); break; } }
    }
    nloc = mine > 0u ? mine : 1u; nx = cnt > 0u ? cnt : 1u;
}
__device__ __forceinline__ void xcd_barrier(const XcdBarrier& b) {
    asm volatile("s_waitcnt vmcnt(0)" ::: "memory");
    __syncthreads();
    if (threadIdx.x == 0) {
        unsigned* bar = b.bar;
        __builtin_amdgcn_s_waitcnt(0);
        unsigned nloc = b.st[0], nx = b.st[1];
        if (nloc == 0u) { xcd_barrier_complete(bar, b.x, nloc, nx); b.st[0] = nloc; b.st[1] = nx; }
        const unsigned old = xb_add(&bar[XB_XSUB(b.x)], 1u);
        const unsigned gen = old / nloc;
        if (old + 1u == (gen + 1u) * nloc) {
            __builtin_amdgcn_fence(__ATOMIC_RELEASE, "agent");
            asm volatile("s_waitcnt vmcnt(0)" ::: "memory");
            const unsigned og = xb_add(&bar[XB_TOP], 1u);
            const unsigned tg = og / nx;
            if (og + 1u == (tg + 1u) * nx) xb_add(&bar[XB_TOPGEN], 1u);
            else XB_SPIN(xb_ld(&bar[XB_TOPGEN]) == tg, bar);
            __builtin_amdgcn_fence(__ATOMIC_ACQUIRE, "agent");
            xb_add(&bar[XB_XGEN(b.x)], 1u);
            asm volatile("s_waitcnt vmcnt(0)" ::: "memory");
        } else {
            XB_SPIN(xb_ld(&bar[XB_XGEN(b.x)]) == gen, bar);
            __builtin_amdgcn_fence(__ATOMIC_ACQUIRE, "agent");
            asm volatile("s_waitcnt vmcnt(0)" ::: "memory");
        }
    }
    __syncthreads();
}

constexpr int RING_BYTES = 131072;
constexpr int LDSCTL_OFF = 143360;
constexpr int LDS_BYTES = 147456;
constexpr int NWAVES = 8;
#ifndef T_IN_P4
#define T_IN_P4 1
#endif
constexpr int NT_GV = (T_IN_P4 && GV_Q) ? 256 : 0, NT_ITEMS = T_IN_P4 ? 576 + NT_GV : 0, NQ_TOTAL = 512 + NT_ITEMS, NQ_MAX = 1088;

struct Args { const float* in[18]; float* out; unsigned char* ws; int ph_lo, ph_hi; unsigned short order[NQ_MAX]; };

__device__ __forceinline__ float wave_sum(float v) {
#pragma unroll
    for (int o = 1; o < 64; o <<= 1) v += __shfl_xor(v, o);
    return v;
}
__device__ __forceinline__ float silu_f(float v) { return v / (1.f + __expf(-v)); }

__device__ __forceinline__ int win_src_col(int n) {
    if (n >= NQKV) { const int k = n - NQKV; return k < 24 ? 2560 + k : -1; }
    const int pn = n >> 8; int j = n & 127; const int hb = n & ~127;
    if (pg8::is_rope_tile(pn)) { const int a = j >> 3, b = j & 7; j = (b < 4) ? 4 * a + b : 64 + 4 * a + (b - 4); }
    return hb + j + (n >= 2560 ? 24 : 0);
}
__device__ __forceinline__ void transpose_item64(const float* W, int ldw, int K, h16* WT, int k0, int n0, int src4, int dl, LAS float* scr, int lane) {
    const int kk = lane >> 4;
    f32x4 v[16];
#pragma unroll
    for (int i = 0; i < 16; ++i) v[i] = src4 >= 0 ? *(const f32x4*)(W + (size_t)(k0 + 4 * i + kk) * ldw + src4) : (f32x4){0.f, 0.f, 0.f, 0.f};
#pragma unroll
    for (int i = 0; i < 16; ++i) { LAS float* p = scr + (4 * i + kk) * 65 + dl; p[0] = v[i].x; p[1] = v[i].y; p[2] = v[i].z; p[3] = v[i].w; }
    asm volatile("s_waitcnt lgkmcnt(0)" ::: "memory");
    const int c = lane & 7;
#pragma unroll
    for (int j = 0; j < 8; ++j) { const int n = (lane >> 3) + 8 * j; const LAS float* sp = scr + (8 * c) * 65 + n;
        u32x4 o; o.x = pk2h(sp[0 * 65], sp[1 * 65]); o.y = pk2h(sp[2 * 65], sp[3 * 65]); o.z = pk2h(sp[4 * 65], sp[5 * 65]); o.w = pk2h(sp[6 * 65], sp[7 * 65]);
        *(u32x4*)(WT + (size_t)(n0 + n) * K + k0 + 8 * c) = o; }
    asm volatile("s_waitcnt lgkmcnt(0)" ::: "memory");
}
template <bool NTL = false>
__device__ __forceinline__ void transpose_item128(const float* W, int ldw, int K, h16* WT, int k0, int n0, int src4, int dl, LAS float* scr, int lane) {
    const int kk = lane >> 4;
    f32x4 v[32];
#pragma unroll
    for (int i = 0; i < 32; ++i) { const f32x4* p = (const f32x4*)(W + (size_t)(k0 + 4 * i + kk) * ldw + src4); v[i] = src4 >= 0 ? (NTL ? __builtin_nontemporal_load(p) : *p) : (f32x4){0.f, 0.f, 0.f, 0.f}; }
    const int c = lane & 7;
#pragma unroll
    for (int hpass = 0; hpass < 2; ++hpass) {
#pragma unroll
        for (int i = 0; i < 16; ++i) { LAS float* p = scr + (4 * i + kk) * 65 + dl; const f32x4 x = v[16 * hpass + i]; p[0] = x.x; p[1] = x.y; p[2] = x.z; p[3] = x.w; }
        asm volatile("s_waitcnt lgkmcnt(0)" ::: "memory");
#pragma unroll
        for (int j = 0; j < 8; ++j) { const int n = (lane >> 3) + 8 * j; const LAS float* sp = scr + (8 * c) * 65 + n;
            u32x4 o; o.x = pk2h(sp[0 * 65], sp[1 * 65]); o.y = pk2h(sp[2 * 65], sp[3 * 65]); o.z = pk2h(sp[4 * 65], sp[5 * 65]); o.w = pk2h(sp[6 * 65], sp[7 * 65]);
            *(u32x4*)(WT + (size_t)(n0 + n) * K + k0 + 64 * hpass + 8 * c) = o; }
        asm volatile("s_waitcnt lgkmcnt(0)" ::: "memory");
    }
}
__device__ __forceinline__ void win_map64(int n0, int q, int& src4, int& dl) {
    if (n0 >= NQKV) { const int k = n0 - NQKV + 4 * q; src4 = (k + 4 <= 24) ? 2560 + k : -1; dl = 4 * q; return; }
    const int pn = n0 >> 8, hb = n0 & ~127, j0 = n0 & 127, add = n0 >= 2560 ? 24 : 0;
    if (pg8::is_rope_tile(pn)) { if (q < 8) { src4 = hb + (j0 >> 1) + 4 * q + add; dl = 8 * q; } else { src4 = hb + 64 + (j0 >> 1) + 4 * (q - 8) + add; dl = 8 * (q - 8) + 4; } }
    else { src4 = n0 + 4 * q + add; dl = 4 * q; }
}

__device__ __forceinline__ void gemv_half(const float* c_in, const float* w_ada, const float* b_ada, float* mod, int cch, int k32, int lane) {
    const int col = cch * 256 + lane * 4; const int kb = k32 * 32;
    const int s0v = __float_as_int(silu_f(c_in[kb + (lane & 31)])), s1v = __float_as_int(silu_f(c_in[DM + kb + (lane & 31)]));
    const float* wp = w_ada + (size_t)kb * (6 * DM) + col;
    f32x4 w[32];
#pragma unroll
    for (int k = 0; k < 32; ++k) w[k] = __builtin_nontemporal_load((const f32x4*)(wp + (size_t)k * (6 * DM)));
    f32x4 a0 = {0.f, 0.f, 0.f, 0.f}, a1 = {0.f, 0.f, 0.f, 0.f};
#pragma unroll
    for (int k = 0; k < 32; ++k) { const float s0 = __int_as_float(__builtin_amdgcn_readlane(s0v, k)), s1 = __int_as_float(__builtin_amdgcn_readlane(s1v, k)); a0 += w[k] * s0; a1 += w[k] * s1; }
    if (k32 == 0) { const f32x4 bv = *(const f32x4*)(b_ada + col); a0 += bv; a1 += bv; }
#pragma unroll
    for (int e = 0; e < 4; ++e) { atomicAdd(mod + col + e, a0[e]); atomicAdd(mod + 6 * DM + col + e, a1[e]); }
}

__device__ __forceinline__ void p0_prologue(const Args& A, LAS unsigned char* lds, int gw, int NGW, int wave, int lane, int rep) {
    unsigned char* ws = A.ws;
    LAS float* scr = (LAS float*)(lds + wave * 16640);
    const float* c_in = A.in[1]; const float* w_ada = A.in[2]; const float* b_ada = A.in[3];
    float* mod = (float*)(ws + WS_MOD); float* posb = (float*)(ws + WS_POSB);
    constexpr int I_GEMV = 48 * 32;
    constexpr int I_DN = (DFF / 128) * (DM / 64), I_UP = (DM / 128) * (DFF / 64), I_IN = (DM / 128) * (NPAD / 64), I_O = (DM / 128) * (DM / 64);
    constexpr int I_W1 = 2 * (4096 / 64) * (128 / 64), I_W2 = 2 * (128 / 64) * (128 / 64), I_ROPE = 4096, I_POSB = 256, I_KMZ = 32;
    constexpr int NITEMS = I_GEMV + (T_IN_P4 ? 0 : I_DN + I_UP + I_O) + I_IN + I_W1 + I_W2 + I_ROPE + I_POSB + I_KMZ;
    const int q16 = lane & 15;
    const bool bal = P0_BAL && T_IN_P4 && NGW == 2048 && rep == 0;
    if (bal && GV_Q) {
        int wi = -1;
        if (gw < 1024) { gemv_half(c_in, w_ada, b_ada, mod, gw & 15, gw >> 4, lane); if (gw < I_IN - 1024) wi = 1024 + gw; } else wi = gw - 1024;
        if (wi >= 0) { const int nblk = NPAD / 64, kb = wi / nblk, nb = wi % nblk; int src4, dl; win_map64(64 * nb, q16, src4, dl); transpose_item128<true>(A.in[6], INCOLS, DM, (h16*)(ws + WS_WIN), 128 * kb, 64 * nb, src4, dl, scr, lane); }
    } else if (bal) {
        if (gw < I_IN) { gemv_half(c_in, w_ada, b_ada, mod, gw % 48, gw / 48, lane);
            const int nblk = NPAD / 64, kb = gw / nblk, nb = gw % nblk; int src4, dl; win_map64(64 * nb, q16, src4, dl); transpose_item128<true>(A.in[6], INCOLS, DM, (h16*)(ws + WS_WIN), 128 * kb, 64 * nb, src4, dl, scr, lane); }
        else {
#pragma unroll 1
            for (int h = gw; h < 2 * I_GEMV; h += 2048 - I_IN) gemv_half(c_in, w_ada, b_ada, mod, h % 48, h / 48, lane); }
    }
    for (int it = gw + (bal ? I_GEMV + I_IN : 0); it < NITEMS; it += NGW) {
        int r = it;
        if (r < I_GEMV) {
            const int cch = r % 48, kch = r / 48; const int col = cch * 256 + lane * 4; const int kb = kch * 64;
            if (GV_Q && T_IN_P4 && cch >= 16) continue;
            f32x4 a0 = {0.f, 0.f, 0.f, 0.f}, a1 = {0.f, 0.f, 0.f, 0.f};
#pragma unroll 16
            for (int k = 0; k < 64; ++k) { const float s0 = silu_f(c_in[kb + k]), s1 = silu_f(c_in[DM + kb + k]);
                const f32x4 w = __builtin_nontemporal_load((const f32x4*)(w_ada + (size_t)(kb + k) * (6 * DM) + col)); a0 += w * s0; a1 += w * s1; }
            if (kch == 0) { const f32x4 bv = *(const f32x4*)(b_ada + col); a0 += bv; a1 += bv; }
#pragma unroll
            for (int e = 0; e < 4; ++e) { atomicAdd(mod + rep * 24576 + col + e, a0[e]); atomicAdd(mod + rep * 24576 + 6 * DM + col + e, a1[e]); }
            continue; }
        r -= I_GEMV;
        if (!T_IN_P4 && r < I_DN) { const int nblk = DM / 64, kb = r / nblk, nb = r % nblk; transpose_item128(A.in[17], DM, DFF, (h16*)(ws + WS_WDN), 128 * kb, 64 * nb, 64 * nb + 4 * q16, 4 * q16, scr, lane); continue; }
        if (!T_IN_P4) r -= I_DN;
        if (!T_IN_P4 && r < I_UP) { const int nblk = DFF / 64, kb = r / nblk, nb = r % nblk; transpose_item128(A.in[16], DFF, DM, (h16*)(ws + WS_WUP), 128 * kb, 64 * nb, 64 * nb + 4 * q16, 4 * q16, scr, lane); continue; }
        if (!T_IN_P4) r -= I_UP;
        if (r < I_IN) { const int nblk = NPAD / 64, kb = r / nblk, nb = r % nblk; int src4, dl; win_map64(64 * nb, q16, src4, dl); transpose_item128<true>(A.in[6], INCOLS, DM, (h16*)(ws + WS_WIN), 128 * kb, 64 * nb, src4, dl, scr, lane); continue; }
        r -= I_IN;
        if (!T_IN_P4 && r < I_O) { const int nblk = DM / 64, kb = r / nblk, nb = r % nblk; transpose_item128(A.in[13], DM, DM, (h16*)(ws + WS_WO), 128 * kb, 64 * nb, 64 * nb + 4 * q16, 4 * q16, scr, lane); continue; }
        if (!T_IN_P4) r -= I_O;
        if (r < I_W1) { const int kv = r / 128, q = r % 128, kb = q / 2, nb = q % 2; transpose_item64(A.in[kv ? 11 : 8], 128, 4096, (h16*)(ws + WS_W1T) + (size_t)kv * 128 * 4096, 64 * kb, 64 * nb, 64 * nb + 4 * q16, 4 * q16, scr, lane); continue; }
        r -= I_W1;
        if (r < I_W2) { const int kv = r / 4, q = r % 4, kb = q / 2, nb = q % 2; transpose_item64(A.in[kv ? 12 : 9], 128, 128, (h16*)(ws + WS_W2T) + (size_t)kv * 128 * 128, 64 * kb, 64 * nb, 64 * nb + 4 * q16, 4 * q16, scr, lane); continue; }
        r -= I_W2;
        if (r < I_POSB) { const int kv = r / 128, kc = r % 128; const float* pos = A.in[kv ? 10 : 7]; const float* w1 = A.in[kv ? 11 : 8];
            f32x2 wv[32];
#pragma unroll
            for (int k = 0; k < 32; ++k) wv[k] = *(const f32x2*)(w1 + (size_t)(kc * 32 + k) * 128 + 2 * lane);
            const int pl = __float_as_int(pos[kc * 32 + (lane & 31)]);
            f32x2 a = {0.f, 0.f};
#pragma unroll
            for (int k = 0; k < 32; ++k) a += wv[k] * __int_as_float(__builtin_amdgcn_readlane(pl, k));
            atomicAdd(posb + rep * 256 + kv * 128 + 2 * lane, a.x); atomicAdd(posb + rep * 256 + kv * 128 + 2 * lane + 1, a.y);
            continue; }
        r -= I_POSB;
        if (r < I_KMZ) { u32x4 z = {0u, 0u, 0u, 0u}; u32x4* p = (u32x4*)(ws + WS_KMEAN + (size_t)r * 4096);
#pragma unroll
          for (int q = 0; q < 4; ++q) p[q * 64 + lane] = z;
          continue; }
        r -= I_KMZ;
        { float* COS = (float*)(ws + WS_COS); float* SIN = (float*)(ws + WS_SIN);
            { const int e = r * 64 + lane; const int t = e >> 6, i = e & 63;
              const float inv = powf(10000.f, -(float)(2 * i) / 128.f); const float ang = (float)t * inv; COS[e] = cosf(ang); SIN[e] = sinf(ang); } }
    }
}

__device__ __forceinline__ void p1_rows(const Args& A, int gw, int NGW, int lane) {
    const float* x = A.in[0]; const float* g1 = A.in[4]; const float* mod = (const float*)(A.ws + WS_MOD); h16* H = (h16*)(A.ws + WS_H);
    for (int row = gw; row < M; row += NGW) {
        const int b = row >> 12; const f32x4* xr = (const f32x4*)(x + (size_t)row * DM) + lane;
        f32x4 v[8]; float s = 0.f;
#pragma unroll
        for (int j = 0; j < 8; ++j) { v[j] = __builtin_nontemporal_load(xr + 64 * j); s += (v[j].x * v[j].x + v[j].y * v[j].y) + (v[j].z * v[j].z + v[j].w * v[j].w); }
        const float rstd = 1.f / sqrtf(wave_sum(s) * (1.f / DM) + EPS);
        u32x2* o8 = (u32x2*)(H + (size_t)row * DM) + lane;
#pragma unroll
        for (int j = 0; j < 8; ++j) { const int col = 4 * lane + 256 * j;
            const f32x4 g = *(const f32x4*)(g1 + col), sh = *(const f32x4*)(mod + b * 6 * DM + col), sc = *(const f32x4*)(mod + b * 6 * DM + DM + col);
            const f32x4 y = (v[j] * rstd * g) * (sc + 1.f) + sh;
            u32x2 w; w.x = pk2h(y.x, y.y); w.y = pk2h(y.z, y.w); o8[64 * j] = w; }
    }
}
__device__ __forceinline__ void p6_rows(const Args& A, int gw, int NGW, int lane) {
    const float* x = A.in[0]; const float* gpost = A.in[5]; const float* gpre = A.in[14]; const float* mod = (const float*)(A.ws + WS_MOD);
    const h16* OP = (const h16*)(A.ws + WS_OP); const float* SSQ = (const float*)(A.ws + WS_SSQ); h16* H = (h16*)(A.ws + WS_H); h16* X1 = (h16*)(A.ws + WS_X1);
    for (int row0 = gw; row0 < M; row0 += 2 * NGW) {
        f32x4 v[2][8]; u32x2 opv[2][8]; float ssp[2];
#pragma unroll
        for (int q = 0; q < 2; ++q) { const int row = row0 + q * NGW;
            ssp[q] = lane < 32 ? SSQ[(size_t)row * 32 + lane] : 0.f;
            const f32x4* xr = (const f32x4*)(x + (size_t)row * DM) + lane; const u32x2* opr = (const u32x2*)(OP + (size_t)row * DM) + lane;
#pragma unroll
            for (int j = 0; j < 8; ++j) { v[q][j] = xr[64 * j]; opv[q][j] = opr[64 * j]; } }
#pragma unroll
        for (int q = 0; q < 2; ++q) { const int row = row0 + q * NGW; const int b = row >> 12; const float* mb = mod + b * 6 * DM;
            const float rstd = 1.f / sqrtf(wave_sum(ssp[q]) * (1.f / DM) + EPS); float s = 0.f;
#pragma unroll
            for (int j = 0; j < 8; ++j) { const int col = 4 * lane + 256 * j;
                const f32x4 g = *(const f32x4*)(gpost + col), gm = *(const f32x4*)(mb + 2 * DM + col);
                v[q][j] = v[q][j] + gm * (unpack4h(opv[q][j]) * rstd * g);
                s += (v[q][j].x * v[q][j].x + v[q][j].y * v[q][j].y) + (v[q][j].z * v[q][j].z + v[q][j].w * v[q][j].w); }
            const float rstd2 = 1.f / sqrtf(wave_sum(s) * (1.f / DM) + EPS);
            u32x2* x1r = (u32x2*)(X1 + (size_t)row * DM) + lane; u32x2* o8 = (u32x2*)(H + (size_t)row * DM) + lane;
#pragma unroll
            for (int j = 0; j < 8; ++j) { const int col = 4 * lane + 256 * j;
                { u32x2 w1; w1.x = pk2h(v[q][j].x, v[q][j].y); w1.y = pk2h(v[q][j].z, v[q][j].w); x1r[64 * j] = w1; }
                const f32x4 g = *(const f32x4*)(gpre + col), sh = *(const f32x4*)(mb + 3 * DM + col), sc = *(const f32x4*)(mb + 4 * DM + col);
                const f32x4 y = (v[q][j] * rstd2 * g) * (sc + 1.f) + sh;
                u32x2 w; w.x = pk2h(y.x, y.y); w.y = pk2h(y.z, y.w); o8[64 * j] = w; } }
    }
}
__device__ __forceinline__ void p9_rows(const Args& A, int gw, int NGW, int lane) {
    const float* gpost = A.in[15]; const float* mod = (const float*)(A.ws + WS_MOD);
    const h16* F = (const h16*)(A.ws + WS_F); const float* SSQ = (const float*)(A.ws + WS_SSQ); const h16* X1 = (const h16*)(A.ws + WS_X1); float* OUT = A.out;
    for (int row0 = gw; row0 < M; row0 += 2 * NGW) {
        u32x2 xv[2][8], fv[2][8]; float ssp[2];
#pragma unroll
        for (int q = 0; q < 2; ++q) { const int row = row0 + q * NGW;
            ssp[q] = lane < 32 ? SSQ[(size_t)row * 32 + lane] : 0.f;
            const u32x2* x1r = (const u32x2*)(X1 + (size_t)row * DM) + lane; const u32x2* fr = (const u32x2*)(F + (size_t)row * DM) + lane;
#pragma unroll
            for (int j = 0; j < 8; ++j) { xv[q][j] = x1r[64 * j]; fv[q][j] = fr[64 * j]; } }
#pragma unroll
        for (int q = 0; q < 2; ++q) { const int row = row0 + q * NGW; const int b = row >> 12; const float* mb = mod + b * 6 * DM;
            const float rstd = 1.f / sqrtf(wave_sum(ssp[q]) * (1.f / DM) + EPS);
            f32x4* outr = (f32x4*)(OUT + (size_t)row * DM) + lane;
#pragma unroll
            for (int j = 0; j < 8; ++j) { const int col = 4 * lane + 256 * j;
                const f32x4 g = *(const f32x4*)(gpost + col), gf = *(const f32x4*)(mb + 5 * DM + col);
                outr[64 * j] = unpack4h(xv[q][j]) + gf * (unpack4h(fv[q][j]) * rstd * g); } }
    }
}

__device__ __forceinline__ void p3_compress_item(const Args& A, LAS unsigned char* lds, int item, int wave, int lane) {
    const int kv = item >> 6, b = (item >> 5) & 1, g = (item >> 4) & 1, rt = item & 15;
    const h16* QKV = (const h16*)(A.ws + WS_QKV); const h16* W1T = (const h16*)(A.ws + WS_W1T) + (size_t)kv * 128 * 4096;
    const h16* W2T = (const h16*)(A.ws + WS_W2T) + (size_t)kv * 128 * 128; const float* posb = (const float*)(A.ws + WS_POSB) + kv * 128;
    h16* OUT = (h16*)(A.ws + WS_KC) + ((size_t)((kv * 2 + b) * 2 + g) * 256) * 128;
    const int colbase = (kv ? C_VCMP : C_KCMP) + g * 128;
    const int i16 = lane & 15, kq = lane >> 4;
    int n = 16 * rt + i16; const int nc = n > 254 ? 254 : n;
    f32x4 acc[8];
#pragma unroll
    for (int nt = 0; nt < 8; ++nt) acc[nt] = (f32x4){0.f, 0.f, 0.f, 0.f};
#pragma unroll 8
    for (int ks = 0; ks < 16; ++ks) {
        const int l = 4 * wave + (ks >> 2), d = ((ks & 3) * 32 + 8 * kq);
        const h16x8 af = *(const h16x8*)(QKV + (size_t)(b * SEQ + 16 * nc + l) * NQKV + colbase + d);
        const int k = 512 * wave + 32 * ks + 8 * kq;
#pragma unroll
        for (int nt = 0; nt < 8; ++nt) { const h16x8 bf = *(const h16x8*)(W1T + (size_t)(16 * nt + i16) * 4096 + k);
            acc[nt] = __builtin_amdgcn_mfma_f32_16x16x32_f16(af, bf, acc[nt], 0, 0, 0); }
    }
    LAS float* red = (LAS float*)lds;
    LAS h16* hid = (LAS h16*)(lds + 65536);
#pragma unroll
    for (int nt = 0; nt < 8; ++nt)
#pragma unroll
        for (int rg = 0; rg < 4; ++rg) red[(wave * 16 + 4 * kq + rg) * 128 + 16 * nt + i16] = acc[nt][rg];
    __syncthreads();
    { const int tid = wave * 64 + lane;
#pragma unroll
      for (int q = 0; q < 4; ++q) { const int e = tid + 512 * q; const int j = e & 127; float s = posb[j];
#pragma unroll
          for (int w = 0; w < 8; ++w) s += red[w * 2048 + e];
          hid[e] = (h16)silu_f(s); } }
    __syncthreads();
    f32x4 o = {0.f, 0.f, 0.f, 0.f};
#pragma unroll
    for (int ks = 0; ks < 4; ++ks) { const h16x8 af = *(const LAS h16x8*)(hid + i16 * 128 + 32 * ks + 8 * kq);
        const h16x8 bf = *(const h16x8*)(W2T + (size_t)(16 * wave + i16) * 128 + 32 * ks + 8 * kq);
        o = __builtin_amdgcn_mfma_f32_16x16x32_f16(af, bf, o, 0, 0, 0); }
#pragma unroll
    for (int rg = 0; rg < 4; ++rg) { const int nn = 16 * rt + 4 * kq + rg; OUT[(size_t)nn * 128 + 16 * wave + i16] = nn > 254 ? (h16)0.f : (h16)o[rg]; }
    __syncthreads();
}
__device__ __forceinline__ void p3_compress_splitk(const Args& A, LAS unsigned char* lds, unsigned* ctl, int it, int wave, int lane) {
    const int kv = it >> 7, mt = (it >> 3) & 15, ks8 = it & 7, b = mt >> 3, g = (mt >> 2) & 1, mq = mt & 3;
    const h16* QKV = (const h16*)(A.ws + WS_QKV); const h16* W1T = (const h16*)(A.ws + WS_W1T) + (size_t)kv * 128 * 4096;
    const h16* W2T = (const h16*)(A.ws + WS_W2T) + (size_t)kv * 128 * 128; const float* posb = (const float*)(A.ws + WS_POSB) + kv * 128;
    h16* OUT = (h16*)(A.ws + WS_KC) + ((size_t)((kv * 2 + b) * 2 + g) * 256) * 128;
    float* PART = (float*)(A.ws + WS_F) + (size_t)((kv * 16 + mt) * 8) * 8192;
    unsigned* cntw = ctl + CW_XCH + 6144 + 64 * (kv * 16 + mt);
    const int colbase = (kv ? C_VCMP : C_KCMP) + g * 128;
    const int i16 = lane & 15, kq = lane >> 4, wr = wave >> 1, wk = wave & 1;
    const int n = 64 * mq + 16 * wr + i16; const int nc = n > 254 ? 254 : n;
    f32x4 acc[8];
#pragma unroll
    for (int nt = 0; nt < 8; ++nt) acc[nt] = (f32x4){0.f, 0.f, 0.f, 0.f};
#pragma unroll
    for (int s_ = 0; s_ < 8; ++s_) {
        const int l = 4 * ks8 + 2 * wk + (s_ >> 2), d = (s_ & 3) * 32 + 8 * kq;
        const h16x8 af = *(const h16x8*)(QKV + (size_t)(b * SEQ + 16 * nc + l) * NQKV + colbase + d);
        const int k = 512 * ks8 + 256 * wk + 32 * s_ + 8 * kq;
#pragma unroll
        for (int nt = 0; nt < 8; ++nt) { const h16x8 bf = *(const h16x8*)(W1T + (size_t)(16 * nt + i16) * 4096 + k);
            acc[nt] = __builtin_amdgcn_mfma_f32_16x16x32_f16(af, bf, acc[nt], 0, 0, 0); }
    }
    LAS float* red = (LAS float*)lds;
    LAS h16* hid = (LAS h16*)(lds + 65536);
#pragma unroll
    for (int nt = 0; nt < 8; ++nt)
#pragma unroll
        for (int rg = 0; rg < 4; ++rg) red[(wave * 16 + 4 * kq + rg) * 128 + 16 * nt + i16] = acc[nt][rg];
    __syncthreads();
    { const int tid = wave * 64 + lane;
#pragma unroll
      for (int q = 0; q < 4; ++q) { const int f = (tid + 512 * q) * 4; const int w2 = f >> 11, rest = f & 2047;
          const f32x4 v = *(const LAS f32x4*)(red + (2 * w2) * 2048 + rest) + *(const LAS f32x4*)(red + (2 * w2 + 1) * 2048 + rest);
          const float* dp = PART + (size_t)ks8 * 8192 + f;
          asm volatile("global_store_dwordx4 %0, %1, off sc0 sc1\n\ts_nop 2" :: "v"(dp), "v"(v) : "memory"); } }
    asm volatile("s_waitcnt vmcnt(0)" ::: "memory");
    if (lane == 0) __hip_atomic_fetch_add(cntw, 1u, __ATOMIC_RELAXED, __HIP_MEMORY_SCOPE_AGENT);
    if (ks8 < 4) {
        if (wave == 0) { unsigned sp = 0u;
            while ((unsigned)__builtin_amdgcn_readfirstlane((int)__hip_atomic_load(cntw, __ATOMIC_RELAXED, __HIP_MEMORY_SCOPE_AGENT)) < 64u) { __builtin_amdgcn_s_sleep(1); if (++sp > (1u << 22)) break; }
            __builtin_amdgcn_fence(__ATOMIC_ACQUIRE, "agent"); }
        __syncthreads();
        { const int tid = wave * 64 + lane; const int e4 = tid * 4; const float* p = PART + (size_t)ks8 * 2048 + e4; f32x4 q0, q1, q2, q3, q4, q5, q6, q7;
          asm volatile("global_load_dwordx4 %0, %8, off sc1\n\tglobal_load_dwordx4 %1, %9, off sc1\n\tglobal_load_dwordx4 %2, %10, off sc1\n\tglobal_load_dwordx4 %3, %11, off sc1\n\t"
                       "global_load_dwordx4 %4, %12, off sc1\n\tglobal_load_dwordx4 %5, %13, off sc1\n\tglobal_load_dwordx4 %6, %14, off sc1\n\tglobal_load_dwordx4 %7, %15, off sc1\n\ts_waitcnt vmcnt(0)"
                       : "=&v"(q0), "=&v"(q1), "=&v"(q2), "=&v"(q3), "=&v"(q4), "=&v"(q5), "=&v"(q6), "=&v"(q7)
                       : "v"(p), "v"(p + 8192), "v"(p + 2 * 8192), "v"(p + 3 * 8192), "v"(p + 4 * 8192), "v"(p + 5 * 8192), "v"(p + 6 * 8192), "v"(p + 7 * 8192) : "memory");
          const f32x4 t = (((q0 + q1) + (q2 + q3)) + ((q4 + q5) + (q6 + q7))) + *(const f32x4*)(posb + (e4 & 127));
          h16* hp = (h16*)nullptr; (void)hp;
          u32x2 hw; hw.x = pk2h(silu_f(t[0]), silu_f(t[1])); hw.y = pk2h(silu_f(t[2]), silu_f(t[3]));
          *(LAS u32x2*)(hid + e4) = hw; }
        __syncthreads();
        f32x4 o = {0.f, 0.f, 0.f, 0.f};
#pragma unroll
        for (int ks = 0; ks < 4; ++ks) { const h16x8 af = *(const LAS h16x8*)(hid + i16 * 128 + 32 * ks + 8 * kq);
            const h16x8 bf = *(const h16x8*)(W2T + (size_t)(16 * wave + i16) * 128 + 32 * ks + 8 * kq);
            o = __builtin_amdgcn_mfma_f32_16x16x32_f16(af, bf, o, 0, 0, 0); }
#pragma unroll
        for (int rg = 0; rg < 4; ++rg) { const int nn = 64 * mq + 16 * ks8 + 4 * kq + rg; const h16 ov = nn > 254 ? (h16)0.f : (h16)o[rg]; h16* op_ = OUT + (size_t)nn * 128 + 16 * wave + i16;
            const unsigned ob = (unsigned)__builtin_bit_cast(unsigned short, ov); asm volatile("global_store_short %0, %1, off sc0 sc1" :: "v"(op_), "v"(ob) : "memory"); }
        asm volatile("s_waitcnt vmcnt(0)" ::: "memory");
    }
    __syncthreads();
    if (ks8 < 4 && wave == 0 && lane == 0) __hip_atomic_fetch_add(ctl + CW_P34 + 64 * (b * 2 + g), 1u, __ATOMIC_RELAXED, __HIP_MEMORY_SCOPE_AGENT);
}
__device__ __forceinline__ void p3_kmean_item(const Args& A, LAS unsigned char* lds, int item, int wave, int lane, unsigned* ctl = nullptr) {
    const int b = item >> 6, nb = (item >> 2) & 15, cq = item & 3;
    const h16* QKV = (const h16*)(A.ws + WS_QKV); h16* KM = (h16*)(A.ws + WS_KMEAN);
    const int tid = wave * 64 + lane, cc = tid & 31, rg = tid >> 5;
    const h16* src = QKV + (size_t)(b * SEQ + nb * 256 + rg * 16) * NQKV + C_KM + cq * 256 + cc * 8;
    h16x8 v[16];
#pragma unroll
    for (int r = 0; r < 16; ++r) v[r] = *(const h16x8*)(src + (size_t)r * NQKV);
    float s8[8];
#pragma unroll
    for (int e = 0; e < 8; ++e) s8[e] = 0.f;
#pragma unroll
    for (int r = 0; r < 16; ++r)
#pragma unroll
        for (int e = 0; e < 8; ++e) s8[e] += (float)v[r][e];
    LAS float* red = (LAS float*)lds;
    *(LAS f32x4*)(red + rg * 256 + cc * 8) = (f32x4){s8[0], s8[1], s8[2], s8[3]}; *(LAS f32x4*)(red + rg * 256 + cc * 8 + 4) = (f32x4){s8[4], s8[5], s8[6], s8[7]};
    __syncthreads();
    if (tid < 256) { float t = 0.f;
#pragma unroll
        for (int g_ = 0; g_ < 16; ++g_) t += red[g_ * 256 + tid];
        const int h = cq * 2 + (tid >> 7), d = tid & 127;
        h16* kp_ = KM + ((size_t)(b * 8 + h) * 32 + nb) * 128 + d; const unsigned kb_ = (unsigned)__builtin_bit_cast(unsigned short, (h16)(t * (1.f / 256.f)));
        asm volatile("global_store_short %0, %1, off sc0 sc1\n\ts_waitcnt vmcnt(0)" :: "v"(kp_), "v"(kb_) : "memory"); }
    __syncthreads();
    if (ctl && tid == 0) __hip_atomic_fetch_add(ctl + CW_P34 + 64 * (4 + b * 4 + cq), 1u, __ATOMIC_RELAXED, __HIP_MEMORY_SCOPE_AGENT);
}

namespace att {
constexpr int SHM_K = 16384, SHM_V = 16384;
constexpr int L_V = 0, L_K = 3 * SHM_V, L_WS = L_K + 3 * SHM_K, L_IMP = L_WS + NWAVES * 256, L_SEL = L_IMP + 64 * 64 * 4, L_END = L_SEL + 64 * 8;
#define KSWZ(row, colB) ((row) * 256 + ((colB) ^ (((row) & 7) << 4)))
#define SBAR() __builtin_amdgcn_sched_barrier(0)
__device__ __forceinline__ int v_st(int k, int c) { const int kk = (k & ~0xC) | ((k & 4) << 1) | ((k & 8) >> 1); return ((kk >> 3) * 4 + (c >> 5)) * 512 + ((kk & 7) * 32 + (c & 31)) * 2; }
__device__ __forceinline__ int v_rd_base(int lane) { return ((lane & 3) << 3) | (((lane >> 2) & 3) << 6) | (((lane >> 4) & 1) << 5) | (((lane >> 5) & 1) << 8); }
constexpr int v_rd_off(int d0, int ks, int half) { return d0 * 512 + ks * 4096 + half * 2048; }
__device__ __forceinline__ int crow(int r, int hi) { return (r & 3) + 8 * (r >> 2) + 4 * hi; }

struct Ctx {
    int tid, wid, lane, r32, hi, sr, sc, kws, vst0, vst1, vb0;
    LAS char* lds; LAS char* V_lds; LAS char* K_lds; LAS float* wsc;
};
struct Stage { h16x8 k0, k1, v0, v1; };

__device__ __forceinline__ void stage_load(Stage& S, const Ctx& c, const h16* Kp, const h16* Vp, int rs, int key0) {
    const char* kb = (const char*)Kp + (size_t)key0 * rs * 2; const char* vb = (const char*)Vp + (size_t)key0 * rs * 2;
    const unsigned lo = (unsigned)(c.sr * rs + c.sc) * 2u, lo2 = lo + (unsigned)(32 * rs) * 2u;
    S.v0 = *(const h16x8*)(vb + lo); S.v1 = *(const h16x8*)(vb + lo2);
    S.k0 = *(const h16x8*)(kb + lo); S.k1 = *(const h16x8*)(kb + lo2);
}
__device__ __forceinline__ void stage_load_k(Stage& S, const Ctx& c, const h16* Kp, int rs, int key0) {
    const char* kb = (const char*)Kp + (size_t)key0 * rs * 2;
    const unsigned lo = (unsigned)(c.sr * rs + c.sc) * 2u, lo2 = lo + (unsigned)(32 * rs) * 2u;
    S.k0 = *(const h16x8*)(kb + lo); S.k1 = *(const h16x8*)(kb + lo2);
}
template <int BUF> __device__ __forceinline__ void stage_write_k(const Stage& S, const Ctx& c) {
    *(LAS h16x8*)(c.K_lds + BUF * SHM_K + c.kws) = S.k0; *(LAS h16x8*)(c.K_lds + BUF * SHM_K + c.kws + 32 * 256) = S.k1;
}
template <int BUF> __device__ __forceinline__ void stage_write(const Stage& S, const Ctx& c) {
    *(LAS h16x8*)(c.V_lds + BUF * SHM_V + c.vst0) = S.v0; *(LAS h16x8*)(c.V_lds + BUF * SHM_V + c.vst1) = S.v1;
    stage_write_k<BUF>(S, c);
}
template <int KB, bool HALF_ONLY>
__device__ __forceinline__ void qkt(f32x16& p0, f32x16& p1, const Ctx& c, const h16x8* qr) {
    p0 = f32x16{}; p1 = f32x16{};
    const LAS char* kb[4];
#pragma unroll
    for (int dd = 0; dd < 4; ++dd) kb[dd] = c.K_lds + KB * SHM_K + KSWZ(c.r32, (dd * 16 + c.hi * 8) * 2);
#pragma unroll
    for (int d0 = 0; d0 < 8; ++d0) { const LAS char* a = kb[d0 & 3] + (d0 >> 2) * 128;
        const h16x8 b0 = *(const LAS h16x8*)(a);
        p0 = __builtin_amdgcn_mfma_f32_32x32x16_f16(b0, qr[d0], p0, 0, 0, 0);
        if (!HALF_ONLY) { const h16x8 b1 = *(const LAS h16x8*)(a + 32 * 256);
            p1 = __builtin_amdgcn_mfma_f32_32x32x16_f16(b1, qr[d0], p1, 0, 0, 0); } }
}
template <int VB>
__device__ __forceinline__ void pv_tile(f32x16* o, int vb0, h16x8 pa0, h16x8 pa1, h16x8 pa2, h16x8 pa3) {
#define TRRD(dst, off) asm volatile("ds_read_b64_tr_b16 %0, %1 offset:%2" : "=&v"(dst) : "v"(vb0), "i"(off) : "memory")
#define MKB(l, h) __builtin_bit_cast(h16x8, (s16x8){l[0], l[1], l[2], l[3], h[0], h[1], h[2], h[3]})
#define PV_D0(d0) do { s16x4 l0, l1, l2, l3, h0, h1, h2, h3; constexpr int b_ = VB * SHM_V + v_rd_off(d0, 0, 0); \
        TRRD(l0, b_); TRRD(h0, b_ + 2048); TRRD(l1, b_ + 4096); TRRD(h1, b_ + 6144); TRRD(l2, b_ + 8192); TRRD(h2, b_ + 10240); TRRD(l3, b_ + 12288); TRRD(h3, b_ + 14336); \
        asm volatile("s_waitcnt lgkmcnt(0)" ::: "memory"); SBAR(); \
        o[d0] = __builtin_amdgcn_mfma_f32_32x32x16_f16(pa0, MKB(l0, h0), o[d0], 0, 0, 0); \
        o[d0] = __builtin_amdgcn_mfma_f32_32x32x16_f16(pa1, MKB(l1, h1), o[d0], 0, 0, 0); \
        o[d0] = __builtin_amdgcn_mfma_f32_32x32x16_f16(pa2, MKB(l2, h2), o[d0], 0, 0, 0); \
        o[d0] = __builtin_amdgcn_mfma_f32_32x32x16_f16(pa3, MKB(l3, h3), o[d0], 0, 0, 0); } while (0)
    PV_D0(0); PV_D0(1); PV_D0(2); PV_D0(3);
#undef PV_D0
#undef MKB
#undef TRRD
}
__device__ __forceinline__ void mask_tile(f32x16& p0, f32x16& p1, int dq, unsigned W, bool rowon) {
    const float NEG = -__builtin_inff();
#pragma unroll
    for (int r = 0; r < 16; ++r) {
        const int c = (r & 3) + 8 * (r >> 2);
        if (!rowon || (unsigned)(dq - c) >= W) p0[r] = NEG;
        if (!rowon || (unsigned)(dq - c - 32) >= W) p1[r] = NEG;
    }
}
__device__ __forceinline__ float rowmax32(const f32x16& p0, const f32x16& p1) {
    float pmax = p0[0];
#pragma unroll
    for (int r = 1; r < 16; ++r) pmax = fmaxf(pmax, p0[r]);
#pragma unroll
    for (int r = 0; r < 16; ++r) pmax = fmaxf(pmax, p1[r]);
    auto rr = __builtin_amdgcn_permlane32_swap(__float_as_uint(pmax), __float_as_uint(pmax), false, false);
    return fmaxf(__uint_as_float(rr[0]), __uint_as_float(rr[1]));
}
__device__ __forceinline__ float rowsum32(const f32x16& p0, const f32x16& p1) {
    float ps = 0.f;
#pragma unroll
    for (int r = 0; r < 16; ++r) ps += p0[r];
#pragma unroll
    for (int r = 0; r < 16; ++r) ps += p1[r];
    auto rr = __builtin_amdgcn_permlane32_swap(__float_as_uint(ps), __float_as_uint(ps), false, false);
    return __uint_as_float(rr[0]) + __uint_as_float(rr[1]);
}
__device__ __forceinline__ void pack_p(const f32x16& p0, const f32x16& p1, h16x8& pa0, h16x8& pa1, h16x8& pa2, h16x8& pa3) {
#define PK4(P, B_, OUT) do { unsigned a0 = pk2h(P[B_+0], P[B_+1]), a1 = pk2h(P[B_+2], P[B_+3]); \
        unsigned b0 = pk2h(P[B_+4], P[B_+5]), b1 = pk2h(P[B_+6], P[B_+7]); \
        auto r0 = __builtin_amdgcn_permlane32_swap(a0, b0, false, false); auto r1 = __builtin_amdgcn_permlane32_swap(a1, b1, false, false); \
        u32x4 w = {r0[0], r1[0], r0[1], r1[1]}; OUT = __builtin_bit_cast(h16x8, w); } while (0)
    PK4(p0, 0, pa0); PK4(p0, 8, pa1); PK4(p1, 0, pa2); PK4(p1, 8, pa3);
#undef PK4
}
constexpr float THR = 8.f;
struct SM { float m, l; };

template <int BUF>
__device__ __forceinline__ void tile_step(const Ctx& c, const h16x8* qr, f32x16* o, SM& sm, int j, int pos, unsigned W, unsigned long long rowmask, int qlo, int qhi) {
    const int kb = 64 * j;
    const bool rowon = (rowmask >> j) & 1ull;
    const bool act = __any(rowon) && (kb <= qhi) && (kb + 63 >= qlo - (int)W + 1);
    if (!act) return;
    f32x16 p0, p1;
    qkt<BUF, false>(p0, p1, c, qr);
    const bool need = (kb + 63 > qlo) || (kb <= qhi - (int)W) || !__all(rowon);
    if (need) mask_tile(p0, p1, pos - kb - 4 * c.hi, W, rowon);
    const float pmax = rowmax32(p0, p1);
    float mn, alpha;
    if (__builtin_expect(__all((pmax - sm.m) <= THR), 1)) { mn = sm.m; alpha = 1.f; }
    else { mn = fmaxf(sm.m, pmax); alpha = __builtin_amdgcn_exp2f((sm.m - mn) * LOG2E); sm.m = mn; }
    const float mnL = -mn * LOG2E;
#pragma unroll
    for (int r = 0; r < 16; ++r) { p0[r] = __builtin_amdgcn_exp2f(fmaf(p0[r], LOG2E, mnL)); p1[r] = __builtin_amdgcn_exp2f(fmaf(p1[r], LOG2E, mnL)); }
    sm.l = sm.l * alpha + rowsum32(p0, p1);
    h16x8 pa0, pa1, pa2, pa3; pack_p(p0, p1, pa0, pa1, pa2, pa3);
    if (__any(alpha < 1.f)) { LAS float* al = c.wsc + 32; if (c.hi == 0) al[c.r32] = alpha; asm volatile("s_waitcnt lgkmcnt(0)" ::: "memory");
#pragma unroll
        for (int d_ = 0; d_ < 4; ++d_)
#pragma unroll
            for (int r = 0; r < 16; ++r) o[d_][r] *= al[crow(r, c.hi)]; }
    SBAR();
    pv_tile<BUF>(o, c.vb0, pa0, pa1, pa2, pa3);
}
__device__ __forceinline__ int next_tile(unsigned long long tiles, int j) {
    const unsigned long long rest = (j >= 63) ? 0ull : (tiles >> (j + 1)) << (j + 1);
    return rest ? (int)__builtin_ctzll(rest) : -1;
}
template <int VAR>
__device__ __forceinline__ void run_attn(const Ctx& c, const h16x8* qr, f32x16* o, SM& sm, const h16* Kp, const h16* Vp, int rs,
                                         unsigned long long tiles, int pos, unsigned W, unsigned long long rowmask, int qlo, int qhi) {
    Stage S;
    int j = (int)__builtin_ctzll(tiles);
#define SLOAD(jj) do { if (VAR == 0) stage_load(S, c, Kp, Vp, rs, 64 * (jj)); } while (0)
#define SWRITE(B) do { if (VAR == 0) stage_write<B>(S, c); } while (0)
#define TSYNC() do { if (VAR != 2) __syncthreads(); } while (0)
    SLOAD(j); SWRITE(0); __syncthreads();
    for (;;) {
        int jn = next_tile(tiles, j);
        if (jn >= 0) SLOAD(jn);
        tile_step<0>(c, qr, o, sm, j, pos, W, rowmask, qlo, qhi);
        if (jn < 0) break;
        SWRITE(1); TSYNC();
        j = jn; jn = next_tile(tiles, j);
        if (jn >= 0) SLOAD(jn);
        tile_step<1>(c, qr, o, sm, j, pos, W, rowmask, qlo, qhi);
        if (jn < 0) break;
        SWRITE(0); TSYNC();
        j = jn;
    }
    __syncthreads();
#undef SLOAD
#undef SWRITE
#undef TSYNC
}

template <int KB, bool HALF_ONLY>
__device__ __forceinline__ void qkt_sk(f32x16& p0, f32x16& p1, const Ctx& c, const h16x8* qr, bool act) {
    if (!act) { const float NEG = -__builtin_inff();
#pragma unroll
        for (int r = 0; r < 16; ++r) { p0[r] = NEG; p1[r] = NEG; } return; }
    qkt<KB, HALF_ONLY>(p0, p1, c, qr);
}
__device__ __forceinline__ void partialSM(f32x16& p0, f32x16& p1, float& m_reg, float& alpha) {
    const float pmax = rowmax32(p0, p1); float mn;
    if (__builtin_expect(__all((pmax - m_reg) <= THR), 1)) { mn = m_reg; alpha = 1.f; }
    else { mn = fmaxf(m_reg, pmax); alpha = __builtin_amdgcn_exp2f((m_reg - mn) * LOG2E); m_reg = mn; }
    const float mnL = -mn * LOG2E;
#pragma unroll
    for (int r = 0; r < 16; ++r) { p0[r] = fmaf(p0[r], LOG2E, mnL); p1[r] = fmaf(p1[r], LOG2E, mnL); }
#pragma unroll
    for (int r = 0; r < 16; ++r) p0[r] = __builtin_amdgcn_exp2f(p0[r]);
}
__device__ __forceinline__ void finishSM(f32x16& p0, f32x16& p1, float alpha, float& l_reg, h16x8& pa0, h16x8& pa1, h16x8& pa2, h16x8& pa3) {
#pragma unroll
    for (int r = 0; r < 16; ++r) p1[r] = __builtin_amdgcn_exp2f(p1[r]);
    l_reg = l_reg * alpha + rowsum32(p0, p1);
    pack_p(p0, p1, pa0, pa1, pa2, pa3);
}
__device__ __forceinline__ void run_attn2(const Ctx& c, const h16x8* qr, f32x16* o, SM& sm, const h16* Kp, const h16* Vp, int rs,
                                          int j_lo, int j_hi, int pos, unsigned W, unsigned long long rowmask, int qlo, int qhi) {
    const int NT = j_hi - j_lo;
    Stage S;
    f32x16 pA0, pA1, pB0, pB1; float alA, alB; h16x8 pa0, pa1, pa2, pa3;
#define KBASE(t) ((j_lo + (t)) * 64)
#define ROWON(t) (((rowmask >> (j_lo + (t))) & 1ull) != 0ull)
#define ACT(t) (__any(ROWON(t)) && KBASE(t) <= qhi && KBASE(t) + 63 >= qlo - (int)W + 1)
#define MASKT(P0_, P1_, t) do { const int kb_ = KBASE(t); const bool ron_ = ROWON(t); \
        if (ACT(t) && ((kb_ + 63 > qlo) || (kb_ <= qhi - (int)W) || !__all(ron_))) mask_tile(P0_, P1_, pos - kb_ - 4 * c.hi, W, ron_); } while (0)
#define RESC(a) do { if (__any((a) < 1.f)) { LAS float* al = c.wsc + 32; if (c.hi == 0) al[c.r32] = (a); asm volatile("s_waitcnt lgkmcnt(0)" ::: "memory"); \
        _Pragma("unroll") for (int d_ = 0; d_ < 4; ++d_) _Pragma("unroll") for (int r = 0; r < 16; ++r) o[d_][r] *= al[crow(r, c.hi)]; } } while (0)
    stage_load(S, c, Kp, Vp, rs, KBASE(0)); stage_write<0>(S, c);
    if (NT > 1) stage_load(S, c, Kp, Vp, rs, KBASE(1));
    __syncthreads();
    SBAR(); qkt_sk<0, false>(pA0, pA1, c, qr, ACT(0));
    MASKT(pA0, pA1, 0); partialSM(pA0, pA1, sm.m, alA);
    if (NT > 1) stage_write<1>(S, c);
    __syncthreads();
#define HALF_STEP(PX0, PX1, alX, PY0, PY1, alY, t, KB, VB, SB) do { \
        SBAR(); qkt_sk<KB, false>(PX0, PX1, c, qr, ACT(t)); \
        finishSM(PY0, PY1, alY, sm.l, pa0, pa1, pa2, pa3); SBAR(); \
        if ((t) + 1 < NT) { stage_load(S, c, Kp, Vp, rs, KBASE((t) + 1)); SBAR(); } \
        if (ACT((t) - 1)) pv_tile<VB>(o, c.vb0, pa0, pa1, pa2, pa3); \
        MASKT(PX0, PX1, (t)); partialSM(PX0, PX1, sm.m, alX); \
        __syncthreads(); \
        if ((t) + 1 < NT) { stage_write<SB>(S, c); } \
        RESC(alX); __syncthreads(); } while (0)
    for (int t = 1; t + 1 < NT; t += 2) {
        HALF_STEP(pB0, pB1, alB, pA0, pA1, alA, t, 1, 0, 0);
        HALF_STEP(pA0, pA1, alA, pB0, pB1, alB, t + 1, 0, 1, 1);
    }
    const bool even = (NT & 1) == 0;
    if (even) { SBAR(); qkt_sk<1, false>(pB0, pB1, c, qr, ACT(NT - 1)); SBAR(); }
    finishSM(pA0, pA1, alA, sm.l, pa0, pa1, pa2, pa3); SBAR();
    if (ACT(even ? NT - 2 : NT - 1)) pv_tile<0>(o, c.vb0, pa0, pa1, pa2, pa3);
    if (even) { MASKT(pB0, pB1, NT - 1); partialSM(pB0, pB1, sm.m, alB); RESC(alB);
        finishSM(pB0, pB1, alB, sm.l, pa0, pa1, pa2, pa3); SBAR(); if (ACT(NT - 1)) pv_tile<1>(o, c.vb0, pa0, pa1, pa2, pa3); }
    __syncthreads();
#undef HALF_STEP
#undef RESC
#undef MASKT
#undef ACT
#undef ROWON
#undef KBASE
}

__device__ __forceinline__ void qkt_rt(f32x16& p0, f32x16& p1, const Ctx& c, const h16x8* qr, int kbo  , float bias = 0.f) {
#pragma unroll
    for (int r = 0; r < 16; ++r) { p0[r] = bias; p1[r] = bias; }
    const LAS char* kb[4];
#pragma unroll
    for (int dd = 0; dd < 4; ++dd) kb[dd] = c.K_lds + kbo + KSWZ(c.r32, (dd * 16 + c.hi * 8) * 2);
#define KFRAG(d0, half) (*(const LAS h16x8*)(kb[(d0) & 3] + ((d0) >> 2) * 128 + (half) * 32 * 256))
#define QK4(A0, A1, A2, A3, g) do { p0 = __builtin_amdgcn_mfma_f32_32x32x16_f16(A0, qr[2 * (g)], p0, 0, 0, 0); p1 = __builtin_amdgcn_mfma_f32_32x32x16_f16(A1, qr[2 * (g)], p1, 0, 0, 0); \
        p0 = __builtin_amdgcn_mfma_f32_32x32x16_f16(A2, qr[2 * (g) + 1], p0, 0, 0, 0); p1 = __builtin_amdgcn_mfma_f32_32x32x16_f16(A3, qr[2 * (g) + 1], p1, 0, 0, 0); } while (0)
    h16x8 a0 = KFRAG(0, 0), a1 = KFRAG(0, 1), a2 = KFRAG(1, 0), a3 = KFRAG(1, 1);
    h16x8 b0 = KFRAG(2, 0), b1 = KFRAG(2, 1), b2 = KFRAG(3, 0), b3 = KFRAG(3, 1);
    SBAR(); QK4(a0, a1, a2, a3, 0); SBAR();
    a0 = KFRAG(4, 0); a1 = KFRAG(4, 1); a2 = KFRAG(5, 0); a3 = KFRAG(5, 1);
    SBAR(); QK4(b0, b1, b2, b3, 1); SBAR();
    b0 = KFRAG(6, 0); b1 = KFRAG(6, 1); b2 = KFRAG(7, 0); b3 = KFRAG(7, 1);
    SBAR(); QK4(a0, a1, a2, a3, 2); SBAR();
    QK4(b0, b1, b2, b3, 3);
#undef QK4
#undef KFRAG
}
__device__ __forceinline__ void stage_write_rt(const Stage& S, const Ctx& c, int kbo, int vbo) {
    *(LAS h16x8*)(c.V_lds + vbo + c.vst0) = S.v0; *(LAS h16x8*)(c.V_lds + vbo + c.vst1) = S.v1;
    *(LAS h16x8*)(c.K_lds + kbo + c.kws) = S.k0; *(LAS h16x8*)(c.K_lds + kbo + c.kws + 32 * 256) = S.k1;
}
template <bool LAG>
__device__ __forceinline__ void run_attn4_impl(const Ctx& c, const h16x8* qr, f32x16* o, SM& sm, const h16* Kp, const h16* Vp, int rs,
                                          int j_lo, int j_hi, int pos, unsigned W, unsigned long long rowmask, int qlo, int qhi) {
    const int NT = j_hi - j_lo;
    constexpr bool lag = LAG;
    Stage S;
    f32x16 p0, p1;
#define KBASE(t) ((j_lo + (t)) * 64)
#define ROWON(t) (((rowmask >> (j_lo + (t))) & 1ull) != 0ull)
#define ACT(t) (__any(ROWON(t)) && KBASE(t) <= qhi && KBASE(t) + 63 >= qlo - (int)W + 1)
#define QK_STEP(t, kbo_) do { if (ACT(t)) { qkt_rt(p0, p1, c, qr, (kbo_)); const int kb_ = KBASE(t); const bool ron_ = ROWON(t); \
            if ((kb_ + 63 > qlo) || (kb_ <= qhi - (int)W) || !__all(ron_)) mask_tile(p0, p1, pos - kb_ - 4 * c.hi, W, ron_); } } while (0)
#define SMPV_STEP(t, vbo_) do { if (ACT(t)) { \
        const float pmax = rowmax32(p0, p1); float mn, alpha; \
        if (__builtin_expect(__all((pmax - sm.m) <= THR), 1)) { mn = sm.m; alpha = 1.f; } \
        else { mn = fmaxf(sm.m, pmax); alpha = __builtin_amdgcn_exp2f((sm.m - mn) * LOG2E); sm.m = mn; } \
        const float mnL = -mn * LOG2E; \
        _Pragma("unroll") for (int r = 0; r < 16; ++r) { p0[r] = __builtin_amdgcn_exp2f(fmaf(p0[r], LOG2E, mnL)); p1[r] = __builtin_amdgcn_exp2f(fmaf(p1[r], LOG2E, mnL)); } \
        sm.l = sm.l * alpha + rowsum32(p0, p1); \
        h16x8 pa0, pa1, pa2, pa3; pack_p(p0, p1, pa0, pa1, pa2, pa3); \
        if (__any(alpha < 1.f)) { LAS float* al = c.wsc + 32; if (c.hi == 0) al[c.r32] = alpha; asm volatile("s_waitcnt lgkmcnt(0)" ::: "memory"); \
            _Pragma("unroll") for (int d_ = 0; d_ < 4; ++d_) _Pragma("unroll") for (int r = 0; r < 16; ++r) o[d_][r] *= al[crow(r, c.hi)]; } \
        SBAR(); pv_tile<0>(o, c.vb0 + (vbo_), pa0, pa1, pa2, pa3); } } while (0)
    stage_load(S, c, Kp, Vp, rs, KBASE(0)); stage_write_rt(S, c, 0, 0);
    __syncthreads();
    int kbo = 0, vbo = 0;
    for (int t = 0; t < NT; ++t) {
        const int kbn = kbo ^ SHM_K, vbn = (vbo == 2 * SHM_V) ? 0 : vbo + SHM_V, vbp = (vbo == 0) ? 2 * SHM_V : vbo - SHM_V;
        if (t + 1 < NT) stage_load(S, c, Kp, Vp, rs, KBASE(t + 1));
        if (!lag) { QK_STEP(t, kbo); SMPV_STEP(t, vbo); }
        else { if (t > 0) SMPV_STEP(t - 1, vbp); QK_STEP(t, kbo); }
        if (t + 1 < NT) stage_write_rt(S, c, kbn, vbn);
        __syncthreads();
        kbo = kbn; vbo = vbn;
    }
    if (lag) { const int vlast = (vbo == 0) ? 2 * SHM_V : vbo - SHM_V; SMPV_STEP(NT - 1, vlast); }
    __syncthreads();
#undef SMPV_STEP
#undef QK_STEP
#undef ACT
#undef ROWON
#undef KBASE
}
__device__ __forceinline__ void run_attn4(const Ctx& c, const h16x8* qr, f32x16* o, SM& sm, const h16* Kp, const h16* Vp, int rs,
                                          int j_lo, int j_hi, int pos, unsigned W, unsigned long long rowmask, int qlo, int qhi) {
    if (c.wid >= 4) run_attn4_impl<true>(c, qr, o, sm, Kp, Vp, rs, j_lo, j_hi, pos, W, rowmask, qlo, qhi);
    else run_attn4_impl<false>(c, qr, o, sm, Kp, Vp, rs, j_lo, j_hi, pos, W, rowmask, qlo, qhi);
}

#define ABAR() do { asm volatile("s_waitcnt lgkmcnt(0)" ::: "memory"); __builtin_amdgcn_s_barrier(); asm volatile("" ::: "memory"); } while (0)
__device__ __forceinline__ void run_attn5(const Ctx& c, const h16x8* qr, f32x16* o, SM& sm, const h16* Kp, const h16* Vp, int rs,
                                          int j_lo, int j_hi, int pos, unsigned W, unsigned long long rowmask, int qlo, int qhi) {
    const int NT = j_hi - j_lo;
    const bool lagw = (c.wid & 1) != 0;
    Stage S;
    f32x16 p0, p1;
#define KBASE(t) ((j_lo + (t)) * 64)
#define ROWON(t) (((rowmask >> (j_lo + (t))) & 1ull) != 0ull)
#define ACT(t) (__any(ROWON(t)) && KBASE(t) <= qhi && KBASE(t) + 63 >= qlo - (int)W + 1)
    stage_load(S, c, Kp, Vp, rs, KBASE(0)); stage_write_rt(S, c, 0, 0);
    if (NT > 1) { stage_load(S, c, Kp, Vp, rs, KBASE(1)); stage_write_rt(S, c, SHM_K, SHM_V); }
    __syncthreads();
    if (lagw) ABAR();
    int bo = 0;
    for (int t = 0; t < NT; ++t) {
        const int bo2 = (bo == 0) ? 2 * SHM_K : bo - SHM_K;
        const bool act = ACT(t);
        if (t + 2 < NT) stage_load(S, c, Kp, Vp, rs, KBASE(t + 2));
        float alpha = 1.f;
        if (act) { qkt_rt(p0, p1, c, qr, bo); const int kb_ = KBASE(t); const bool ron_ = ROWON(t);
            if ((kb_ + 63 > qlo) || (kb_ <= qhi - (int)W) || !__all(ron_)) mask_tile(p0, p1, pos - kb_ - 4 * c.hi, W, ron_);
            const float pmax = rowmax32(p0, p1); float mn;
            if (__builtin_expect(__all((pmax - sm.m) <= THR), 1)) { mn = sm.m; }
            else { mn = fmaxf(sm.m, pmax); alpha = __builtin_amdgcn_exp2f((sm.m - mn) * LOG2E); sm.m = mn; }
            const float mnL = -mn * LOG2E;
#pragma unroll
            for (int r = 0; r < 16; ++r) { p0[r] = __builtin_amdgcn_exp2f(fmaf(p0[r], LOG2E, mnL)); p1[r] = fmaf(p1[r], LOG2E, mnL); } }
        ABAR();
        if (act) {
#pragma unroll
            for (int r = 0; r < 16; ++r) p1[r] = __builtin_amdgcn_exp2f(p1[r]);
            sm.l = sm.l * alpha + rowsum32(p0, p1);
            h16x8 pa0, pa1, pa2, pa3; pack_p(p0, p1, pa0, pa1, pa2, pa3);
            if (__any(alpha < 1.f)) { LAS float* al = c.wsc + 32; if (c.hi == 0) al[c.r32] = alpha; asm volatile("s_waitcnt lgkmcnt(0)" ::: "memory");
#pragma unroll
                for (int d_ = 0; d_ < 4; ++d_)
#pragma unroll
                    for (int r = 0; r < 16; ++r) o[d_][r] *= al[crow(r, c.hi)]; }
            SBAR(); pv_tile<0>(o, c.vb0 + bo, pa0, pa1, pa2, pa3);
        }
        if (t + 2 < NT) stage_write_rt(S, c, bo2, bo2);
        ABAR();
        bo = (bo == 2 * SHM_K) ? 0 : bo + SHM_K;
    }
    if (!lagw) ABAR();
    __syncthreads();
#undef ACT
#undef ROWON
#undef KBASE
}

__device__ __forceinline__ void mask_tile2(f32x16& p0, f32x16& p1, int dq, unsigned W, bool rowon) {
    const float NEG = -__builtin_inff();
    const int dqe = rowon ? dq : -1;
    if (W >= (1u << 30)) {
#pragma unroll
        for (int r = 0; r < 16; ++r) { const int c = (r & 3) + 8 * (r >> 2); if (c > dqe) p0[r] = NEG; if (c + 32 > dqe) p1[r] = NEG; }
    } else {
#pragma unroll
        for (int r = 0; r < 16; ++r) { const int c = (r & 3) + 8 * (r >> 2); if ((unsigned)(dqe - c) >= W) p0[r] = NEG; if ((unsigned)(dqe - c - 32) >= W) p1[r] = NEG; }
    }
}
__device__ __forceinline__ void pv_rt(f32x16* o, int vb, h16x8 pa0, h16x8 pa1, h16x8 pa2, h16x8 pa3) {
#define TRRD(dst, off) asm volatile("ds_read_b64_tr_b16 %0, %1 offset:%2" : "=&v"(dst) : "v"(vb), "i"(off) : "memory")
#define MKB(l, h) __builtin_bit_cast(h16x8, (s16x8){l[0], l[1], l[2], l[3], h[0], h[1], h[2], h[3]})
#define RD8(L0, H0, L1, H1, L2, H2, L3, H3, d0) do { constexpr int b_ = v_rd_off(d0, 0, 0); \
        TRRD(L0, b_); TRRD(H0, b_ + 2048); TRRD(L1, b_ + 4096); TRRD(H1, b_ + 6144); TRRD(L2, b_ + 8192); TRRD(H2, b_ + 10240); TRRD(L3, b_ + 12288); TRRD(H3, b_ + 14336); } while (0)
#define MM4(L0, H0, L1, H1, L2, H2, L3, H3, d0) do { \
        o[d0] = __builtin_amdgcn_mfma_f32_32x32x16_f16(pa0, MKB(L0, H0), o[d0], 0, 0, 0); o[d0] = __builtin_amdgcn_mfma_f32_32x32x16_f16(pa1, MKB(L1, H1), o[d0], 0, 0, 0); \
        o[d0] = __builtin_amdgcn_mfma_f32_32x32x16_f16(pa2, MKB(L2, H2), o[d0], 0, 0, 0); o[d0] = __builtin_amdgcn_mfma_f32_32x32x16_f16(pa3, MKB(L3, H3), o[d0], 0, 0, 0); } while (0)
    s16x4 al0, ah0, al1, ah1, al2, ah2, al3, ah3, bl0, bh0, bl1, bh1, bl2, bh2, bl3, bh3;
    RD8(al0, ah0, al1, ah1, al2, ah2, al3, ah3, 0);
    RD8(bl0, bh0, bl1, bh1, bl2, bh2, bl3, bh3, 1);
    asm volatile("s_waitcnt lgkmcnt(8)" ::: "memory"); SBAR();
    MM4(al0, ah0, al1, ah1, al2, ah2, al3, ah3, 0); SBAR();
    RD8(al0, ah0, al1, ah1, al2, ah2, al3, ah3, 2);
    asm volatile("s_waitcnt lgkmcnt(8)" ::: "memory"); SBAR();
    MM4(bl0, bh0, bl1, bh1, bl2, bh2, bl3, bh3, 1); SBAR();
    RD8(bl0, bh0, bl1, bh1, bl2, bh2, bl3, bh3, 3);
    asm volatile("s_waitcnt lgkmcnt(8)" ::: "memory"); SBAR();
    MM4(al0, ah0, al1, ah1, al2, ah2, al3, ah3, 2); SBAR();
    asm volatile("s_waitcnt lgkmcnt(0)" ::: "memory"); SBAR();
    MM4(bl0, bh0, bl1, bh1, bl2, bh2, bl3, bh3, 3);
#undef MM4
#undef RD8
#undef MKB
#undef TRRD
}
__device__ __forceinline__ void run_attn6(const Ctx& c, const h16x8* qr, f32x16* o, SM& sm, const h16* Kp, const h16* Vp, int rs,
                                          int j_lo, int j_hi, int pos, unsigned W, unsigned long long rowmask, int qlo, int qhi) {
    const int NT = j_hi - j_lo;
    Stage S;
#define KBASE(t) ((j_lo + (t)) * 64)
#define ROWON(t) (((rowmask >> (j_lo + (t))) & 1ull) != 0ull)
#define ACT(t) (__any(ROWON(t)) && KBASE(t) <= qhi && KBASE(t) + 63 >= qlo - (int)W + 1)
    stage_load(S, c, Kp, Vp, rs, KBASE(0)); stage_write_rt(S, c, 0, 0);
    __syncthreads();
    int bo = 0;
    for (int t = 0; t < NT; ++t) {
        if (t + 1 < NT) stage_load(S, c, Kp, Vp, rs, KBASE(t + 1));
        if (ACT(t)) {
            const bool ron_ = ROWON(t);
            f32x16 p0, p1; qkt_rt(p0, p1, c, qr, bo, ron_ ? 0.f : -__builtin_inff());
            { const int kb_ = KBASE(t);
              if ((kb_ + 63 > qlo) || (kb_ <= qhi - (int)W)) mask_tile2(p0, p1, pos - kb_ - 4 * c.hi, W, ron_); }
            const float pmax = rowmax32(p0, p1); float mn, alpha;
            if (__builtin_expect(__all((pmax - sm.m) <= THR), 1)) { mn = sm.m; alpha = 1.f; }
            else { mn = fmaxf(sm.m, pmax); alpha = __builtin_amdgcn_exp2f((sm.m - mn) * LOG2E); sm.m = mn; }
            const float mnL = -mn * LOG2E;
#pragma unroll
            for (int r = 0; r < 16; ++r) { p0[r] = __builtin_amdgcn_exp2f(fmaf(p0[r], LOG2E, mnL)); p1[r] = __builtin_amdgcn_exp2f(fmaf(p1[r], LOG2E, mnL)); }
            sm.l = sm.l * alpha + rowsum32(p0, p1);
            h16x8 pa0, pa1, pa2, pa3; pack_p(p0, p1, pa0, pa1, pa2, pa3);
            if (__any(alpha < 1.f)) { LAS float* al = c.wsc + 32; if (c.hi == 0) al[c.r32] = alpha; asm volatile("s_waitcnt lgkmcnt(0)" ::: "memory");
#pragma unroll
                for (int d_ = 0; d_ < 4; ++d_)
#pragma unroll
                    for (int r = 0; r < 16; ++r) o[d_][r] *= al[crow(r, c.hi)]; }
            SBAR(); pv_rt(o, c.vb0 + bo, pa0, pa1, pa2, pa3);
        }
        if (t + 1 < NT) stage_write_rt(S, c, bo ^ SHM_K, bo ^ SHM_V);
        __syncthreads();
        bo ^= SHM_K;
    }
#undef ACT
#undef ROWON
#undef KBASE
}


struct DmaOff { unsigned k0, k1, v0, v1; };
__device__ __forceinline__ DmaOff dma_offsets(const Ctx& c, int rs) {
    DmaOff d;
#pragma unroll
    for (int i = 0; i < 2; ++i) { const int o = (2 * c.wid + i) * 1024 + 16 * c.lane;
        const int row = o >> 8, phys = (o & 255) >> 4, logical = phys ^ (row & 7);
        const unsigned ko = (unsigned)(row * rs + logical * 8);
        const int st = o >> 9, kh = st >> 2, cq = st & 3, kk = kh * 8 + ((o & 511) >> 6), c8 = ((o & 63) >> 4) * 8;
        const int k = (kk & ~0xC) | ((kk & 4) << 1) | ((kk & 8) >> 1);
        const unsigned vo = (unsigned)(k * rs + cq * 32 + c8);
        if (i == 0) { d.k0 = ko; d.v0 = vo; } else { d.k1 = ko; d.v1 = vo; } }
    return d;
}
__device__ __forceinline__ void stage_dma(const Ctx& c, const DmaOff& d, const h16* Kp, const h16* Vp, int rs, int key0, int slot) {
    const h16* kb = Kp + (size_t)key0 * rs; const h16* vb = Vp + (size_t)key0 * rs;
    LAS char* kd = (LAS char*)c.K_lds + slot + c.wid * 2048; LAS char* vd = (LAS char*)c.V_lds + slot + c.wid * 2048;
    __builtin_amdgcn_global_load_lds((const unsigned*)(kb + d.k0), (LAS unsigned*)(kd), 16, 0, 0);
    __builtin_amdgcn_global_load_lds((const unsigned*)(kb + d.k1), (LAS unsigned*)(kd + 1024), 16, 0, 0);
    __builtin_amdgcn_global_load_lds((const unsigned*)(vb + d.v0), (LAS unsigned*)(vd), 16, 0, 0);
    __builtin_amdgcn_global_load_lds((const unsigned*)(vb + d.v1), (LAS unsigned*)(vd + 1024), 16, 0, 0);
}
typedef short v4i16_t __attribute__((ext_vector_type(4)));
__device__ __forceinline__ s16x4 vtr(const LAS char* p) { return __builtin_bit_cast(s16x4, __builtin_amdgcn_ds_read_tr16_b64_v4i16((LAS v4i16_t*)p)); }
__device__ __forceinline__ void run_attn9(const Ctx& c, const h16x8* qr, f32x16* o, SM& sm, const h16* Kp, const h16* Vp, int rs,
                                          int j_lo, int j_hi, int pos, unsigned W, unsigned long long rowmask, int qlo, int qhi) {
    const int NT = j_hi - j_lo;
    const DmaOff dmo = dma_offsets(c, rs);
    f32x16 X0, X1;
    u32x4 pwA0, pwA1, pwA2, pwA3, pwB0, pwB1, pwB2, pwB3;
    float l_reg = 0.f, m_reg = -1e30f;
#define KBASE(t) ((j_lo + (t)) * 64)
#define ROWON(t) (((rowmask >> (j_lo + (t))) & 1ull) != 0ull)
    const LAS char* kq[4];
#pragma unroll
    for (int dd = 0; dd < 4; ++dd) kq[dd] = c.K_lds + KSWZ(c.r32, (dd * 16 + c.hi * 8) * 2);
    const LAS char* vq = c.V_lds + v_rd_base(c.lane);
#define KFR(kbo, i) (*(const LAS h16x8*)(kq[((i) >> 1) & 3] + (kbo) + ((i) >> 3) * 128 + ((i) & 1) * 32 * 256))
#define VLO(vbo, j) vtr(vq + (vbo) + v_rd_off((j) >> 2, (j) & 3, 0))
#define VHI(vbo, j) vtr(vq + (vbo) + v_rd_off((j) >> 2, (j) & 3, 1))
#define MKB(l, h) __builtin_bit_cast(h16x8, (s16x8){l[0], l[1], l[2], l[3], h[0], h[1], h[2], h[3]})
    const f32x16 zero16 = {};
#define GA(i, kbo) do { \
        if ((i) & 1) X1 = __builtin_amdgcn_mfma_f32_32x32x16_f16(kf[(i) & 3], qr[(i) >> 1], (i) == 1 ? zero16 : X1, 0, 0, 0); \
        else X0 = __builtin_amdgcn_mfma_f32_32x32x16_f16(kf[(i) & 3], qr[(i) >> 1], (i) == 0 ? zero16 : X0, 0, 0, 0); \
        if ((i) + 4 < 16) kf[(i) & 3] = KFR(kbo, (i) + 4); \
        SBAR(); } while (0)
#define GB(j, HP, vbo, mnL_, PP0, PP1, PP2, PP3, PN0, PN1, PN2, PN3) do { \
        if (HP) { const u32x4 pwj_ = ((j) & 3) == 0 ? PP0 : ((j) & 3) == 1 ? PP1 : ((j) & 3) == 2 ? PP2 : PP3; \
            o[(j) >> 2] = __builtin_amdgcn_mfma_f32_32x32x16_f16(__builtin_bit_cast(h16x8, pwj_), MKB(vl[(j) & 3], vh[(j) & 3]), o[(j) >> 2], 0, 0, 0); \
            if ((j) + 4 < 16) { vl[(j) & 3] = VLO(vbo, (j) + 4); vh[(j) & 3] = VHI(vbo, (j) + 4); } } \
        { const float e0_ = __builtin_amdgcn_exp2f(fmaf((j) < 8 ? X0[(2 * (j)) & 15] : X1[(2 * (j)) & 15], LOG2E, mnL_)); \
          const float e1_ = __builtin_amdgcn_exp2f(fmaf((j) < 8 ? X0[(2 * (j) + 1) & 15] : X1[(2 * (j) + 1) & 15], LOG2E, mnL_)); \
          sacc += e0_; sacc += e1_; const unsigned cv_ = pk2h(e0_, e1_); \
          constexpr int jj_ = (j) >> 2, sub_ = (j) & 3; \
          if (sub_ == 0) ca0 = cv_; else if (sub_ == 1) ca1 = cv_; else if (sub_ == 2) cb0 = cv_; else { \
              auto r0_ = __builtin_amdgcn_permlane32_swap(ca0, cb0, false, false); auto r1_ = __builtin_amdgcn_permlane32_swap(ca1, cv_, false, false); \
              const u32x4 w_ = {r0_[0], r1_[0], r0_[1], r1_[1]}; if (jj_ == 0) PN0 = w_; else if (jj_ == 1) PN1 = w_; else if (jj_ == 2) PN2 = w_; else PN3 = w_; } } \
        SBAR(); } while (0)
#define STEP(t, HP, PP0, PP1, PP2, PP3, PN0, PN1, PN2, PN3) do { \
        const int kbo_ = bo, vbo_ = bop; \
        if ((t) + 1 < NT) stage_dma(c, dmo, Kp, Vp, rs, KBASE((t) + 1), bon); \
        h16x8 kf[4]; kf[0] = KFR(kbo_, 0); kf[1] = KFR(kbo_, 1); kf[2] = KFR(kbo_, 2); kf[3] = KFR(kbo_, 3); \
        SBAR(); \
        GA(0, kbo_); GA(1, kbo_); GA(2, kbo_); GA(3, kbo_); GA(4, kbo_); GA(5, kbo_); GA(6, kbo_); GA(7, kbo_); \
        GA(8, kbo_); GA(9, kbo_); GA(10, kbo_); GA(11, kbo_); GA(12, kbo_); GA(13, kbo_); GA(14, kbo_); GA(15, kbo_); \
        s16x4 vl[4], vh[4]; \
        if (HP) { vl[0] = VLO(vbo_, 0); vh[0] = VHI(vbo_, 0); vl[1] = VLO(vbo_, 1); vh[1] = VHI(vbo_, 1); vl[2] = VLO(vbo_, 2); vh[2] = VHI(vbo_, 2); vl[3] = VLO(vbo_, 3); vh[3] = VHI(vbo_, 3); } \
        const bool ron_ = ROWON(t); \
        { const int kb_ = KBASE(t); if ((kb_ + 63 > qlo) || (kb_ <= qhi - (int)W)) mask_tile2(X0, X1, pos - kb_ - 4 * c.hi, W, true); } \
        const float pmax_ = ron_ ? rowmax32(X0, X1) : -__builtin_inff(); float mn_, alpha; \
        if (__builtin_expect(__all((pmax_ - m_reg) <= THR), 1)) { mn_ = m_reg; alpha = 1.f; } \
        else { mn_ = fmaxf(m_reg, pmax_); alpha = __builtin_amdgcn_exp2f((m_reg - mn_) * LOG2E); m_reg = mn_; } \
        const float mnL_ = ron_ ? -mn_ * LOG2E : -__builtin_inff(); \
        float sacc = 0.f; unsigned ca0 = 0u, ca1 = 0u, cb0 = 0u; \
        SBAR(); \
        GB(0, HP, vbo_, mnL_, PP0, PP1, PP2, PP3, PN0, PN1, PN2, PN3); GB(1, HP, vbo_, mnL_, PP0, PP1, PP2, PP3, PN0, PN1, PN2, PN3); \
        GB(2, HP, vbo_, mnL_, PP0, PP1, PP2, PP3, PN0, PN1, PN2, PN3); GB(3, HP, vbo_, mnL_, PP0, PP1, PP2, PP3, PN0, PN1, PN2, PN3); \
        GB(4, HP, vbo_, mnL_, PP0, PP1, PP2, PP3, PN0, PN1, PN2, PN3); GB(5, HP, vbo_, mnL_, PP0, PP1, PP2, PP3, PN0, PN1, PN2, PN3); \
        GB(6, HP, vbo_, mnL_, PP0, PP1, PP2, PP3, PN0, PN1, PN2, PN3); GB(7, HP, vbo_, mnL_, PP0, PP1, PP2, PP3, PN0, PN1, PN2, PN3); \
        GB(8, HP, vbo_, mnL_, PP0, PP1, PP2, PP3, PN0, PN1, PN2, PN3); GB(9, HP, vbo_, mnL_, PP0, PP1, PP2, PP3, PN0, PN1, PN2, PN3); \
        GB(10, HP, vbo_, mnL_, PP0, PP1, PP2, PP3, PN0, PN1, PN2, PN3); GB(11, HP, vbo_, mnL_, PP0, PP1, PP2, PP3, PN0, PN1, PN2, PN3); \
        GB(12, HP, vbo_, mnL_, PP0, PP1, PP2, PP3, PN0, PN1, PN2, PN3); GB(13, HP, vbo_, mnL_, PP0, PP1, PP2, PP3, PN0, PN1, PN2, PN3); \
        GB(14, HP, vbo_, mnL_, PP0, PP1, PP2, PP3, PN0, PN1, PN2, PN3); GB(15, HP, vbo_, mnL_, PP0, PP1, PP2, PP3, PN0, PN1, PN2, PN3); \
        { auto rr_ = __builtin_amdgcn_permlane32_swap(__float_as_uint(sacc), __float_as_uint(sacc), false, false); l_reg = l_reg * alpha + (__uint_as_float(rr_[0]) + __uint_as_float(rr_[1])); } \
        if (__any(alpha < 1.f)) { LAS float* al = c.wsc + 32; if (c.hi == 0) al[c.r32] = alpha; asm volatile("s_waitcnt lgkmcnt(0)" ::: "memory"); \
            _Pragma("unroll") for (int d_ = 0; d_ < 4; ++d_) _Pragma("unroll") for (int r = 0; r < 16; ++r) o[d_][r] *= al[crow(r, c.hi)]; } \
        asm volatile("s_waitcnt vmcnt(0)" ::: "memory"); __syncthreads(); \
        bop = bo; bo = bon; bon = (bon == 2 * SHM_K) ? 0 : bon + SHM_K; } while (0)
    __syncthreads();
    stage_dma(c, dmo, Kp, Vp, rs, KBASE(0), 0);
    asm volatile("s_waitcnt vmcnt(0)" ::: "memory"); __syncthreads();
    int bo = 0, bop = 0, bon = SHM_K;
    STEP(0, 0, pwB0, pwB1, pwB2, pwB3, pwA0, pwA1, pwA2, pwA3);
    int t = 1;
    for (; t + 1 < NT; t += 2) { STEP(t, 1, pwA0, pwA1, pwA2, pwA3, pwB0, pwB1, pwB2, pwB3); STEP(t + 1, 1, pwB0, pwB1, pwB2, pwB3, pwA0, pwA1, pwA2, pwA3); }
    if (t < NT) { STEP(t, 1, pwA0, pwA1, pwA2, pwA3, pwB0, pwB1, pwB2, pwB3);
        SBAR(); pv_rt(o, c.vb0 + bop, __builtin_bit_cast(h16x8, pwB0), __builtin_bit_cast(h16x8, pwB1), __builtin_bit_cast(h16x8, pwB2), __builtin_bit_cast(h16x8, pwB3)); }
    else { SBAR(); pv_rt(o, c.vb0 + bop, __builtin_bit_cast(h16x8, pwA0), __builtin_bit_cast(h16x8, pwA1), __builtin_bit_cast(h16x8, pwA2), __builtin_bit_cast(h16x8, pwA3)); }
    sm.m = m_reg; sm.l = l_reg;
    __syncthreads();
#undef STEP
#undef GB
#undef GA
#undef MKB
#undef VHI
#undef VLO
#undef KFR
#undef ROWON
#undef KBASE
}
__device__ __forceinline__ void finish(const Ctx& c, f32x16* o, SM& sm, float gate) {
    LAS float* li = c.wsc;
    const float s = sm.l > 0.f ? gate / sm.l : 0.f;
    if (c.hi == 0) li[c.r32] = s;
    asm volatile("s_waitcnt lgkmcnt(0)" ::: "memory");
#pragma unroll
    for (int r = 0; r < 16; ++r) { const float sr_ = li[crow(r, c.hi)];
#pragma unroll
        for (int d0 = 0; d0 < 4; ++d0) o[d0][r] *= sr_; }
    asm volatile("s_waitcnt lgkmcnt(0)" ::: "memory");
    sm.m = -1e30f; sm.l = 0.f;
}
__device__ __forceinline__ void store_o(const Ctx& c, f32x16* o, h16* Ow  , int ldo, bool acc) {
    LAS h16* stg = (LAS h16*)(c.lds + c.wid * 8192);
#pragma unroll
    for (int r = 0; r < 16; ++r) { const int orow = crow(r, c.hi);
#pragma unroll
        for (int d0 = 0; d0 < 4; ++d0) { stg[orow * 128 + d0 * 32 + c.r32] = (h16)o[d0][r]; o[d0][r] = 0.f; } }
    asm volatile("s_waitcnt lgkmcnt(0)" ::: "memory");
    const int rq = c.lane >> 4, ch = c.lane & 15;
    u32x4 own[8];
#pragma unroll
    for (int it = 0; it < 8; ++it) own[it] = *(const LAS u32x4*)(stg + (it * 4 + rq) * 128 + ch * 8);
    if (acc) {
        u32x4 old[8];
        const h16* p0 = Ow + (size_t)rq * ldo + ch * 8;
#define LD16(k) "global_load_dwordx4 %" #k ", %8, off sc1\n\t"
        const h16* a0 = p0, * a1 = p0 + (size_t)4 * ldo, * a2 = p0 + (size_t)8 * ldo, * a3 = p0 + (size_t)12 * ldo, * a4 = p0 + (size_t)16 * ldo, * a5 = p0 + (size_t)20 * ldo, * a6 = p0 + (size_t)24 * ldo, * a7 = p0 + (size_t)28 * ldo;
        asm volatile("global_load_dwordx4 %0, %8, off sc1\n\tglobal_load_dwordx4 %1, %9, off sc1\n\tglobal_load_dwordx4 %2, %10, off sc1\n\tglobal_load_dwordx4 %3, %11, off sc1\n\t"
                     "global_load_dwordx4 %4, %12, off sc1\n\tglobal_load_dwordx4 %5, %13, off sc1\n\tglobal_load_dwordx4 %6, %14, off sc1\n\tglobal_load_dwordx4 %7, %15, off sc1\n\ts_waitcnt vmcnt(0)"
                     : "=&v"(old[0]), "=&v"(old[1]), "=&v"(old[2]), "=&v"(old[3]), "=&v"(old[4]), "=&v"(old[5]), "=&v"(old[6]), "=&v"(old[7])
                     : "v"(a0), "v"(a1), "v"(a2), "v"(a3), "v"(a4), "v"(a5), "v"(a6), "v"(a7) : "memory");
#undef LD16
#pragma unroll
        for (int it = 0; it < 8; ++it) {
#pragma unroll
            for (int e = 0; e < 4; ++e) { const unsigned wa = own[it][e], wb = old[it][e]; const h16x2 ha = __builtin_bit_cast(h16x2, wa), hb = __builtin_bit_cast(h16x2, wb);
                own[it][e] = pk2h((float)ha.x + (float)hb.x, (float)ha.y + (float)hb.y); } }
    }
#pragma unroll
    for (int it = 0; it < 8; ++it) *(u32x4*)(Ow + (size_t)(it * 4 + rq) * ldo + ch * 8) = own[it];
}

__device__ __forceinline__ void nsa_prepare(const Args& A, const Ctx& c, int b, int g, int ci, h16x8* qr, f32x16* o, unsigned long long& rowmask, h16* O) {
    const h16* QKV = (const h16*)(A.ws + WS_QKV); const float* G = (const float*)(A.ws + WS_GATE);
    const h16* KC = (const h16*)(A.ws + WS_KC) + ((size_t)((0 * 2 + b) * 2 + g) * 256) * 128;
    const h16* VC = (const h16*)(A.ws + WS_KC) + ((size_t)((1 * 2 + b) * 2 + g) * 256) * 128;
    const int hh = c.wid >> 1, head = g * 4 + hh, sub = (c.wid & 1) * 32, t0 = 64 * ci;
    const int qidx = sub + c.r32, t = t0 + qidx; const size_t tokrow = (size_t)(b * SEQ + t);
#pragma unroll
    for (int d0 = 0; d0 < 8; ++d0) qr[d0] = *(const h16x8*)(QKV + tokrow * NQKV + C_QN + head * 128 + d0 * 16 + c.hi * 8);
    const float g0 = G[tokrow * 24 + head * 3];
    LAS float* impH = (LAS float*)((hh < 2 ? c.K_lds : c.V_lds) + SHM_K * (1 + (hh & 1)));
#define IMPP(s_) impH[qidx * 64 + (((s_) + 2 * qidx) & 63)]
    LAS float* rlH = (LAS float*)(c.lds + L_IMP);
    LAS unsigned long long* selm = (LAS unsigned long long*)(c.lds + L_SEL);
    h16* Ow = O + (size_t)(b * SEQ + t0 + sub) * DM + head * 128;
    __syncthreads();
    { LAS f32x4* z = (LAS f32x4*)(impH + qidx * 64 + 32 * c.hi);
#pragma unroll
      for (int e = 0; e < 8; ++e) z[e] = (f32x4){0.f, 0.f, 0.f, 0.f}; }
    const int posc = (t - 31) >> 4;
    const int ntc = ((4 * ci + 2) >> 6) + 1;
    const unsigned WC = 1u << 30;
    float m = -1e30f, l = 0.f;
    Stage S; stage_load(S, c, KC, VC, 128, 0);
    for (int j = 0; j < ntc; ++j) {
        __syncthreads();
        stage_write<0>(S, c); __syncthreads();
        if (j + 1 < ntc) stage_load(S, c, KC, VC, 128, 64 * (j + 1));
        f32x16 p0, p1; qkt<0, false>(p0, p1, c, qr);
        mask_tile2(p0, p1, posc - 64 * j - 4 * c.hi, WC, true);
        const float pmax = rowmax32(p0, p1); const float mn = fmaxf(m, pmax); const float alpha = __builtin_amdgcn_exp2f((m - mn) * LOG2E); m = mn;
        if (__any(alpha < 1.f)) {
            LAS float* al = c.wsc + 32; if (c.hi == 0) al[c.r32] = alpha; asm volatile("s_waitcnt lgkmcnt(0)" ::: "memory");
#pragma unroll
            for (int d_ = 0; d_ < 4; ++d_)
#pragma unroll
                for (int r = 0; r < 16; ++r) o[d_][r] *= al[crow(r, c.hi)];
            for (int k = 0; k < 8 * j + 1; ++k) IMPP(2 * k + c.hi) *= alpha; }
        const float mL = -mn * LOG2E;
#pragma unroll
        for (int r = 0; r < 16; ++r) { p0[r] = __builtin_amdgcn_exp2f(fmaf(p0[r], LOG2E, mL)); p1[r] = __builtin_amdgcn_exp2f(fmaf(p1[r], LOG2E, mL)); }
        l = l * alpha + rowsum32(p0, p1);
        {
            const int sb = 16 * j + c.hi;
#pragma unroll
            for (int gq = 0; gq < 4; ++gq) { IMPP(sb + 2 * gq) += p0[4 * gq] + p0[4 * gq + 1] + p0[4 * gq + 2] + 0.5f * p0[4 * gq + 3];
                IMPP(sb + 8 + 2 * gq) += p1[4 * gq] + p1[4 * gq + 1] + p1[4 * gq + 2] + 0.5f * p1[4 * gq + 3]; }
            asm volatile("s_waitcnt lgkmcnt(0)" ::: "memory");
#pragma unroll
            for (int gq = 0; gq < 4; ++gq) { IMPP(sb + 2 * gq + 1) += 0.5f * p0[4 * gq + 3];
                if (sb + 8 + 2 * gq + 1 < 64) IMPP(sb + 8 + 2 * gq + 1) += 0.5f * p1[4 * gq + 3]; }
        }
        h16x8 pa0, pa1, pa2, pa3; pack_p(p0, p1, pa0, pa1, pa2, pa3);
        SBAR();
        pv_tile<0>(o, c.vb0, pa0, pa1, pa2, pa3);
    }
    {
        LAS float* li = c.wsc; const float rli = l > 0.f ? 1.f / l : 0.f;
        if (c.hi == 0) { li[c.r32] = rli * g0; rlH[hh * 64 + qidx] = rli; }
        asm volatile("s_waitcnt lgkmcnt(0)" ::: "memory");
#pragma unroll
        for (int r = 0; r < 16; ++r) { const float sr_ = li[crow(r, c.hi)];
#pragma unroll
            for (int d0 = 0; d0 < 4; ++d0) o[d0][r] *= sr_; }
    }
    __syncthreads();
    {
        const int s = c.lane;
        const LAS float* i0 = (const LAS float*)(c.K_lds + SHM_K), * i1 = (const LAS float*)(c.K_lds + 2 * SHM_K), * i2 = (const LAS float*)(c.V_lds + SHM_V), * i3 = (const LAS float*)(c.V_lds + 2 * SHM_V);
        for (int qq = 0; qq < 8; ++qq) { const int q = c.wid * 8 + qq; const int ps = q * 64 + ((s + 2 * q) & 63);
            const float my = ((i0[ps] * rlH[q] + i1[ps] * rlH[64 + q]) + i2[ps] * rlH[128 + q]) + i3[ps] * rlH[192 + q];
            const bool valid = (s >= 1 && s <= ci - 2);
            bool pick = valid;
            if (ci - 2 > 13) {
                const unsigned key = valid ? __float_as_uint(my) + 1u : 0u; unsigned T = 0u;
                for (int bit = 31; bit >= 0; --bit) { const unsigned trial = T | (1u << bit); if (__popcll(__ballot(key >= trial)) >= 13) T = trial; }
                const unsigned long long gt = __ballot(key > T), eq = __ballot(key == T);
                const int need = 13 - __popcll(gt); const int rk = __popcll(eq & ((1ull << s) - 1ull));
                pick = (key > T) || (key == T && rk < need);
            }
            const bool sel = (s == 0) || (s == ci) || (s == ci - 1) || pick;
            const unsigned long long bm = __ballot(sel && s <= ci);
            if (c.lane == 0) selm[q] = bm; }
        __syncthreads();
    }
    rowmask = selm[qidx];
#undef IMPP
    store_o(c, o, Ow, DM, false);
}
__device__ __forceinline__ void moba_prepare(const Args& A, const Ctx& c, int b, int h, int cj, h16x8* qr, unsigned long long& rowmask) {
    const h16* QKV = (const h16*)(A.ws + WS_QKV);
    const h16* KMT = (const h16*)(A.ws + WS_KMEAN) + (size_t)(b * 8 + h) * 32 * 128;
    const int wq0 = 256 * cj + 32 * c.wid, t = wq0 + c.r32; const size_t tokrow = (size_t)(b * SEQ + t);
#pragma unroll
    for (int d0 = 0; d0 < 8; ++d0) qr[d0] = *(const h16x8*)(QKV + tokrow * NQKV + C_QM + h * 128 + d0 * 16 + c.hi * 8);
    rowmask = 0xFull << (4 * cj);
    if (cj > 0) {
        __syncthreads();
        { const h16x8 kk = *(const h16x8*)(KMT + (size_t)c.sr * 128 + c.sc); *(LAS h16x8*)(c.K_lds + c.kws) = kk; }
        __syncthreads();
        f32x16 p0, p1; qkt<0, true>(p0, p1, c, qr);
        float S[16];
#pragma unroll
        for (int r = 0; r < 8; ++r) { auto rr = __builtin_amdgcn_permlane32_swap(__float_as_uint(p0[r]), __float_as_uint(p0[r]), false, false);
            const int n = (r & 3) + 8 * (r >> 2); S[n] = __uint_as_float(rr[0]); S[n + 4] = __uint_as_float(rr[1]); }
#pragma unroll
        for (int n = 0; n < 16; ++n) S[n] = (n < cj) ? S[n] : -__builtin_inff();
#pragma unroll
        for (int n = 0; n < 16; ++n) { int cnt = 0;
#pragma unroll
            for (int mm = 0; mm < 16; ++mm) { if (mm < n) cnt += (S[mm] >= S[n]) ? 1 : 0; else if (mm > n) cnt += (S[mm] > S[n]) ? 1 : 0; }
            const unsigned long long bits = (n < cj && cnt < 3) ? (0xFull << (4 * n)) : 0ull; rowmask |= bits; }
        __syncthreads();
    }
}
#undef SBAR
}


#if DIAG
constexpr int CW_DIAG = 96;
#ifndef DIAG_FIELD
#define DIAG_FIELD 4
#endif
__device__ __forceinline__ void diag_max(unsigned* ctl, float v, int lane, unsigned payload = 0u) { if (lane == 0 && fabsf(v) > 2.0f) atomicAdd(ctl + CW_DIAG + 4, 1u); if (lane == 0) atomicMax((unsigned long long*)(ctl + CW_DIAG), ((unsigned long long)__float_as_uint(fabsf(v)) << 32) | payload); }
__device__ __forceinline__ float diag_dot_h(const h16* a, const float* W, int ldw, int col, int K, int lane) {
    float s = 0.f; for (int k = lane; k < K; k += 64) s += (float)a[k] * W[(size_t)k * ldw + col]; return wave_sum(s); }
__device__ __forceinline__ unsigned diag_hash(unsigned x) { x ^= x >> 16; x *= 0x7feb352du; x ^= x >> 15; x *= 0x846ca68bu; x ^= x >> 16; return x; }
__device__ __forceinline__ void diag_qkv(const Args& A, unsigned* ctl, int gw, int NGW, int lane) {
    const h16* H = (const h16*)(A.ws + WS_H); const h16* QKV = (const h16*)(A.ws + WS_QKV); const float* G = (const float*)(A.ws + WS_GATE);
    const float* COS = (const float*)(A.ws + WS_COS); const float* SIN = (const float*)(A.ws + WS_SIN); const float* W = A.in[6];
    for (int sidx = gw; sidx < 8192; sidx += NGW) {
        const unsigned hsh = diag_hash(sidx * 2 + 1); const int row = hsh % M; const int cs = (hsh >> 13) % INCOLS; const int t = row & (SEQ - 1);
        const h16* hr = H + (size_t)row * DM;
        if (cs >= 2560 && cs < 2584) { const float raw = diag_dot_h(hr, W, INCOLS, cs, DM, lane); diag_max(ctl, G[(size_t)row * 24 + cs - 2560] - 1.f / (1.f + expf(-raw)), lane); continue; }
        const int n = cs < 2560 ? cs : cs - 24; const int pn = n >> 8; const int add = cs < 2560 ? 0 : 24;
        const float got = (float)QKV[(size_t)row * NQKV + n];
        float want;
        if (pg8::is_rope_tile(pn)) { const int d = n & 127, hb = n & ~127; const float rd = diag_dot_h(hr, W, INCOLS, cs, DM, lane), rp = diag_dot_h(hr, W, INCOLS, hb + (d ^ 64) + add, DM, lane);
            const int i = d & 63; const float c = COS[t * 64 + i], s_ = SIN[t * 64 + i];
            want = d < 64 ? rd * c - rp * s_ : rd * c + rp * s_; if (pg8::is_q_tile(pn)) want *= QSCALE; }
        else want = diag_dot_h(hr, W, INCOLS, cs, DM, lane);
        diag_max(ctl, got - want, lane);
    }
}
__device__ __forceinline__ void diag_kc(const Args& A, unsigned* ctl, int gw, int NGW, int lane) {
    const h16* QKV = (const h16*)(A.ws + WS_QKV); const h16* KC = (const h16*)(A.ws + WS_KC);
    for (int sidx = gw; sidx < 256; sidx += NGW) {
        const unsigned hsh = diag_hash(sidx * 2 + 77); const int kv = hsh & 1, b = (hsh >> 1) & 1, g = (hsh >> 2) & 1, n = (hsh >> 3) % 255, c = (hsh >> 12) & 127;
        const float* pos = A.in[kv ? 10 : 7]; const float* w1 = A.in[kv ? 11 : 8]; const float* w2 = A.in[kv ? 12 : 9];
        const int colbase = (kv ? C_VCMP : C_KCMP) + g * 128;
        float h0 = 0.f, h1 = 0.f;
        for (int k = 0; k < 4096; ++k) { const int l = k >> 7, d = k & 127; const float a = (float)QKV[(size_t)(b * SEQ + 16 * n + l) * NQKV + colbase + d] + pos[k];
            h0 += a * w1[(size_t)k * 128 + lane]; h1 += a * w1[(size_t)k * 128 + 64 + lane]; }
        h0 = h0 / (1.f + expf(-h0)); h1 = h1 / (1.f + expf(-h1));
        const float want = wave_sum(h0 * w2[lane * 128 + c] + h1 * w2[(64 + lane) * 128 + c]);
        const float got = (float)KC[((size_t)((kv * 2 + b) * 2 + g) * 256 + n) * 128 + c];
        diag_max(ctl, (got - want) * 2.f, lane);
    }
}
template <int MODE  >
__device__ __forceinline__ void diag_gemm(unsigned* ctl, const h16* Abuf, int K, const float* W, int N, const void* Cbuf, float scale, int gw, int NGW, int lane, unsigned salt) {
    for (int sidx = gw; sidx < 8192; sidx += NGW) {
        const unsigned hsh = diag_hash(sidx * 2 + salt); const int row = hsh % M; const int col = (hsh >> 13) % N;
        float want = diag_dot_h(Abuf + (size_t)row * K, W, N, col, K, lane); float got;
        if (MODE == 1) { want = fmaxf(want, 0.f); want *= want; got = (float)((const h16*)Cbuf)[(size_t)row * N + col]; } else got = ((const float*)Cbuf)[(size_t)row * N + col];
        diag_max(ctl, (got - want) * scale, lane);
    }
}

#ifndef DIAG_TMAX
#define DIAG_TMAX 4096
#endif
#ifndef DIAG_TMIN
#define DIAG_TMIN 0
#endif

__device__ __forceinline__ void diag_kmean(const Args& A, unsigned* ctl, int gw, int NGW, int lane) {
    const h16* QKV = (const h16*)(A.ws + WS_QKV); const h16* KM = (const h16*)(A.ws + WS_KMEAN);
    for (int sidx = gw; sidx < 256; sidx += NGW) {
        const int b = sidx >> 7, h = (sidx >> 4) & 7, nb = sidx & 15;
        const h16* Kh = QKV + (size_t)(b * SEQ) * NQKV + C_KM + h * 128;
        float m0 = 0.f, m1 = 0.f; for (int j = 0; j < 256; ++j) { const h16* kr = Kh + (size_t)(nb * 256 + j) * NQKV; m0 += (float)kr[lane]; m1 += (float)kr[64 + lane]; }
        const h16* kp = KM + ((size_t)(b * 8 + h) * 32 + nb) * 128;
        float d = fmaxf(fabsf((float)kp[lane] - m0 * (1.f / 256.f)), fabsf((float)kp[64 + lane] - m1 * (1.f / 256.f)));
#pragma unroll
        for (int o_ = 1; o_ < 64; o_ <<= 1) d = fmaxf(d, __shfl_xor(d, o_));
        diag_max(ctl, d * 100.f, lane, ((unsigned)nb << 8) | (b << 7) | (h << 4));
    }
}
struct OnlineSM { float m, Z, a0, a1; };
__device__ __forceinline__ void osm_key(OnlineSM& st, float qa, float qb, const h16* Krow, const h16* Vrow, int lane) {
    const float sc = wave_sum(qa * (float)Krow[lane] + qb * (float)Krow[64 + lane]);
    const float mn = fmaxf(st.m, sc), corr = expf(st.m - mn), w = expf(sc - mn);
    st.Z = st.Z * corr + w; st.a0 = st.a0 * corr + w * (float)Vrow[lane]; st.a1 = st.a1 * corr + w * (float)Vrow[64 + lane]; st.m = mn;
}
__device__ __forceinline__ void diag_nsa(const Args& A, unsigned* ctl, LAS unsigned char* lds, int gw, int NGW, int wave, int lane) {
    const h16* QKV = (const h16*)(A.ws + WS_QKV); const float* G = (const float*)(A.ws + WS_GATE); const h16* O = (const h16*)(A.ws + WS_O);
    LAS float* pl = (LAS float*)(lds + wave * 4096);
    LAS float* impl = pl + 256;
    for (int sidx = gw; sidx < 16384; sidx += NGW) {
        const unsigned hsh = diag_hash(sidx * 2 + 101); const int b = hsh & 1, g = (hsh >> 1) & 1, hh = (hsh >> 2) & 3;
        int t = DIAG_TMIN + (int)((hsh >> 4) % (unsigned)(DIAG_TMAX - DIAG_TMIN)); if (sidx < 256) t = DIAG_TMIN + (sidx % (DIAG_TMAX - DIAG_TMIN));
        const int cb = t >> 6; const int nvis = t >= 31 ? ((t - 31) >> 4) + 1 : 0;
        const h16* KC = (const h16*)(A.ws + WS_KC) + ((size_t)((0 * 2 + b) * 2 + g) * 256) * 128;
        const h16* VC = (const h16*)(A.ws + WS_KC) + ((size_t)((1 * 2 + b) * 2 + g) * 256) * 128;
        const size_t tokrow = (size_t)(b * SEQ + t);
        if (lane < 64) impl[lane] = 0.f;
        float oc0 = 0.f, oc1 = 0.f, myqa = 0.f, myqb = 0.f;
        for (int h4 = 0; h4 < 4; ++h4) {
            const h16* qp = QKV + tokrow * NQKV + C_QN + (g * 4 + h4) * 128; const float qa = (float)qp[lane], qb = (float)qp[64 + lane];
            if (h4 == hh) { myqa = qa; myqb = qb; }
            float mx = -__builtin_inff();
            for (int n = 0; n < nvis; ++n) { const float sc = wave_sum(qa * (float)KC[n * 128 + lane] + qb * (float)KC[n * 128 + 64 + lane]); if (lane == 0) pl[n] = sc; mx = fmaxf(mx, sc); }
            float Z = 0.f; for (int n = 0; n < nvis; ++n) Z += expf(pl[n] - mx);
            for (int n = lane; n < 256; n += 64) pl[n] = n < nvis ? expf(pl[n] - mx) / Z : 0.f;
            { const int s_ = lane; float v = pl[4 * s_] + pl[4 * s_ + 1] + pl[4 * s_ + 2] + 0.5f * pl[4 * s_ + 3] + (s_ > 0 ? 0.5f * pl[4 * s_ - 1] : 0.f); impl[s_] += v; }
            if (h4 == hh) for (int n = 0; n < nvis; ++n) { const float p = pl[n]; oc0 += p * (float)VC[n * 128 + lane]; oc1 += p * (float)VC[n * 128 + 64 + lane]; }
        }
        const int s_ = lane; const bool causal = s_ <= cb, forced = (s_ == 0) || (s_ == cb) || (s_ == cb - 1);
        const float key = causal ? (forced ? __builtin_inff() : impl[s_]) : -__builtin_inff();
        int rank = 0; for (int j = 0; j < 64; ++j) { const float kj = __shfl(key, j); rank += (kj > key || (kj == key && j < s_)) ? 1 : 0; }
        const unsigned long long selmask = __ballot(rank < 16 && causal);
        OnlineSM ss; ss.m = -__builtin_inff(); ss.Z = 0.f; ss.a0 = 0.f; ss.a1 = 0.f;
        const h16* Ks = QKV + (size_t)(b * SEQ) * NQKV + C_KSEL + g * 128; const h16* Vs = QKV + (size_t)(b * SEQ) * NQKV + C_VSEL + g * 128;
        for (int blk = 0; blk <= cb; ++blk) if ((selmask >> blk) & 1ull) for (int l = 0; l < 64; ++l) { const int kp = 64 * blk + l; if (kp <= t) osm_key(ss, myqa, myqb, Ks + (size_t)kp * NQKV, Vs + (size_t)kp * NQKV, lane); }
        OnlineSM sw; sw.m = -__builtin_inff(); sw.Z = 0.f; sw.a0 = 0.f; sw.a1 = 0.f;
        const h16* Kw = QKV + (size_t)(b * SEQ) * NQKV + C_KWIN + g * 128; const h16* Vw = QKV + (size_t)(b * SEQ) * NQKV + C_VWIN + g * 128;
        for (int kp = (t - 511 > 0 ? t - 511 : 0); kp <= t; ++kp) osm_key(sw, myqa, myqb, Kw + (size_t)kp * NQKV, Vw + (size_t)kp * NQKV, lane);
        const float* gp = G + tokrow * 24 + (g * 4 + hh) * 3;
        const float w0 = gp[0] * oc0 + gp[1] * ss.a0 / ss.Z + gp[2] * sw.a0 / sw.Z, w1 = gp[0] * oc1 + gp[1] * ss.a1 / ss.Z + gp[2] * sw.a1 / sw.Z;
        const h16* op = O + tokrow * DM + (g * 4 + hh) * 128;
        float d = fmaxf(fabsf((float)op[lane] - w0), fabsf((float)op[64 + lane] - w1));
#pragma unroll
        for (int o_ = 1; o_ < 64; o_ <<= 1) d = fmaxf(d, __shfl_xor(d, o_));
        diag_max(ctl, d * 10.f, lane, ((unsigned)t << 8) | (b << 7) | (g << 6) | (hh << 4));
    }
}
__device__ __forceinline__ void diag_moba(const Args& A, unsigned* ctl, int gw, int NGW, int lane) {
    const h16* QKV = (const h16*)(A.ws + WS_QKV); const h16* O = (const h16*)(A.ws + WS_O);
    for (int sidx = gw; sidx < 2048; sidx += NGW) {
        const unsigned hsh = diag_hash(sidx * 2 + 203); const int b = hsh & 1, h = (hsh >> 1) & 7;
        int t = DIAG_TMIN + (int)((hsh >> 4) % (unsigned)(DIAG_TMAX - DIAG_TMIN)); if (sidx < 256) t = DIAG_TMIN + ((sidx * 37) % (DIAG_TMAX - DIAG_TMIN));
        const int cur = t >> 8; const size_t tokrow = (size_t)(b * SEQ + t);
        const h16* qp = QKV + tokrow * NQKV + C_QM + h * 128; const float qa = (float)qp[lane], qb = (float)qp[64 + lane];
        const h16* Kh = QKV + (size_t)(b * SEQ) * NQKV + C_KM + h * 128; const h16* Vh = QKV + (size_t)(b * SEQ) * NQKV + C_VM + h * 128;
        float key = -__builtin_inff();
        for (int n = 0; n < cur; ++n) { float m0 = 0.f, m1 = 0.f; for (int j = 0; j < 256; ++j) { const h16* kr = Kh + (size_t)(n * 256 + j) * NQKV; m0 += (float)kr[lane]; m1 += (float)kr[64 + lane]; }
            const float sc = wave_sum(qa * (m0 * (1.f / 256.f)) + qb * (m1 * (1.f / 256.f))); if (lane == n) key = sc; }
        int rank = 0; for (int j = 0; j < 16; ++j) { const float kj = __shfl(key, j); rank += (kj > key || (kj == key && j < lane)) ? 1 : 0; }
        const unsigned long long selmask = __ballot(lane < cur && rank < 3);
        if (DIAG_SELCMP) { const unsigned long long km = ((const unsigned long long*)(A.ws + 329 * MiB))[(size_t)(b * 8 + h) * SEQ + t];
            unsigned long long want = 0xFull << (4 * cur); for (int n = 0; n < cur; ++n) if ((selmask >> n) & 1ull) want |= 0xFull << (4 * n);
            diag_max(ctl, km == want ? 0.f : 10.f, lane, ((unsigned)t << 8) | (b << 7) | (h << 4)); continue; }
        OnlineSM ss; ss.m = -__builtin_inff(); ss.Z = 0.f; ss.a0 = 0.f; ss.a1 = 0.f;
        for (int n = 0; n < cur; ++n) if ((selmask >> n) & 1ull) for (int j = 0; j < 256; ++j) { const int kp = n * 256 + j; osm_key(ss, qa, qb, Kh + (size_t)kp * NQKV, Vh + (size_t)kp * NQKV, lane); }
        for (int kp = cur * 256; kp <= t; ++kp) osm_key(ss, qa, qb, Kh + (size_t)kp * NQKV, Vh + (size_t)kp * NQKV, lane);
        const h16* op = O + tokrow * DM + 1024 + h * 128;
        float d = fmaxf(fabsf((float)op[lane] - ss.a0 / ss.Z), fabsf((float)op[64 + lane] - ss.a1 / ss.Z));
#pragma unroll
        for (int o_ = 1; o_ < 64; o_ <<= 1) d = fmaxf(d, __shfl_xor(d, o_));
        diag_max(ctl, d * 10.f, lane, ((unsigned)t << 8) | (b << 7) | (h << 4));
    }
}
#endif

__device__ __forceinline__ void run_t_item(const float* c_in, const float* w_ada, const float* b_ada, const float* w_dn, const float* w_up, const float* w_o, unsigned char* ws, LAS unsigned char* L, unsigned t) {
    int tl = threadIdx.x; asm volatile("" : "+v"(tl));
    const int ln = tl & 63, wv = __builtin_amdgcn_readfirstlane(tl >> 6), q16 = ln & 15;
    if (t < (unsigned)NT_GV) { const int r_ = (int)t * 8 + wv; gemv_half(c_in, w_ada, b_ada, (float*)(ws + WS_MOD), 16 + (r_ & 31), r_ >> 5, ln); return; }
    t -= (unsigned)NT_GV;
    LAS float* scr = (LAS float*)(L + wv * 16640);
    int r = (int)t * 8 + wv; const float* W; int ldw, K, sh; h16* WT;
    if (r < 2048) { W = w_dn; ldw = DM; K = DFF; WT = (h16*)(ws + WS_WDN); sh = 5; }
    else if (r < 4096) { r -= 2048; W = w_up; ldw = DFF; K = DM; WT = (h16*)(ws + WS_WUP); sh = 7; }
    else { r -= 4096; W = w_o; ldw = DM; K = DM; WT = (h16*)(ws + WS_WO); sh = 5; }
    const int kb = r >> sh, nb = r & ((1 << sh) - 1);
    transpose_item128<true>(W, ldw, K, WT, 128 * kb, 64 * nb, 64 * nb + 4 * q16, 4 * q16, scr, ln);
}

__global__ void __launch_bounds__(NWAVES * 64, 2) hymba_fwd(Args args) {
    extern __shared__ __attribute__((aligned(16))) unsigned char lds[];
    LAS unsigned char* L = (LAS unsigned char*)lds;
    volatile LAS unsigned* LCTL = (volatile LAS unsigned*)(L + LDSCTL_OFF);
    const int tid = threadIdx.x, lane = tid & 63, wave = __builtin_amdgcn_readfirstlane(tid >> 6);
    const int G = gridDim.x; const int bx = blockIdx.x; const int vcu = (G % 8 == 0) ? (bx % 8) * (G / 8) + bx / 8 : bx;
    const int NGW = G * NWAVES; (void)lane; (void)wave;
    unsigned* ctl = (unsigned*)(args.ws + WS_CTL);
    for (int u = tid; u < (LDS_BYTES - LDSCTL_OFF) / 4; u += NWAVES * 64) ((LAS unsigned*)(L + LDSCTL_OFF))[u] = 0u;
    __syncthreads();
    XcdBarrier bar; bar.bar = ctl + CW_BAR; bar.x = 0; bar.st = nullptr;
    if (MK_N_LAUNCHES == 1) bar = xcd_barrier_post(ctl + CW_BAR, LCTL);
    const int lo = args.ph_lo, hi = args.ph_hi;
#ifndef PH_MASK
#define PH_MASK 0x3ff
#endif
#define IN(k) (((PH_MASK >> (k)) & 1) && lo <= (k) && (k) < hi)
#define SEAM(k) do { if (IN(k) && IN((k) + 1)) xcd_barrier(bar); } while (0)
#define NREP(k) ((REPEAT_PH == (k)) ? 2 : 1)
#define FRESH() int tid_ = threadIdx.x; asm volatile("" : "+v"(tid_)); const int lane_ = tid_ & 63, wave_ = __builtin_amdgcn_readfirstlane(tid_ >> 6); const int gw_ = vcu * NWAVES + wave_; (void)lane_; (void)gw_

    if (IN(0)) { FRESH(); for (int rep = 0; rep < NREP(0); ++rep) p0_prologue(args, L, gw_, NGW, wave_, lane_, rep); }
    SEAM(0);
    if (IN(1)) { FRESH(); for (int rep = 0; rep < NREP(1); ++rep) p1_rows(args, gw_, NGW, lane_); }
    SEAM(1);
    if (IN(2)) {
        pg8::Gemm g{(const h16*)(args.ws + WS_H), (const h16*)(args.ws + WS_WIN), M, NPAD, DM}; pg8::StaticOrder S; S.init(M, NPAD, G, bx, WGM_P2);
        pg8::EpiQKV E{(h16*)(args.ws + WS_QKV), (float*)(args.ws + WS_GATE), (const float*)(args.ws + WS_COS), (const float*)(args.ws + WS_SIN)};
        for (int rep = 0; rep < NREP(2); ++rep) pg8::gemm_phase<pg8::EpiQKV, pg8::StaticOrder, true, true>(L, g, S, E);
        if (T_IN_P4 && T_P2_ITEMS > 0 && IN(4) && (S.nwg % G) != 0 && bx >= (S.nwg % G)) { FRESH();
#pragma unroll 1
            for (int k = 0; k < T_P2_ITEMS; ++k) { __syncthreads(); if (tid_ == 0) LCTL[2] = __hip_atomic_fetch_add(ctl + CW_QUEUE + 8, 1u, __ATOMIC_RELAXED, __HIP_MEMORY_SCOPE_AGENT); __syncthreads();
                const unsigned t = (unsigned)__builtin_amdgcn_readfirstlane((int)LCTL[2]); if (t >= (unsigned)NT_ITEMS) break; run_t_item(args.in[1], args.in[2], args.in[3], args.in[17], args.in[16], args.in[13], args.ws, L, t); } }
    }
    SEAM(2);
#if DIAG
    if (DIAG & 1) { FRESH(); diag_qkv(args, ctl, gw_, NGW, lane_); }
#endif
    if (IN(3)) {
        FRESH();
        for (int rep = 0; rep < NREP(3); ++rep)
        if (P3_SPLITK && G == 256 && NREP(3) == 1) { p3_compress_splitk(args, L, ctl, bx, wave_, lane_); if ((bx & 7) >= 4) p3_kmean_item(args, L, (bx >> 3) * 4 + (bx & 7) - 4, wave_, lane_, ctl); }
        else
        for (int it = bx; it < 256; it += G) { if (it < 128) p3_compress_item(args, L, it, wave_, lane_); else p3_kmean_item(args, L, it - 128, wave_, lane_); }
    }
    const bool p34 = P34_HANDOFF && P3_SPLITK && G == 256 && IN(3) && IN(4) && NREP(3) == 1 && NREP(4) == 1;
    if (!p34) SEAM(3);
#if DIAG
    if (DIAG & 2) { FRESH(); diag_kc(args, ctl, gw_, NGW, lane_); }
#endif
    if (IN(4)) {
        FRESH();
#ifndef Q_DED
#define Q_DED 16
#endif
#ifndef Q_RES
#define Q_RES 200
#endif
#define Q_FETCH(qv) do { __syncthreads(); if (tid_ == 0) { unsigned mode = LCTL[3], item = 0xffffu; \
            if (mode == 0u) { const unsigned t = __hip_atomic_fetch_add(ctl + CW_QUEUE + 8 + rep4, 1u, __ATOMIC_RELAXED, __HIP_MEMORY_SCOPE_AGENT); if (t + Q_RES + 1 >= (unsigned)NT_ITEMS) mode = 1u; if (t < (unsigned)NT_ITEMS) item = 0x4000u | t; } \
            if (item == 0xffffu && mode == 1u) { const unsigned a_ = __hip_atomic_fetch_add(ctl + CW_QUEUE + rep4, 1u, __ATOMIC_RELAXED, __HIP_MEMORY_SCOPE_AGENT); if (a_ < 512u) item = args.order[a_]; else mode = 2u; } \
            if (item == 0xffffu && mode == 2u) { const unsigned t = __hip_atomic_fetch_add(ctl + CW_QUEUE + 8 + rep4, 1u, __ATOMIC_RELAXED, __HIP_MEMORY_SCOPE_AGENT); if (t < (unsigned)NT_ITEMS) item = 0x4000u | t; } \
            LCTL[3] = mode; LCTL[2] = item; } __syncthreads(); qv = (unsigned)__builtin_amdgcn_readfirstlane((int)LCTL[2]); } while (0)
        const h16* QKVp = (const h16*)(args.ws + WS_QKV);
        for (int rep4 = 0; rep4 < NREP(4); ++rep4) {
        if (rep4) xcd_barrier(bar);
        if (tid_ == 0) LCTL[3] = (T_IN_P4 && bx < Q_DED) ? 0u : 1u;
        for (;;) {
            unsigned v; Q_FETCH(v);
            if (v == 0xffffu) break;
            if (T_IN_P4 && (v & 0x4000u)) { run_t_item(args.in[1], args.in[2], args.in[3], args.in[17], args.in[16], args.in[13], args.ws, L, v & 0x3fffu); continue; }
#define MAKE_CTX(cn) int tl_##cn = threadIdx.x; asm volatile("" : "+v"(tl_##cn)); \
            att::Ctx cn; cn.tid = tl_##cn; cn.wid = __builtin_amdgcn_readfirstlane(tl_##cn >> 6); cn.lane = tl_##cn & 63; cn.r32 = cn.lane & 31; cn.hi = cn.lane >> 5; cn.sr = tl_##cn >> 4; cn.sc = (tl_##cn & 15) * 8; \
            cn.kws = KSWZ(cn.sr, cn.sc * 2); cn.vst0 = att::v_st(cn.sr, cn.sc); cn.vst1 = att::v_st(32 + cn.sr, cn.sc); \
            cn.lds = (LAS char*)L; cn.V_lds = cn.lds + att::L_V; cn.K_lds = cn.lds + att::L_K; cn.wsc = (LAS float*)(cn.lds + att::L_WS) + cn.wid * 64; \
            cn.vb0 = (int)(unsigned)(uintptr_t)cn.V_lds + att::v_rd_base(cn.lane)
            MAKE_CTX(c0);
            const bool moba = (v & 0x8000u) != 0u; const int b = (v >> 7) & 1;
            h16x8 qr[8]; f32x16 o[4] = {}; unsigned long long rowmask;
            if (p34 && tid_ == 0) { const int slot = moba ? 4 + b * 4 + (int)((v >> 5) & 3) : b * 2 + (int)((v >> 6) & 1); const unsigned bit = 1u << slot, want = moba ? 16u : 32u;
                if (!(LCTL[5] & bit)) { unsigned sp = 0u; while (__hip_atomic_load(ctl + CW_P34 + 64 * slot, __ATOMIC_RELAXED, __HIP_MEMORY_SCOPE_AGENT) < want) { __builtin_amdgcn_s_sleep(1); if (++sp > (1u << 22)) break; }
                    __builtin_amdgcn_fence(__ATOMIC_ACQUIRE, "agent"); LCTL[5] |= bit; } }
            if (moba) att::moba_prepare(args, c0, b, (v >> 4) & 7, v & 15, qr, rowmask);
            else att::nsa_prepare(args, c0, b, (v >> 6) & 1, v & 63, qr, o, rowmask, (h16*)(args.ws + WS_O));
            const int nbr = moba ? 1 : 2;
#pragma unroll 1
            for (int br = 0; br < nbr; ++br) {
                MAKE_CTX(c);
                int koff, voff, j_lo, j_hi, wq0, ocol; unsigned W; unsigned long long rm;
                if (moba) { const int h = (v >> 4) & 7, cj = v & 15; koff = C_KM + h * 128; voff = C_VM + h * 128; j_lo = 0; j_hi = 4 * cj + 4; W = 1u << 30; rm = rowmask; wq0 = 256 * cj + 32 * c.wid; ocol = 1024 + h * 128; }
                else { const int g = (v >> 6) & 1, ci = v & 63; wq0 = 64 * ci + (c.wid & 1) * 32; ocol = (g * 4 + (c.wid >> 1)) * 128; j_hi = ci + 1;
                    if (br == 0) { koff = C_KSEL + g * 128; voff = C_VSEL + g * 128; j_lo = 0; W = 1u << 30; rm = rowmask; }
                    else { koff = C_KWIN + g * 128; voff = C_VWIN + g * 128; j_lo = ci - 8 < 0 ? 0 : ci - 8; W = 512u; rm = ~0ull; } }
                const h16* Kp_ = QKVp + (size_t)(b * SEQ) * NQKV + koff; const h16* Vp_ = QKVp + (size_t)(b * SEQ) * NQKV + voff;
                h16* Ow_ = (h16*)(args.ws + WS_O) + (size_t)(b * SEQ + wq0) * DM + ocol;
                const float gate = moba ? 1.f : ((const float*)(args.ws + WS_GATE))[(size_t)(b * SEQ + wq0 + c.r32) * 24 + (ocol >> 7) * 3 + 1 + br];
                { att::SM sm; sm.m = -1e30f; sm.l = 0.f;
                att::run_attn9(c, qr, o, sm, Kp_, Vp_, NQKV, j_lo, j_hi, wq0 + c.r32, W, rm, wq0, wq0 + 31);
                att::finish(c, o, sm, gate); att::store_o(c, o, Ow_, DM, !moba); }
            }
        }
        }
#undef Q_FETCH
    }
    SEAM(4);
#if DIAG
    if (DIAG & 32) { FRESH(); diag_nsa(args, ctl, L, gw_, NGW, wave_, lane_); }
    if (DIAG & 64) { FRESH(); diag_moba(args, ctl, gw_, NGW, lane_); }
    if (DIAG & 128) { FRESH(); diag_kmean(args, ctl, gw_, NGW, lane_); }
#endif
    const bool fuse6 = FUSE_P6 && G == (M / 256) * (DM / 256) && IN(5) && IN(6);
    if (IN(5)) {
        pg8::Gemm g{(const h16*)(args.ws + WS_O), (const h16*)(args.ws + WS_WO), M, DM, DM}; pg8::StaticOrder S; S.init(M, DM, G, bx);
        if (fuse6) { pg8::EpiNormResNorm E{args.in[0], (h16*)(args.ws + WS_X1), (h16*)(args.ws + WS_H), (float*)(args.ws + WS_SSQ + 1 * MiB), (float*)(args.ws + WS_SSQ + 1 * MiB + 512 * 1024),
                                           ctl + CW_XCH + 2048, ctl + CW_XCH + 4096, args.in[5], args.in[14], (const float*)(args.ws + WS_MOD)};
            pg8::gemm_phase<pg8::EpiNormResNorm, pg8::StaticOrder, true, true>(L, g, S, E); }
        else { pg8::EpiF16SS E{(h16*)(args.ws + WS_OP), DM, (float*)(args.ws + WS_SSQ)};
        for (int rep = 0; rep < NREP(5); ++rep) pg8::gemm_phase<pg8::EpiF16SS, pg8::StaticOrder, true, true>(L, g, S, E); }
    }
    if (!fuse6) SEAM(5);
#if DIAG
    if (DIAG & 4) { FRESH(); diag_gemm<0>(ctl, (const h16*)(args.ws + WS_O), DM, args.in[13], DM, args.ws + WS_OP, 10.f, gw_, NGW, lane_, 5u); }
#endif
    if (IN(6) && !fuse6) { FRESH(); for (int rep = 0; rep < NREP(6); ++rep) p6_rows(args, gw_, NGW, lane_); }
    SEAM(6);
    const bool p78 = P78_HANDOFF && G == (M / 256) * (DM / 256) && IN(7) && IN(8) && NREP(7) == 1 && NREP(8) == 1;
    if (IN(7)) {
        pg8::Gemm g{(const h16*)(args.ws + WS_H), (const h16*)(args.ws + WS_WUP), M, DFF, DM}; pg8::StaticOrder S; S.init(M, DFF, G, bx, WGM_P7);
        pg8::EpiRelu2 E{(h16*)(args.ws + WS_U), DFF};
        for (int rep = 0; rep < NREP(7); ++rep) pg8::gemm_phase<pg8::EpiRelu2, pg8::StaticOrder, true, true>(L, g, S, E);
        if (p78 && threadIdx.x == 0) { pg8::Unit u_; for (int i = 0; S.next(i, u_); ++i) __hip_atomic_fetch_add(ctl + CW_P78 + 64 * u_.pm, 1u, __ATOMIC_RELAXED, __HIP_MEMORY_SCOPE_AGENT); }
    }
    if (!p78) SEAM(7);
#if DIAG
    if (DIAG & 8) { FRESH(); diag_gemm<1>(ctl, (const h16*)(args.ws + WS_H), DM, args.in[16], DFF, args.ws + WS_U, 1.f, gw_, NGW, lane_, 9u); }
#endif
    const bool fuse9 = FUSE_P9 && G == (M / 256) * (DM / 256) && IN(8) && IN(9);
    if (IN(8)) {
        pg8::Gemm g{(const h16*)(args.ws + WS_U), (const h16*)(args.ws + WS_WDN), M, DM, DFF}; pg8::StaticOrder S; S.init(M, DM, G, bx);
        if (p78) { pg8::Unit u_; if (S.next(0, u_) && threadIdx.x == 0) { unsigned sp = 0u;
                while (__hip_atomic_load(ctl + CW_P78 + 64 * u_.pm, __ATOMIC_RELAXED, __HIP_MEMORY_SCOPE_AGENT) < (unsigned)(DFF / 256)) { __builtin_amdgcn_s_sleep(1); if (++sp > (1u << 22)) break; }
                __builtin_amdgcn_fence(__ATOMIC_ACQUIRE, "agent"); }
            __syncthreads(); }
        if (fuse9) { pg8::EpiNormOut E{(const h16*)(args.ws + WS_X1), args.out, (float*)(args.ws + WS_SSQ + 2 * MiB), ctl + CW_XCH, args.in[15], (const float*)(args.ws + WS_MOD) + 5 * DM};
            pg8::gemm_phase<pg8::EpiNormOut, pg8::StaticOrder, true, true>(L, g, S, E); }
        else { pg8::EpiF16SS E{(h16*)(args.ws + WS_F), DM, (float*)(args.ws + WS_SSQ)};
        for (int rep = 0; rep < NREP(8); ++rep) pg8::gemm_phase<pg8::EpiF16SS, pg8::StaticOrder, true, true>(L, g, S, E); }
    }
    if (!fuse9) SEAM(8);
#if DIAG
    if (DIAG & 16) { FRESH(); diag_gemm<0>(ctl, (const h16*)(args.ws + WS_U), DFF, args.in[17], DM, args.ws + WS_F, 1.f, gw_, NGW, lane_, 13u); }
#endif
    if (IN(9) && !fuse9) { FRESH(); p9_rows(args, gw_, NGW, lane_); }
#if DIAG
    { xcd_barrier(bar); FRESH(); const unsigned long long dv = __hip_atomic_load((unsigned long long*)(ctl + CW_DIAG), __ATOMIC_RELAXED, __HIP_MEMORY_SCOPE_AGENT);
      const float mval = __uint_as_float((unsigned)(dv >> 32)); const unsigned pay = (unsigned)dv; const int pt = pay >> 8;
      float Cval = 1000.f * exp2f(ceilf(log2f(fmaxf(mval, 1e-12f))));
      if (DIAG_FIELD == 4) Cval = 10.f * (float)(1u + __hip_atomic_load(ctl + CW_DIAG + 4, __ATOMIC_RELAXED, __HIP_MEMORY_SCOPE_AGENT));
      if (DIAG_FIELD == 1) Cval = 10.f * (float)((pt >> 6) + 1);
      if (DIAG_FIELD == 2) Cval = 10.f * (float)((pt & 63) + 1);
      if (DIAG_FIELD == 3) Cval = 10.f * (float)(((pay >> 4) & 15) + 1);
      for (size_t e = (size_t)gw_ * 64 + lane_; e < (size_t)M * DM; e += (size_t)NGW * 64) args.out[e] = Cval; }
#endif
#undef IN
#undef SEAM
}

static void build_order(unsigned short* order) {
    struct It { int cost; unsigned short v; };
    It items[512]; int n = 0;
    for (int b = 0; b < 2; ++b) for (int g = 0; g < 2; ++g) for (int i = 0; i < 64; ++i) {
        const int ntc = ((4 * i + 2) >> 6) + 1; const int cost = 6 * ntc + 2 * (i + 1) + 2 * (i + 1 < 9 ? i + 1 : 9) + 40;
        items[n].cost = cost; items[n].v = (unsigned short)((b << 7) | (g << 6) | i); ++n; }
    for (int b = 0; b < 2; ++b) for (int h = 0; h < 8; ++h) for (int j = 0; j < 16; ++j) {
        items[n].cost = 2 * 4 * (j + 1) + 18; items[n].v = (unsigned short)(0x8000 | (b << 7) | (h << 4) | j); ++n; }
    for (int i = 1; i < 512; ++i) { It k = items[i]; int j = i - 1; while (j >= 0 && items[j].cost < k.cost) { items[j + 1] = items[j]; --j; } items[j + 1] = k; }
    if (1) { for (int i = 0; i < 512; ++i) order[i] = items[i].v; return; }
    const int NT = NT_ITEMS, TC = 7; long tot = (long)NT * TC; for (int i = 0; i < 512; ++i) tot += items[i].cost;
    const double tend = 0.8 * (double)tot / 256.0; int fr[256]; for (int w = 0; w < 256; ++w) fr[w] = 0;
    int nA = 0, nT = 0; n = 0;
    while (nA < 512 || nT < NT) {
        int w = 0; for (int u = 1; u < 256; ++u) if (fr[u] < fr[w]) w = u;
        const double tgt = 24.0 + (NT - 24) * (double)fr[w] / tend;
        if (nT < NT && (nA >= 512 || (double)nT < tgt)) { order[n++] = (unsigned short)(0x4000 | nT); ++nT; fr[w] += TC; }
        else { order[n++] = items[nA].v; fr[w] += items[nA].cost; ++nA; }
    }
}

extern "C" void kernel_launch(void* const* d_in, const int* in_sizes, int n_in, void* d_out, int out_size, void* d_ws, size_t ws_size, hipStream_t stream) {
    static int grid = 0; static Args a;
    if (grid == 0) {
        if (n_in != 18 || in_sizes[0] != M * DM || out_size != M * DM || ws_size < WS_END) { fprintf(stderr, "kernel_launch: unexpected shapes (n_in %d, in0 %d, out %d, ws %zu)\n", n_in, n_in > 0 ? in_sizes[0] : -1, out_size, ws_size); grid = -1; return; }
        int dev = 0, cus = 0, per_cu = 0;
        if (hipGetDevice(&dev) != hipSuccess || hipDeviceGetAttribute(&cus, hipDeviceAttributeMultiprocessorCount, dev) != hipSuccess) { grid = -1; return; }
        if (hipFuncSetAttribute((const void*)hymba_fwd, hipFuncAttributeMaxDynamicSharedMemorySize, LDS_BYTES) != hipSuccess) { fprintf(stderr, "kernel_launch: hipFuncSetAttribute failed\n"); grid = -1; return; }
        if (hipOccupancyMaxActiveBlocksPerMultiprocessor(&per_cu, (const void*)hymba_fwd, NWAVES * 64, LDS_BYTES) != hipSuccess || per_cu < 1) { fprintf(stderr, "kernel_launch: occupancy query says %d\n", per_cu); }
        (void)hipGetLastError();
        grid = cus;
        memset(&a, 0, sizeof(a));
        build_order(a.order);
    }
    if (grid < 0) return;
    (void)hipMemsetAsync((char*)d_ws + WS_CTL, 0, CTL_ZERO_BYTES, stream);
    for (int i = 0; i < 18; ++i) a.in[i] = (const float*)d_in[i];
    a.out = (float*)d_out; a.ws = (unsigned char*)d_ws;
    if (MK_N_LAUNCHES == 1) {
        a.ph_lo = 0; a.ph_hi = 10;
        void* params[] = {&a};
        hipError_t e = hipLaunchCooperativeKernel((const void*)hymba_fwd, dim3(grid), dim3(NWAVES * 64), params, LDS_BYTES, stream);
        if (e != hipSuccess) fprintf(stderr, "kernel_launch: cooperative launch failed: %s (grid %d)\n", hipGetErrorString(e), grid);
    } else {
        for (int p = 0; p < 10; ++p) { a.ph_lo = p; a.ph_hi = p + 1; hipLaunchKernelGGL(hymba_fwd, dim3(grid), dim3(NWAVES * 64), LDS_BYTES, stream, a); }
    }
}
```

```cpp
#include <hip/hip_runtime.h>
#include <cstdio>
#include <cstdint>
#include <cmath>
#include <cstring>

#ifndef DIAG
#define DIAG 0
#endif
#ifndef DIAG_SELCMP
#define DIAG_SELCMP 1
#endif
#ifndef PROBE_VAR
#define PROBE_VAR 2
#endif
#ifndef REPEAT_PH
#define REPEAT_PH -1
#ifndef T_P2_ITEMS
#define T_P2_ITEMS 6
#endif
#ifndef P0_BAL
#define P0_BAL 1
#endif
#ifndef WGM_P7
#define WGM_P7 2
#endif
#ifndef WGM_P2
#define WGM_P2 4
#endif
#ifndef P34_HANDOFF
#define P34_HANDOFF 1
#endif
#ifndef P78_HANDOFF
#define P78_HANDOFF 1
#endif
#ifndef GV_Q
#define GV_Q 1
#endif
#ifndef P3_SPLITK
#define P3_SPLITK 1
#endif
#ifndef FUSE_P9
#define FUSE_P9 1
#endif
#ifndef FUSE_P6
#define FUSE_P6 1
#endif
#endif
#ifndef MK_N_LAUNCHES
#define MK_N_LAUNCHES 1
#endif

typedef _Float16 h16;
typedef _Float16 h16x2 __attribute__((ext_vector_type(2)));
typedef _Float16 h16x8 __attribute__((ext_vector_type(8)));
typedef float f32x2 __attribute__((ext_vector_type(2)));
typedef float f32x4 __attribute__((ext_vector_type(4)));
typedef float f32x16 __attribute__((ext_vector_type(16)));
typedef unsigned u32x2 __attribute__((ext_vector_type(2)));
typedef unsigned u32x4 __attribute__((ext_vector_type(4)));
typedef short s16x4 __attribute__((ext_vector_type(4)));
typedef short s16x8 __attribute__((ext_vector_type(8)));

#define LAS __attribute__((address_space(3)))
#define GAS __attribute__((address_space(1)))

__device__ __forceinline__ unsigned pk2h(float lo, float hi) { f32x2 v = {lo, hi}; h16x2 h = __builtin_convertvector(v, h16x2); return __builtin_bit_cast(unsigned, h); }

constexpr int BATCH = 2, SEQ = 4096, DM = 2048, M = BATCH * SEQ, DFF = 8192, HD = 128;
constexpr int INCOLS = 5656, NQKV = 5632, NPAD = 5888;
constexpr int C_QN = 0, C_KCMP = 1024, C_VCMP = 1280, C_KSEL = 1536, C_VSEL = 1792, C_KWIN = 2048, C_VWIN = 2304, C_QM = 2560, C_KM = 3584, C_VM = 4608;
constexpr float EPS = 1e-6f;
constexpr float QSCALE = 0.08838834764831845f;
constexpr float LOG2E = 1.4426950408889634f;

constexpr size_t MiB = 1u << 20;
constexpr size_t WS_CTL = 0, CTL_ZERO_BYTES = 1 * MiB;
constexpr size_t WS_MOD = 512 * 1024;
constexpr size_t WS_POSB = 768 * 1024;
constexpr size_t WS_KMEAN = 1 * MiB + 64 * 1024;
constexpr size_t WS_KC = 1 * MiB + 512 * 1024;
constexpr size_t WS_COS = 2 * MiB, WS_SIN = 3 * MiB;
constexpr size_t WS_W1T = 4 * MiB;
constexpr size_t WS_W2T = 6 * MiB;
constexpr size_t WS_GATE = 6 * MiB + 512 * 1024;
constexpr size_t WS_SSQ = 328 * MiB;
constexpr size_t WS_WIN = 8 * MiB;
constexpr size_t WS_WO = 32 * MiB;
constexpr size_t WS_WUP = 40 * MiB;
constexpr size_t WS_WDN = 72 * MiB;
constexpr size_t WS_H = 104 * MiB;
constexpr size_t WS_QKV = 136 * MiB;
constexpr size_t WS_O = 224 * MiB;
constexpr size_t WS_OP = 256 * MiB;
constexpr size_t WS_U = 136 * MiB;
constexpr size_t WS_X1 = 296 * MiB;
constexpr size_t WS_F = 264 * MiB;
constexpr size_t WS_END = 331 * MiB;
constexpr int CW_QUEUE = 64;
constexpr int CW_XCH = 8192;
constexpr int CW_P34 = 16384;
constexpr int CW_P78 = 18432;
constexpr int CW_BAR = 4096;

__device__ __forceinline__ f32x4 unpack4h(u32x2 w) { const unsigned wx = w[0], wy = w[1];
    const h16x2 a = __builtin_bit_cast(h16x2, wx), b = __builtin_bit_cast(h16x2, wy); return (f32x4){(float)a.x, (float)a.y, (float)b.x, (float)b.y}; }

namespace pg8 {
constexpr int BM = 256, BK = 64, HALF = 128, HTB = HALF * BK * 2, STAGE_BYTES = 8 * HTB, NXCD = 8, WGM = 2;
__host__ __device__ __forceinline__ int lds_byte(int r, int c) { const int st = (r >> 4) * 2 + (c >> 5), rr = r & 15, cc = c & 31, ob = rr * 64 + cc * 2; return st * 1024 + (ob ^ (((ob >> 9) & 1) << 5)); }
__host__ __device__ __forceinline__ void stage_rc(int b, int& R, int& C) { const int st = b / 1024, sb = b % 1024, swz = sb ^ (((sb >> 9) & 1) << 5); R = (st >> 1) * 16 + swz / 64; C = (st & 1) * 32 + (swz % 64) / 2; }
__host__ __device__ __forceinline__ int perm32(int rho) { const int n = rho >> 4, i = rho & 15; return 8 * (i >> 2) + 4 * n + (i & 3); }
struct Unit { int pm, pn; };
struct Gemm { const h16* A; const h16* Bt; int M, N, K; };
struct StaticOrder {
    int nM, nN, nwg, G, c, wgm;
    __host__ __device__ void init(int M_, int N_, int G_, int c_, int wgm_ = WGM) { nM = M_ / BM; nN = N_ / BM; nwg = nM * nN; G = G_; c = c_; wgm = wgm_; }
    __host__ __device__ bool next(int i, Unit& u) const {
        const long L = (long)i * G + c; if (L >= nwg) return false;
        int wgid = (int)L; { const int q = nwg / NXCD, r = nwg % NXCD, xcd = wgid % NXCD, off = wgid / NXCD; wgid = (xcd < r ? xcd * (q + 1) : r * (q + 1) + (xcd - r) * q) + off; }
        const int nig = wgm * nN, gid = wgid / nig, fm = gid * wgm, gsz = (nM - fm) < wgm ? (nM - fm) : wgm;
        u.pm = fm + ((wgid % nig) % gsz); u.pn = (wgid % nig) / gsz; return true;
    }
};
template <class Epi, class Sched, bool ALIGN_EPI, bool SP2>
__device__ __forceinline__ void gemm_phase(LAS unsigned char* lds, const Gemm g, const Sched& S, const Epi& E) {
    const int tid = threadIdx.x, wid = __builtin_amdgcn_readfirstlane(tid >> 6), lane = tid & 63, wr = wid >> 2, wc = wid & 3, fr = lane & 15, fq = lane >> 4;
    const int K = g.K, nt = K / BK;
    unsigned voffA[2], voffB[2];
#pragma unroll
    for (int i = 0; i < 2; ++i) { int R, C; stage_rc(tid * 16 + i * 8192, R, C); const int Rb = Epi::PERM ? ((R & ~31) + perm32(R & 31)) : R;
        voffA[i] = (unsigned)(R * K + C) * 2u; voffB[i] = (unsigned)(Rb * K + C) * 2u; }
    const size_t kstep = (size_t)(BK * 2);
    const size_t hstep = (size_t)HALF * K * 2;
    const size_t tstep = 2 * hstep;
    const unsigned ldsw = (unsigned)wid * 1024u;
    const int aoff = lds_byte(wr * 64 + fr, fq * 8), boff = lds_byte(wc * 32 + fr, fq * 8);
#define PG8_SA(b, h) (((b) * 2 + (h)) * HTB)
#define PG8_SB(b, h) ((4 + (b) * 2 + (h)) * HTB)
#define PG8_STAGE(bufoff, gbase, voff) do { _Pragma("unroll") for (int _i = 0; _i < 2; ++_i) \
        __builtin_amdgcn_global_load_lds((const unsigned*)((const char*)(gbase) + (voff)[_i]), (LAS unsigned*)(lds + (bufoff) + ldsw + _i * 8192), 16, 0, 0); } while (0)
#define PG8_LDA(dst, b, h) do { _Pragma("unroll") for (int m = 0; m < 4; ++m) _Pragma("unroll") for (int k = 0; k < 2; ++k) dst[m][k] = *(const LAS h16x8*)(lds + PG8_SA(b, h) + aoff + m * 2048 + k * 1024); } while (0)
#define PG8_LDB(dst, b, h) do { _Pragma("unroll") for (int n = 0; n < 2; ++n) _Pragma("unroll") for (int k = 0; k < 2; ++k) dst[n][k] = *(const LAS h16x8*)(lds + PG8_SB(b, h) + boff + n * 2048 + k * 1024); } while (0)
#define PG8_MMA(ai, bj, At, Bt) do { __builtin_amdgcn_s_setprio(1); _Pragma("unroll") for (int m = 0; m < 4; ++m) _Pragma("unroll") for (int n = 0; n < 2; ++n) _Pragma("unroll") for (int k = 0; k < 2; ++k) \
        acc[ai][bj][m][n] = __builtin_amdgcn_mfma_f32_16x16x32_f16(Bt[n][k], At[m][k], acc[ai][bj][m][n], 0, 0, 0); __builtin_amdgcn_s_setprio(0); } while (0)
#define PG8_WAIT_V(n) asm volatile("s_waitcnt vmcnt(" #n ")" ::: "memory")
#define PG8_WAIT_L(n) asm volatile("s_waitcnt lgkmcnt(" #n ")" ::: "memory")
#define PG8_BAR __builtin_amdgcn_s_barrier()
#define PG8_SCHED __builtin_amdgcn_sched_barrier(0)
    Unit cur, nxt; int ui = 0;
    if (!S.next(0, cur)) return;
    f32x4 acc[2][2][4][2];
#pragma unroll
    for (int a = 0; a < 2; ++a)
#pragma unroll
        for (int b = 0; b < 2; ++b)
#pragma unroll
            for (int m = 0; m < 4; ++m)
#pragma unroll
                for (int n = 0; n < 2; ++n) acc[a][b][m][n] = (f32x4){0.f, 0.f, 0.f, 0.f};
    h16x8 At[4][2], B0[2][2], B1[2][2];
    const char* cA = (const char*)g.A + (size_t)cur.pm * tstep; const char* cB = (const char*)g.Bt + (size_t)cur.pn * tstep;
    if constexpr (SP2) {
        PG8_STAGE(PG8_SB(0, 0), cB, voffB); PG8_STAGE(PG8_SB(0, 1), cB + hstep, voffB); PG8_STAGE(PG8_SA(0, 0), cA, voffA); PG8_STAGE(PG8_SA(0, 1), cA + hstep, voffA);
        if (wr == 1) PG8_BAR;
        PG8_WAIT_V(2); PG8_BAR;
        PG8_STAGE(PG8_SB(1, 0), cB + kstep, voffB); PG8_STAGE(PG8_SA(1, 0), cA + kstep, voffA); PG8_STAGE(PG8_SB(1, 1), cB + hstep + kstep, voffB);
        PG8_WAIT_V(6); PG8_BAR;
    } else {
        PG8_STAGE(PG8_SB(0, 0), cB, voffB); PG8_STAGE(PG8_SA(0, 0), cA, voffA); PG8_STAGE(PG8_SB(0, 1), cB + hstep, voffB); PG8_STAGE(PG8_SA(0, 1), cA + hstep, voffA);
        if (wr == 1) PG8_BAR;
        PG8_WAIT_V(4); PG8_BAR;
        PG8_STAGE(PG8_SB(1, 0), cB + kstep, voffB); PG8_STAGE(PG8_SA(1, 0), cA + kstep, voffA); PG8_STAGE(PG8_SB(1, 1), cB + hstep + kstep, voffB);
        PG8_WAIT_V(6); PG8_BAR;
    }
    for (;;) {
        const bool has_next = S.next(ui + 1, nxt);
        const char* nA = has_next ? (const char*)g.A + (size_t)nxt.pm * tstep : cA; const char* nB = has_next ? (const char*)g.Bt + (size_t)nxt.pn * tstep : cB;
        for (int t = 0; t < nt; t += 2) {
            const bool last = (t == nt - 2);
            const char* a1 = cA + (size_t)(t + 1) * kstep;
            const char* a2 = last ? nA : cA + (size_t)(t + 2) * kstep; const char* b2 = last ? nB : cB + (size_t)(t + 2) * kstep;
            const char* a3 = a2 + kstep; const char* b3 = b2 + kstep;
            if constexpr (SP2) {
            PG8_LDB(B0, 0, 0); PG8_LDB(B1, 0, 1); PG8_SCHED; PG8_LDA(At, 0, 0); PG8_STAGE(PG8_SA(1, 1), a1 + hstep, voffA);
            PG8_WAIT_V(8); PG8_WAIT_L(0); PG8_BAR; PG8_MMA(0, 0, At, B0); PG8_MMA(0, 1, At, B1); PG8_BAR; PG8_SCHED;
            PG8_LDA(At, 0, 1); PG8_STAGE(PG8_SB(0, 0), b2, voffB); PG8_STAGE(PG8_SB(0, 1), b2 + hstep, voffB); PG8_STAGE(PG8_SA(0, 0), a2, voffA);
            PG8_WAIT_V(8); PG8_WAIT_L(0); PG8_BAR; PG8_MMA(1, 0, At, B0); PG8_MMA(1, 1, At, B1); PG8_BAR; PG8_SCHED;
            PG8_LDB(B0, 1, 0); PG8_LDB(B1, 1, 1); PG8_SCHED; PG8_LDA(At, 1, 0); PG8_STAGE(PG8_SA(0, 1), a2 + hstep, voffA);
            PG8_WAIT_V(8); PG8_WAIT_L(0); PG8_BAR; PG8_MMA(0, 0, At, B0); PG8_MMA(0, 1, At, B1); PG8_BAR; PG8_SCHED;
            PG8_LDA(At, 1, 1); PG8_STAGE(PG8_SB(1, 0), b3, voffB); PG8_STAGE(PG8_SB(1, 1), b3 + hstep, voffB); PG8_STAGE(PG8_SA(1, 0), a3, voffA);
            PG8_WAIT_V(8); PG8_WAIT_L(0); PG8_BAR; PG8_MMA(1, 0, At, B0); PG8_MMA(1, 1, At, B1); PG8_BAR; PG8_SCHED;
            } else {
            PG8_LDB(B0, 0, 0); PG8_SCHED; PG8_LDA(At, 0, 0); PG8_STAGE(PG8_SA(1, 1), a1 + hstep, voffA);
            PG8_WAIT_L(8); PG8_BAR; PG8_WAIT_L(0); PG8_MMA(0, 0, At, B0); PG8_BAR; PG8_SCHED;
            PG8_LDB(B1, 0, 1); PG8_STAGE(PG8_SB(0, 0), b2, voffB);
            PG8_BAR; PG8_WAIT_L(0); PG8_MMA(0, 1, At, B1); PG8_BAR;
            PG8_LDA(At, 0, 1); PG8_STAGE(PG8_SA(0, 0), a2, voffA);
            PG8_BAR; PG8_WAIT_L(0); PG8_MMA(1, 0, At, B0); PG8_BAR; PG8_SCHED;
            PG8_STAGE(PG8_SB(0, 1), b2 + hstep, voffB);
            PG8_WAIT_V(6); PG8_BAR; PG8_MMA(1, 1, At, B1); PG8_BAR;
            PG8_LDB(B0, 1, 0); PG8_SCHED; PG8_LDA(At, 1, 0); PG8_STAGE(PG8_SA(0, 1), a2 + hstep, voffA);
            PG8_WAIT_L(8); PG8_BAR; PG8_WAIT_L(0); PG8_MMA(0, 0, At, B0); PG8_BAR; PG8_SCHED;
            PG8_LDB(B1, 1, 1); PG8_STAGE(PG8_SB(1, 0), b3, voffB);
            PG8_BAR; PG8_WAIT_L(0); PG8_MMA(0, 1, At, B1); PG8_BAR;
            PG8_LDA(At, 1, 1); PG8_STAGE(PG8_SA(1, 0), a3, voffA);
            PG8_BAR; PG8_WAIT_L(0); PG8_MMA(1, 0, At, B0); PG8_BAR; PG8_SCHED;
            PG8_STAGE(PG8_SB(1, 1), b3 + hstep, voffB);
            PG8_WAIT_V(6); PG8_BAR; PG8_MMA(1, 1, At, B1); PG8_BAR;
            }
        }
        if constexpr (ALIGN_EPI) { if (wr == 0) PG8_BAR; }
        if constexpr (!Epi::AFTER_DRAIN) E(acc, cur, wr, wc, fr, fq);
        if (!has_next) break;
#pragma unroll
        for (int a = 0; a < 2; ++a)
#pragma unroll
            for (int b = 0; b < 2; ++b)
#pragma unroll
                for (int m = 0; m < 4; ++m)
#pragma unroll
                    for (int n = 0; n < 2; ++n) acc[a][b][m][n] = (f32x4){0.f, 0.f, 0.f, 0.f};
        cur = nxt; cA = nA; cB = nB; ++ui;
        if constexpr (ALIGN_EPI) { if (wr == 1) PG8_BAR; }
    }
    PG8_WAIT_V(0);
    if constexpr (!ALIGN_EPI) { if (wr == 0) PG8_BAR; }
    PG8_BAR;
    if constexpr (Epi::AFTER_DRAIN) E.fused(acc, cur, wr, wc, fr, fq, lds, wid, lane);
#undef PG8_SA
#undef PG8_SB
#undef PG8_STAGE
#undef PG8_LDA
#undef PG8_LDB
#undef PG8_MMA
#undef PG8_WAIT_V
#undef PG8_WAIT_L
#undef PG8_BAR
#undef PG8_SCHED
}

__device__ __forceinline__ bool is_rope_tile(int pn) { return pn < 4 || pn == 4 || pn == 6 || pn == 8 || (pn >= 10 && pn < 18); }
__device__ __forceinline__ bool is_q_tile(int pn) { return pn < 4 || (pn >= 10 && pn < 14); }
struct EpiQKV {
    static constexpr bool PERM = true, AFTER_DRAIN = false;
    h16* QKV; float* G; const float* COS; const float* SIN;
    __device__ __forceinline__ void operator()(const f32x4 (&acc)[2][2][4][2], const Unit& u, int wr, int wc, int fr, int fq) const {
        const int pn = u.pn;
        const int row0 = u.pm * BM + wr * 64 + fr;
        if (pn == 22) {
            if (wc == 0 && fq < 3) {
#pragma unroll
                for (int ai = 0; ai < 2; ++ai)
#pragma unroll
                    for (int m = 0; m < 4; ++m) { const int row = row0 + ai * HALF + m * 16; float* gp = G + (size_t)row * 24 + 8 * fq;
                        f32x4 v0 = acc[ai][0][m][0], v1 = acc[ai][0][m][1];
#pragma unroll
                        for (int e = 0; e < 4; ++e) { v0[e] = 1.f / (1.f + __expf(-v0[e])); v1[e] = 1.f / (1.f + __expf(-v1[e])); }
                        *(f32x4*)gp = v0; *(f32x4*)(gp + 4) = v1; }
            }
            return;
        }
        if (is_rope_tile(pn)) {
            const float sc = is_q_tile(pn) ? QSCALE : 1.f;
            const int a4 = 4 * (4 * wc + fq);
#pragma unroll
            for (int ai = 0; ai < 2; ++ai)
#pragma unroll
                for (int m = 0; m < 4; ++m) { const int row = row0 + ai * HALF + m * 16; const int t = row & (SEQ - 1);
                    const f32x4 c4 = *(const f32x4*)(COS + t * 64 + a4), s4 = *(const f32x4*)(SIN + t * 64 + a4);
                    h16* rowp = QKV + (size_t)row * NQKV + pn * BM + a4;
#pragma unroll
                    for (int bj = 0; bj < 2; ++bj) { const f32x4 x1 = acc[ai][bj][m][0], x2 = acc[ai][bj][m][1];
                        const f32x4 o1 = (x1 * c4 - x2 * s4) * sc, o2 = (x2 * c4 + x1 * s4) * sc;
                        u32x2 w1; w1.x = pk2h(o1[0], o1[1]); w1.y = pk2h(o1[2], o1[3]);
                        u32x2 w2; w2.x = pk2h(o2[0], o2[1]); w2.y = pk2h(o2[2], o2[3]);
                        const auto r0 = __builtin_amdgcn_permlane16_swap(w1.x, w2.x, false, false); const auto r1 = __builtin_amdgcn_permlane16_swap(w1.y, w2.y, false, false);
                        const u32x4 wq = {r0[0], r1[0], r0[1], r1[1]};
                        *(u32x4*)(rowp + bj * HALF + ((fq & 1) ? 60 : 0)) = wq; } }
        } else {
            const int col0 = pn * BM + wc * 32 + 8 * fq;
#pragma unroll
            for (int ai = 0; ai < 2; ++ai)
#pragma unroll
                for (int m = 0; m < 4; ++m) { h16* rowp = QKV + (size_t)(row0 + ai * HALF + m * 16) * NQKV + col0;
#pragma unroll
                    for (int bj = 0; bj < 2; ++bj) { const f32x4 v0 = acc[ai][bj][m][0], v1 = acc[ai][bj][m][1];
                        u32x4 w; w.x = pk2h(v0[0], v0[1]); w.y = pk2h(v0[2], v0[3]); w.z = pk2h(v1[0], v1[1]); w.w = pk2h(v1[2], v1[3]);
                        *(u32x4*)(rowp + bj * HALF) = w; } }
        }
    }
};
struct EpiF16SS {
    static constexpr bool PERM = true, AFTER_DRAIN = false;
    h16* C; int ldc; float* SSQ;
    __device__ __forceinline__ void operator()(const f32x4 (&acc)[2][2][4][2], const Unit& u, int wr, int wc, int fr, int fq) const {
        const int row0 = u.pm * BM + wr * 64 + fr, col0 = u.pn * BM + wc * 32 + 8 * fq;
#pragma unroll
        for (int ai = 0; ai < 2; ++ai)
#pragma unroll
            for (int m = 0; m < 4; ++m) { const int row = row0 + ai * HALF + m * 16; h16* rowp = C + (size_t)row * ldc + col0; float s = 0.f;
#pragma unroll
                for (int bj = 0; bj < 2; ++bj) { const f32x4 v0 = acc[ai][bj][m][0], v1 = acc[ai][bj][m][1];
                    s += ((v0[0] * v0[0] + v0[1] * v0[1]) + (v0[2] * v0[2] + v0[3] * v0[3])) + ((v1[0] * v1[0] + v1[1] * v1[1]) + (v1[2] * v1[2] + v1[3] * v1[3]));
                    u32x4 w; w.x = pk2h(v0[0], v0[1]); w.y = pk2h(v0[2], v0[3]); w.z = pk2h(v1[0], v1[1]); w.w = pk2h(v1[2], v1[3]);
                    *(u32x4*)(rowp + bj * HALF) = w; }
                s += __shfl_xor(s, 16); s += __shfl_xor(s, 32);
                if (fq == 0) SSQ[(size_t)row * 32 + u.pn * 4 + wc] = s; }
    }
};
struct EpiRelu2 {
    static constexpr bool PERM = true, AFTER_DRAIN = false;
    h16* O; int ldc;
    __device__ __forceinline__ void operator()(const f32x4 (&acc)[2][2][4][2], const Unit& u, int wr, int wc, int fr, int fq) const {
        const int row0 = u.pm * BM + wr * 64 + fr, col0 = u.pn * BM + wc * 32 + 8 * fq;
#pragma unroll
        for (int ai = 0; ai < 2; ++ai)
#pragma unroll
            for (int m = 0; m < 4; ++m) { h16* rowp = O + (size_t)(row0 + ai * HALF + m * 16) * ldc + col0;
#pragma unroll
                for (int bj = 0; bj < 2; ++bj) { f32x4 v0 = acc[ai][bj][m][0], v1 = acc[ai][bj][m][1];
#pragma unroll
                    for (int e = 0; e < 4; ++e) { const float a = fmaxf(v0[e], 0.f), b = fmaxf(v1[e], 0.f); v0[e] = a * a; v1[e] = b * b; }
                    u32x4 w; w.x = pk2h(v0[0], v0[1]); w.y = pk2h(v0[2], v0[3]); w.z = pk2h(v1[0], v1[1]); w.w = pk2h(v1[2], v1[3]);
                    { const h16* sp_ = rowp + bj * HALF; asm volatile("global_store_dwordx4 %0, %1, off sc0 sc1\n\ts_nop 2" :: "v"(sp_), "v"(w) : "memory"); } } }
    }
};
__device__ __forceinline__ void row_exchange(const f32x4 (&acc)[2][2][4][2], float* X8, unsigned* cntw, const Unit& u, LAS unsigned char* lds, int wid, int lane, int wr, int wc, int fr, int fq) {
        LAS float* P = (LAS float*)(lds + 4096);
        LAS float* S = (LAS float*)lds;
#pragma unroll
        for (int ai = 0; ai < 2; ++ai)
#pragma unroll
            for (int m = 0; m < 4; ++m) { float s = 0.f;
#pragma unroll
                for (int bj = 0; bj < 2; ++bj) { const f32x4 v0 = acc[ai][bj][m][0], v1 = acc[ai][bj][m][1];
                    s += ((v0[0] * v0[0] + v0[1] * v0[1]) + (v0[2] * v0[2] + v0[3] * v0[3])) + ((v1[0] * v1[0] + v1[1] * v1[1]) + (v1[2] * v1[2] + v1[3] * v1[3])); }
                s += __shfl_xor(s, 16); s += __shfl_xor(s, 32);
                if (fq == 0) P[(ai * HALF + wr * 64 + m * 16 + fr) * 4 + wc] = s; }
        asm volatile("s_waitcnt lgkmcnt(0)" ::: "memory"); __builtin_amdgcn_s_barrier(); asm volatile("" ::: "memory");
        if (lane < 32) { const f32x4 p4 = *(const LAS f32x4*)(P + (wid * 32 + lane) * 4);
            __hip_atomic_store((unsigned*)X8 + (size_t)(u.pm * BM + wid * 32 + lane) * 8 + u.pn, __float_as_uint((p4[0] + p4[1]) + (p4[2] + p4[3])), __ATOMIC_RELAXED, __HIP_MEMORY_SCOPE_AGENT); }
        asm volatile("s_waitcnt vmcnt(0)" ::: "memory");
        if (lane == 0) __hip_atomic_fetch_add(cntw, 1u, __ATOMIC_RELAXED, __HIP_MEMORY_SCOPE_AGENT);
        if (wid == 0) { unsigned sp = 0u;
            while ((unsigned)__builtin_amdgcn_readfirstlane((int)__hip_atomic_load(cntw, __ATOMIC_RELAXED, __HIP_MEMORY_SCOPE_AGENT)) < 64u) { __builtin_amdgcn_s_sleep(1); if (++sp > (1u << 22)) break; }
            __builtin_amdgcn_fence(__ATOMIC_ACQUIRE, "agent"); }
        asm volatile("s_waitcnt vmcnt(0) lgkmcnt(0)" ::: "memory"); __builtin_amdgcn_s_barrier(); asm volatile("" ::: "memory");
        { const float* p = X8 + (size_t)(u.pm * BM + wid * 32 + (lane & 31)) * 8 + (lane >> 5) * 4; f32x4 q0;
            asm volatile("global_load_dwordx4 %0, %1, off sc1\n\ts_waitcnt vmcnt(0)" : "=&v"(q0) : "v"(p) : "memory");
            float ts = (q0[0] + q0[1]) + (q0[2] + q0[3]); ts += __shfl_xor(ts, 32);
            if (lane < 32) S[wid * 32 + lane] = 1.f / sqrtf(ts * (1.f / DM) + EPS); }
        asm volatile("s_waitcnt lgkmcnt(0)" ::: "memory"); __builtin_amdgcn_s_barrier(); asm volatile("" ::: "memory");
}
struct EpiNormOut {
    static constexpr bool PERM = true, AFTER_DRAIN = true;
    const h16* X1; float* OUT; float* SSQ; unsigned* cnt; const float* gpost; const float* gatef;
    __device__ __forceinline__ void fused(const f32x4 (&acc)[2][2][4][2], const Unit& u, int, int, int, int, LAS unsigned char* lds, int, int) const {
        int tid = threadIdx.x; asm volatile("" : "+v"(tid));
        const int wid = __builtin_amdgcn_readfirstlane(tid >> 6), lane = tid & 63, wr = wid >> 2, wc = wid & 3, fr = lane & 15, fq = lane >> 4;
        const int row0 = u.pm * BM + wr * 64 + fr, col0 = u.pn * BM + wc * 32 + 8 * fq;
        row_exchange(acc, SSQ, cnt + 64 * u.pm, u, lds, wid, lane, wr, wc, fr, fq);
        const LAS float* S = (const LAS float*)lds;
        u32x4 xr[2][4][2];
#pragma unroll
        for (int m = 0; m < 4; ++m)
#pragma unroll
            for (int bj = 0; bj < 2; ++bj) xr[0][m][bj] = __builtin_nontemporal_load((const u32x4*)(X1 + ((unsigned)(row0 * DM + col0) + (unsigned)(m * 16 * DM + bj * HALF))));
#pragma unroll
        for (int m = 0; m < 4; ++m)
#pragma unroll
            for (int bj = 0; bj < 2; ++bj) xr[1][m][bj] = __builtin_nontemporal_load((const u32x4*)(X1 + ((unsigned)(row0 * DM + col0) + (unsigned)((HALF + m * 16) * DM + bj * HALF))));
        const float* gfb = gatef + (size_t)(u.pm >> 4) * 6 * DM;
        f32x4 cf[2][2];
#pragma unroll
        for (int bj = 0; bj < 2; ++bj)
#pragma unroll
            for (int n = 0; n < 2; ++n) cf[bj][n] = *(const f32x4*)(gpost + col0 + bj * HALF + 4 * n) * *(const f32x4*)(gfb + col0 + bj * HALF + 4 * n);
        const unsigned eo = (unsigned)(row0 * DM + col0);
#pragma unroll
        for (int ai = 0; ai < 2; ++ai)
#pragma unroll
            for (int m = 0; m < 4; ++m) { const float rstd = S[ai * HALF + wr * 64 + m * 16 + fr]; const unsigned o = eo + (unsigned)((ai * HALF + m * 16) * DM);
#pragma unroll
                for (int bj = 0; bj < 2; ++bj) { u32x4 xw = xr[ai][m][bj]; asm volatile("" : "+v"(xw));
                    const f32x4 x0 = unpack4h((u32x2){xw[0], xw[1]}), x1 = unpack4h((u32x2){xw[2], xw[3]});
                    __builtin_nontemporal_store(x0 + cf[bj][0] * (acc[ai][bj][m][0] * rstd), (f32x4*)(OUT + o + bj * HALF));
                    __builtin_nontemporal_store(x1 + cf[bj][1] * (acc[ai][bj][m][1] * rstd), (f32x4*)(OUT + o + bj * HALF + 4)); }
                asm volatile("" ::: "memory"); }
    }
};
struct EpiNormResNorm {
    static constexpr bool PERM = true, AFTER_DRAIN = true;
    const float* X; h16* X1; h16* H; float* SSQa; float* SSQb; unsigned* cnta; unsigned* cntb; const float* gpost; const float* gpre; const float* mod;
    __device__ __forceinline__ void fused(f32x4 (&acc)[2][2][4][2], const Unit& u, int, int, int, int, LAS unsigned char* lds, int, int) const {
        int tid = threadIdx.x; asm volatile("" : "+v"(tid));
        const int wid = __builtin_amdgcn_readfirstlane(tid >> 6), lane = tid & 63, wr = wid >> 2, wc = wid & 3, fr = lane & 15, fq = lane >> 4;
        const int row0 = u.pm * BM + wr * 64 + fr, col0 = u.pn * BM + wc * 32 + 8 * fq;
        const unsigned eo = (unsigned)(row0 * DM + col0);
        const float* mb = mod + (size_t)(u.pm >> 4) * 6 * DM;
        const LAS float* S = (const LAS float*)lds;
        row_exchange(acc, SSQa, cnta + 64 * u.pm, u, lds, wid, lane, wr, wc, fr, fq);
        { f32x4 cf[2][2];
#pragma unroll
          for (int bj = 0; bj < 2; ++bj)
#pragma unroll
            for (int n = 0; n < 2; ++n) cf[bj][n] = *(const f32x4*)(gpost + col0 + bj * HALF + 4 * n) * *(const f32x4*)(mb + 2 * DM + col0 + bj * HALF + 4 * n);
#pragma unroll
          for (int ai = 0; ai < 2; ++ai) { f32x4 xv[4][2][2];
#pragma unroll
            for (int m = 0; m < 4; ++m)
#pragma unroll
                for (int bj = 0; bj < 2; ++bj)
#pragma unroll
                    for (int n = 0; n < 2; ++n) xv[m][bj][n] = __builtin_nontemporal_load((const f32x4*)(X + (eo + (unsigned)((ai * HALF + m * 16) * DM + bj * HALF + 4 * n))));
#pragma unroll
            for (int m = 0; m < 4; ++m) { const float rstd = S[ai * HALF + wr * 64 + m * 16 + fr]; const unsigned o = eo + (unsigned)((ai * HALF + m * 16) * DM);
#pragma unroll
                for (int bj = 0; bj < 2; ++bj) { f32x4 x0 = xv[m][bj][0], x1 = xv[m][bj][1]; asm volatile("" : "+v"(x0), "+v"(x1));
                    const f32x4 v0 = x0 + cf[bj][0] * (acc[ai][bj][m][0] * rstd), v1 = x1 + cf[bj][1] * (acc[ai][bj][m][1] * rstd);
                    acc[ai][bj][m][0] = v0; acc[ai][bj][m][1] = v1;
                    u32x4 w; w.x = pk2h(v0[0], v0[1]); w.y = pk2h(v0[2], v0[3]); w.z = pk2h(v1[0], v1[1]); w.w = pk2h(v1[2], v1[3]);
                    *(u32x4*)(X1 + o + bj * HALF) = w; }
                asm volatile("" ::: "memory"); } } }
        row_exchange(acc, SSQb, cntb + 64 * u.pm, u, lds, wid, lane, wr, wc, fr, fq);
        { f32x4 ca[2][2], cs[2][2];
#pragma unroll
          for (int bj = 0; bj < 2; ++bj)
#pragma unroll
            for (int n = 0; n < 2; ++n) { const int c = col0 + bj * HALF + 4 * n; ca[bj][n] = *(const f32x4*)(gpre + c) * (*(const f32x4*)(mb + 4 * DM + c) + 1.f); cs[bj][n] = *(const f32x4*)(mb + 3 * DM + c); }
#pragma unroll
          for (int ai = 0; ai < 2; ++ai)
#pragma unroll
            for (int m = 0; m < 4; ++m) { const float rstd = S[ai * HALF + wr * 64 + m * 16 + fr]; const unsigned o = eo + (unsigned)((ai * HALF + m * 16) * DM);
#pragma unroll
                for (int bj = 0; bj < 2; ++bj) { const f32x4 y0 = (acc[ai][bj][m][0] * rstd) * ca[bj][0] + cs[bj][0], y1 = (acc[ai][bj][m][1] * rstd) * ca[bj][1] + cs[bj][1];
                    u32x4 w; w.x = pk2h(y0[0], y0[1]); w.y = pk2h(y0[2], y0[3]); w.z = pk2h(y1[0], y1[1]); w.w = pk2h(y1[2], y1[3]);
                    *(u32x4*)(H + o + bj * HALF) = w; }
                asm volatile("" ::: "memory"); } }
    }
};
}

#define XB_TMO      128
#define XB_XCNT(j)  (256  + 64 * (j))
#define XB_XSUB(j)  (1280 + 64 * (j))
#define XB_XGEN(j)  (2304 + 64 * (j))
#define XB_TOP      3328
#define XB_TOPGEN   3392
#define XCD_BAR_WORDS 3456
#define XB_SPIN_CAP (1u << 20)
__device__ __forceinline__ unsigned xb_ld(unsigned* p)              { return __hip_atomic_load(p, __ATOMIC_RELAXED, __HIP_MEMORY_SCOPE_AGENT); }
__device__ __forceinline__ unsigned xb_add(unsigned* p, unsigned v) { return __hip_atomic_fetch_add(p, v, __ATOMIC_RELAXED, __HIP_MEMORY_SCOPE_AGENT); }
__device__ __forceinline__ unsigned xb_xcc_id() { return (unsigned)__builtin_amdgcn_s_getreg((3 << 11) | 20) & 0xFu; }
#define XB_SPIN(cond, bar) do { unsigned _sp = 0; while (cond) { __builtin_amdgcn_s_sleep(1); \
    if ((++_sp & 255u) == 0u) { if (xb_ld(&(bar)[XB_TMO])) break; if (_sp > XB_SPIN_CAP) { atomicAdd(&(bar)[XB_TMO], 1u); break; } } } } while (0)
struct XcdBarrier { unsigned* bar; unsigned x; volatile LAS unsigned* st; };
__device__ __forceinline__ XcdBarrier xcd_barrier_post(unsigned* bar, volatile LAS unsigned* st) {
    XcdBarrier b; b.bar = bar; b.x = xb_xcc_id(); b.st = st;
    if (threadIdx.x == 0) (void)xb_add(&bar[XB_XCNT(b.x)], 1u);
    return b;
}
__device__ __forceinline__ void xcd_barrier_complete(unsigned* bar, unsigned x, unsigned& nloc, unsigned& nx) {
    const unsigned G = gridDim.x * gridDim.y * gridDim.z;
    unsigned sum, cnt, mine, sp = 0u;
    for (;;) {
        sum = 0u; cnt = 0u; mine = 0u;
#pragma unroll
        for (unsigned j = 0; j < 16; ++j) { const unsigned c = xb_ld(&bar[XB_XCNT(j)]); sum += c; cnt += (c > 0u) ? 1u : 0u; mine = (j == x) ? c : mine; }
        if (sum == G) break;
        __builtin_amdgcn_s_sleep(1);
        if ((++sp & 255u) == 0u) { if (xb_ld(&bar[XB_TMO])) break; if (sp > XB_SPIN_CAP) { atomicAdd(&bar[XB_TMO], 1u); break; } }
    }
    nloc = mine > 0u ? mine : 1u; nx = cnt > 0u ? cnt : 1u;
}
__device__ __forceinline__ void xcd_barrier(const XcdBarrier& b) {
    asm volatile("s_waitcnt vmcnt(0)" ::: "memory");
    __syncthreads();
    if (threadIdx.x == 0) {
        unsigned* bar = b.bar;
        __builtin_amdgcn_s_waitcnt(0);
        unsigned nloc = b.st[0], nx = b.st[1];
        if (nloc == 0u) { xcd_barrier_complete(bar, b.x, nloc, nx); b.st[0] = nloc; b.st[1] = nx; }
        const unsigned old = xb_add(&bar[XB_XSUB(b.x)], 1u);
        const unsigned gen = old / nloc;
        if (old + 1u == (gen + 1u) * nloc) {
            __builtin_amdgcn_fence(__ATOMIC_RELEASE, "agent");
            asm volatile("s_waitcnt vmcnt(0)" ::: "memory");
            const unsigned og = xb_add(&bar[XB_TOP], 1u);
            const unsigned tg = og / nx;
            if (og + 1u == (tg + 1u) * nx) xb_add(&bar[XB_TOPGEN], 1u);
            else XB_SPIN(xb_ld(&bar[XB_TOPGEN]) == tg, bar);
            __builtin_amdgcn_fence(__ATOMIC_ACQUIRE, "agent");
            xb_add(&bar[XB_XGEN(b.x)], 1u);
            asm volatile("s_waitcnt vmcnt(0)" ::: "memory");
        } else {
            XB_SPIN(xb_ld(&bar[XB_XGEN(b.x)]) == gen, bar);
            __builtin_amdgcn_fence(__ATOMIC_ACQUIRE, "agent");
            asm volatile("s_waitcnt vmcnt(0)" ::: "memory");
        }
    }
    __syncthreads();
}

constexpr int RING_BYTES = 131072;
constexpr int LDSCTL_OFF = 143360;
constexpr int LDS_BYTES = 147456;
constexpr int NWAVES = 8;
#ifndef T_IN_P4
#define T_IN_P4 1
#endif
constexpr int NT_GV = (T_IN_P4 && GV_Q) ? 256 : 0, NT_ITEMS = T_IN_P4 ? 576 + NT_GV : 0, NQ_TOTAL = 512 + NT_ITEMS, NQ_MAX = 1088;

struct Args { const float* in[18]; float* out; unsigned char* ws; int ph_lo, ph_hi; unsigned short order[NQ_MAX]; };

__device__ __forceinline__ float wave_sum(float v) {
#pragma unroll
    for (int o = 1; o < 64; o <<= 1) v += __shfl_xor(v, o);
    return v;
}
__device__ __forceinline__ float silu_f(float v) { return v / (1.f + __expf(-v)); }

__device__ __forceinline__ int win_src_col(int n) {
    if (n >= NQKV) { const int k = n - NQKV; return k < 24 ? 2560 + k : -1; }
    const int pn = n >> 8; int j = n & 127; const int hb = n & ~127;
    if (pg8::is_rope_tile(pn)) { const int a = j >> 3, b = j & 7; j = (b < 4) ? 4 * a + b : 64 + 4 * a + (b - 4); }
    return hb + j + (n >= 2560 ? 24 : 0);
}
__device__ __forceinline__ void transpose_item64(const float* W, int ldw, int K, h16* WT, int k0, int n0, int src4, int dl, LAS float* scr, int lane) {
    const int kk = lane >> 4;
    f32x4 v[16];
#pragma unroll
    for (int i = 0; i < 16; ++i) v[i] = src4 >= 0 ? *(const f32x4*)(W + (size_t)(k0 + 4 * i + kk) * ldw + src4) : (f32x4){0.f, 0.f, 0.f, 0.f};
#pragma unroll
    for (int i = 0; i < 16; ++i) { LAS float* p = scr + (4 * i + kk) * 65 + dl; p[0] = v[i].x; p[1] = v[i].y; p[2] = v[i].z; p[3] = v[i].w; }
    asm volatile("s_waitcnt lgkmcnt(0)" ::: "memory");
    const int c = lane & 7;
#pragma unroll
    for (int j = 0; j < 8; ++j) { const int n = (lane >> 3) + 8 * j; const LAS float* sp = scr + (8 * c) * 65 + n;
        u32x4 o; o.x = pk2h(sp[0 * 65], sp[1 * 65]); o.y = pk2h(sp[2 * 65], sp[3 * 65]); o.z = pk2h(sp[4 * 65], sp[5 * 65]); o.w = pk2h(sp[6 * 65], sp[7 * 65]);
        *(u32x4*)(WT + (size_t)(n0 + n) * K + k0 + 8 * c) = o; }
    asm volatile("s_waitcnt lgkmcnt(0)" ::: "memory");
}
template <bool NTL = false>
__device__ __forceinline__ void transpose_item128(const float* W, int ldw, int K, h16* WT, int k0, int n0, int src4, int dl, LAS float* scr, int lane) {
    const int kk = lane >> 4;
    f32x4 v[32];
#pragma unroll
    for (int i = 0; i < 32; ++i) { const f32x4* p = (const f32x4*)(W + (size_t)(k0 + 4 * i + kk) * ldw + src4); v[i] = src4 >= 0 ? (NTL ? __builtin_nontemporal_load(p) : *p) : (f32x4){0.f, 0.f, 0.f, 0.f}; }
    const int c = lane & 7;
#pragma unroll
    for (int hpass = 0; hpass < 2; ++hpass) {
#pragma unroll
        for (int i = 0; i < 16; ++i) { LAS float* p = scr + (4 * i + kk) * 65 + dl; const f32x4 x = v[16 * hpass + i]; p[0] = x.x; p[1] = x.y; p[2] = x.z; p[3] = x.w; }
        asm volatile("s_waitcnt lgkmcnt(0)" ::: "memory");
#pragma unroll
        for (int j = 0; j < 8; ++j) { const int n = (lane >> 3) + 8 * j; const LAS float* sp = scr + (8 * c) * 65 + n;
            u32x4 o; o.x = pk2h(sp[0 * 65], sp[1 * 65]); o.y = pk2h(sp[2 * 65], sp[3 * 65]); o.z = pk2h(sp[4 * 65], sp[5 * 65]); o.w = pk2h(sp[6 * 65], sp[7 * 65]);
            *(u32x4*)(WT + (size_t)(n0 + n) * K + k0 + 64 * hpass + 8 * c) = o; }
        asm volatile("s_waitcnt lgkmcnt(0)" ::: "memory");
    }
}
__device__ __forceinline__ void win_map64(int n0, int q, int& src4, int& dl) {
    if (n0 >= NQKV) { const int k = n0 - NQKV + 4 * q; src4 = (k + 4 <= 24) ? 2560 + k : -1; dl = 4 * q; return; }
    const int pn = n0 >> 8, hb = n0 & ~127, j0 = n0 & 127, add = n0 >= 2560 ? 24 : 0;
    if (pg8::is_rope_tile(pn)) { if (q < 8) { src4 = hb + (j0 >> 1) + 4 * q + add; dl = 8 * q; } else { src4 = hb + 64 + (j0 >> 1) + 4 * (q - 8) + add; dl = 8 * (q - 8) + 4; } }
    else { src4 = n0 + 4 * q + add; dl = 4 * q; }
}

__device__ __forceinline__ void gemv_half(const float* c_in, const float* w_ada, const float* b_ada, float* mod, int cch, int k32, int lane) {
    const int col = cch * 256 + lane * 4; const int kb = k32 * 32;
    const int s0v = __float_as_int(silu_f(c_in[kb + (lane & 31)])), s1v = __float_as_int(silu_f(c_in[DM + kb + (lane & 31)]));
    const float* wp = w_ada + (size_t)kb * (6 * DM) + col;
    f32x4 w[32];
#pragma unroll
    for (int k = 0; k < 32; ++k) w[k] = __builtin_nontemporal_load((const f32x4*)(wp + (size_t)k * (6 * DM)));
    f32x4 a0 = {0.f, 0.f, 0.f, 0.f}, a1 = {0.f, 0.f, 0.f, 0.f};
#pragma unroll
    for (int k = 0; k < 32; ++k) { const float s0 = __int_as_float(__builtin_amdgcn_readlane(s0v, k)), s1 = __int_as_float(__builtin_amdgcn_readlane(s1v, k)); a0 += w[k] * s0; a1 += w[k] * s1; }
    if (k32 == 0) { const f32x4 bv = *(const f32x4*)(b_ada + col); a0 += bv; a1 += bv; }
#pragma unroll
    for (int e = 0; e < 4; ++e) { atomicAdd(mod + col + e, a0[e]); atomicAdd(mod + 6 * DM + col + e, a1[e]); }
}

__device__ __forceinline__ void p0_prologue(const Args& A, LAS unsigned char* lds, int gw, int NGW, int wave, int lane, int rep) {
    unsigned char* ws = A.ws;
    LAS float* scr = (LAS float*)(lds + wave * 16640);
    const float* c_in = A.in[1]; const float* w_ada = A.in[2]; const float* b_ada = A.in[3];
    float* mod = (float*)(ws + WS_MOD); float* posb = (float*)(ws + WS_POSB);
    constexpr int I_GEMV = 48 * 32;
    constexpr int I_DN = (DFF / 128) * (DM / 64), I_UP = (DM / 128) * (DFF / 64), I_IN = (DM / 128) * (NPAD / 64), I_O = (DM / 128) * (DM / 64);
    constexpr int I_W1 = 2 * (4096 / 64) * (128 / 64), I_W2 = 2 * (128 / 64) * (128 / 64), I_ROPE = 4096, I_POSB = 256, I_KMZ = 32;
    constexpr int NITEMS = I_GEMV + (T_IN_P4 ? 0 : I_DN + I_UP + I_O) + I_IN + I_W1 + I_W2 + I_ROPE + I_POSB + I_KMZ;
    const int q16 = lane & 15;
    const bool bal = P0_BAL && T_IN_P4 && NGW == 2048 && rep == 0;
    if (bal && GV_Q) {
        int wi = -1;
        if (gw < 1024) { gemv_half(c_in, w_ada, b_ada, mod, gw & 15, gw >> 4, lane); if (gw < I_IN - 1024) wi = 1024 + gw; } else wi = gw - 1024;
        if (wi >= 0) { const int nblk = NPAD / 64, kb = wi / nblk, nb = wi % nblk; int src4, dl; win_map64(64 * nb, q16, src4, dl); transpose_item128<true>(A.in[6], INCOLS, DM, (h16*)(ws + WS_WIN), 128 * kb, 64 * nb, src4, dl, scr, lane); }
    } else if (bal) {
        if (gw < I_IN) { gemv_half(c_in, w_ada, b_ada, mod, gw % 48, gw / 48, lane);
            const int nblk = NPAD / 64, kb = gw / nblk, nb = gw % nblk; int src4, dl; win_map64(64 * nb, q16, src4, dl); transpose_item128<true>(A.in[6], INCOLS, DM, (h16*)(ws + WS_WIN), 128 * kb, 64 * nb, src4, dl, scr, lane); }
        else {
#pragma unroll 1
            for (int h = gw; h < 2 * I_GEMV; h += 2048 - I_IN) gemv_half(c_in, w_ada, b_ada, mod, h % 48, h / 48, lane); }
    }
    for (int it = gw + (bal ? I_GEMV + I_IN : 0); it < NITEMS; it += NGW) {
        int r = it;
        if (r < I_GEMV) {
            const int cch = r % 48, kch = r / 48; const int col = cch * 256 + lane * 4; const int kb = kch * 64;
            if (GV_Q && T_IN_P4 && cch >= 16) continue;
            f32x4 a0 = {0.f, 0.f, 0.f, 0.f}, a1 = {0.f, 0.f, 0.f, 0.f};
#pragma unroll 16
            for (int k = 0; k < 64; ++k) { const float s0 = silu_f(c_in[kb + k]), s1 = silu_f(c_in[DM + kb + k]);
                const f32x4 w = __builtin_nontemporal_load((const f32x4*)(w_ada + (size_t)(kb + k) * (6 * DM) + col)); a0 += w * s0; a1 += w * s1; }
            if (kch == 0) { const f32x4 bv = *(const f32x4*)(b_ada + col); a0 += bv; a1 += bv; }
#pragma unroll
            for (int e = 0; e < 4; ++e) { atomicAdd(mod + rep * 24576 + col + e, a0[e]); atomicAdd(mod + rep * 24576 + 6 * DM + col + e, a1[e]); }
            continue; }
        r -= I_GEMV;
        if (!T_IN_P4 && r < I_DN) { const int nblk = DM / 64, kb = r / nblk, nb = r % nblk; transpose_item128(A.in[17], DM, DFF, (h16*)(ws + WS_WDN), 128 * kb, 64 * nb, 64 * nb + 4 * q16, 4 * q16, scr, lane); continue; }
        if (!T_IN_P4) r -= I_DN;
        if (!T_IN_P4 && r < I_UP) { const int nblk = DFF / 64, kb = r / nblk, nb = r % nblk; transpose_item128(A.in[16], DFF, DM, (h16*)(ws + WS_WUP), 128 * kb, 64 * nb, 64 * nb + 4 * q16, 4 * q16, scr, lane); continue; }
        if (!T_IN_P4) r -= I_UP;
        if (r < I_IN) { const int nblk = NPAD / 64, kb = r / nblk, nb = r % nblk; int src4, dl; win_map64(64 * nb, q16, src4, dl); transpose_item128<true>(A.in[6], INCOLS, DM, (h16*)(ws + WS_WIN), 128 * kb, 64 * nb, src4, dl, scr, lane); continue; }
        r -= I_IN;
        if (!T_IN_P4 && r < I_O) { const int nblk = DM / 64, kb = r / nblk, nb = r % nblk; transpose_item128(A.in[13], DM, DM, (h16*)(ws + WS_WO), 128 * kb, 64 * nb, 64 * nb + 4 * q16, 4 * q16, scr, lane); continue; }
        if (!T_IN_P4) r -= I_O;
        if (r < I_W1) { const int kv = r / 128, q = r % 128, kb = q / 2, nb = q % 2; transpose_item64(A.in[kv ? 11 : 8], 128, 4096, (h16*)(ws + WS_W1T) + (size_t)kv * 128 * 4096, 64 * kb, 64 * nb, 64 * nb + 4 * q16, 4 * q16, scr, lane); continue; }
        r -= I_W1;
        if (r < I_W2) { const int kv = r / 4, q = r % 4, kb = q / 2, nb = q % 2; transpose_item64(A.in[kv ? 12 : 9], 128, 128, (h16*)(ws + WS_W2T) + (size_t)kv * 128 * 128, 64 * kb, 64 * nb, 64 * nb + 4 * q16, 4 * q16, scr, lane); continue; }
        r -= I_W2;
        if (r < I_POSB) { const int kv = r / 128, kc = r % 128; const float* pos = A.in[kv ? 10 : 7]; const float* w1 = A.in[kv ? 11 : 8];
            f32x2 wv[32];
#pragma unroll
            for (int k = 0; k < 32; ++k) wv[k] = *(const f32x2*)(w1 + (size_t)(kc * 32 + k) * 128 + 2 * lane);
            const int pl = __float_as_int(pos[kc * 32 + (lane & 31)]);
            f32x2 a = {0.f, 0.f};
#pragma unroll
            for (int k = 0; k < 32; ++k) a += wv[k] * __int_as_float(__builtin_amdgcn_readlane(pl, k));
            atomicAdd(posb + rep * 256 + kv * 128 + 2 * lane, a.x); atomicAdd(posb + rep * 256 + kv * 128 + 2 * lane + 1, a.y);
            continue; }
        r -= I_POSB;
        if (r < I_KMZ) { u32x4 z = {0u, 0u, 0u, 0u}; u32x4* p = (u32x4*)(ws + WS_KMEAN + (size_t)r * 4096);
#pragma unroll
          for (int q = 0; q < 4; ++q) p[q * 64 + lane] = z;
          continue; }
        r -= I_KMZ;
        { float* COS = (float*)(ws + WS_COS); float* SIN = (float*)(ws + WS_SIN);
            { const int e = r * 64 + lane; const int t = e >> 6, i = e & 63;
              const float inv = powf(10000.f, -(float)(2 * i) / 128.f); const float ang = (float)t * inv; COS[e] = cosf(ang); SIN[e] = sinf(ang); } }
    }
}

__device__ __forceinline__ void p1_rows(const Args& A, int gw, int NGW, int lane) {
    const float* x = A.in[0]; const float* g1 = A.in[4]; const float* mod = (const float*)(A.ws + WS_MOD); h16* H = (h16*)(A.ws + WS_H);
    const bool odd = (lane & 1) != 0;
    for (int row = gw; row < M; row += NGW) {
        const int b = row >> 12; const f32x4* xr = (const f32x4*)(x + (size_t)row * DM) + lane;
        f32x4 v[8]; float s = 0.f;
#pragma unroll
        for (int j = 0; j < 8; ++j) { v[j] = __builtin_nontemporal_load(xr + 64 * j); s += (v[j].x * v[j].x + v[j].y * v[j].y) + (v[j].z * v[j].z + v[j].w * v[j].w); }
        const float rstd = 1.f / sqrtf(wave_sum(s) * (1.f / DM) + EPS);
        u32x2 w[8];
#pragma unroll
        for (int j = 0; j < 8; ++j) { const int col = 4 * lane + 256 * j;
            const f32x4 g = *(const f32x4*)(g1 + col), sh = *(const f32x4*)(mod + b * 6 * DM + col), sc = *(const f32x4*)(mod + b * 6 * DM + DM + col);
            const f32x4 y = (v[j] * rstd * g) * (sc + 1.f) + sh;
            w[j].x = pk2h(y.x, y.y); w[j].y = pk2h(y.z, y.w); }
        h16* hr = H + (size_t)row * DM;
#pragma unroll
        for (int jp = 0; jp < 4; ++jp) { const int j0 = 2 * jp, j1 = 2 * jp + 1;
            const unsigned sx = odd ? w[j0].x : w[j1].x, sy = odd ? w[j0].y : w[j1].y;
            const unsigned rx = (unsigned)__builtin_amdgcn_mov_dpp((int)sx, 0xB1, 0xf, 0xf, true), ry = (unsigned)__builtin_amdgcn_mov_dpp((int)sy, 0xB1, 0xf, 0xf, true);
            u32x4 o; o.x = odd ? rx : w[j0].x; o.y = odd ? ry : w[j0].y; o.z = odd ? w[j1].x : rx; o.w = odd ? w[j1].y : ry;
            *(u32x4*)(hr + (odd ? 256 * j1 + 4 * (lane - 1) : 256 * j0 + 4 * lane)) = o; }
    }
}
__device__ __forceinline__ void p6_rows(const Args& A, int gw, int NGW, int lane) {
    const float* x = A.in[0]; const float* gpost = A.in[5]; const float* gpre = A.in[14]; const float* mod = (const float*)(A.ws + WS_MOD);
    const h16* OP = (const h16*)(A.ws + WS_OP); const float* SSQ = (const float*)(A.ws + WS_SSQ); h16* H = (h16*)(A.ws + WS_H); h16* X1 = (h16*)(A.ws + WS_X1);
    for (int row0 = gw; row0 < M; row0 += 2 * NGW) {
        f32x4 v[2][8]; u32x2 opv[2][8]; float ssp[2];
#pragma unroll
        for (int q = 0; q < 2; ++q) { const int row = row0 + q * NGW;
            ssp[q] = lane < 32 ? SSQ[(size_t)row * 32 + lane] : 0.f;
            const f32x4* xr = (const f32x4*)(x + (size_t)row * DM) + lane; const u32x2* opr = (const u32x2*)(OP + (size_t)row * DM) + lane;
#pragma unroll
            for (int j = 0; j < 8; ++j) { v[q][j] = xr[64 * j]; opv[q][j] = opr[64 * j]; } }
#pragma unroll
        for (int q = 0; q < 2; ++q) { const int row = row0 + q * NGW; const int b = row >> 12; const float* mb = mod + b * 6 * DM;
            const float rstd = 1.f / sqrtf(wave_sum(ssp[q]) * (1.f / DM) + EPS); float s = 0.f;
#pragma unroll
            for (int j = 0; j < 8; ++j) { const int col = 4 * lane + 256 * j;
                const f32x4 g = *(const f32x4*)(gpost + col), gm = *(const f32x4*)(mb + 2 * DM + col);
                v[q][j] = v[q][j] + gm * (unpack4h(opv[q][j]) * rstd * g);
                s += (v[q][j].x * v[q][j].x + v[q][j].y * v[q][j].y) + (v[q][j].z * v[q][j].z + v[q][j].w * v[q][j].w); }
            const float rstd2 = 1.f / sqrtf(wave_sum(s) * (1.f / DM) + EPS);
            u32x2* x1r = (u32x2*)(X1 + (size_t)row * DM) + lane; u32x2* o8 = (u32x2*)(H + (size_t)row * DM) + lane;
#pragma unroll
            for (int j = 0; j < 8; ++j) { const int col = 4 * lane + 256 * j;
                { u32x2 w1; w1.x = pk2h(v[q][j].x, v[q][j].y); w1.y = pk2h(v[q][j].z, v[q][j].w); x1r[64 * j] = w1; }
                const f32x4 g = *(const f32x4*)(gpre + col), sh = *(const f32x4*)(mb + 3 * DM + col), sc = *(const f32x4*)(mb + 4 * DM + col);
                const f32x4 y = (v[q][j] * rstd2 * g) * (sc + 1.f) + sh;
                u32x2 w; w.x = pk2h(y.x, y.y); w.y = pk2h(y.z, y.w); o8[64 * j] = w; } }
    }
}
__device__ __forceinline__ void p9_rows(const Args& A, int gw, int NGW, int lane) {
    const float* gpost = A.in[15]; const float* mod = (const float*)(A.ws + WS_MOD);
    const h16* F = (const h16*)(A.ws + WS_F); const float* SSQ = (const float*)(A.ws + WS_SSQ); const h16* X1 = (const h16*)(A.ws + WS_X1); float* OUT = A.out;
    for (int row0 = gw; row0 < M; row0 += 2 * NGW) {
        u32x2 xv[2][8], fv[2][8]; float ssp[2];
#pragma unroll
        for (int q = 0; q < 2; ++q) { const int row = row0 + q * NGW;
            ssp[q] = lane < 32 ? SSQ[(size_t)row * 32 + lane] : 0.f;
            const u32x2* x1r = (const u32x2*)(X1 + (size_t)row * DM) + lane; const u32x2* fr = (const u32x2*)(F + (size_t)row * DM) + lane;
#pragma unroll
            for (int j = 0; j < 8; ++j) { xv[q][j] = x1r[64 * j]; fv[q][j] = fr[64 * j]; } }
#pragma unroll
        for (int q = 0; q < 2; ++q) { const int row = row0 + q * NGW; const int b = row >> 12; const float* mb = mod + b * 6 * DM;
            const float rstd = 1.f / sqrtf(wave_sum(ssp[q]) * (1.f / DM) + EPS);
            f32x4* outr = (f32x4*)(OUT + (size_t)row * DM) + lane;
#pragma unroll
            for (int j = 0; j < 8; ++j) { const int col = 4 * lane + 256 * j;
                const f32x4 g = *(const f32x4*)(gpost + col), gf = *(const f32x4*)(mb + 5 * DM + col);
                outr[64 * j] = unpack4h(xv[q][j]) + gf * (unpack4h(fv[q][j]) * rstd * g); } }
    }
}

__device__ __forceinline__ void p3_compress_item(const Args& A, LAS unsigned char* lds, int item, int wave, int lane) {
    const int kv = item >> 6, b = (item >> 5) & 1, g = (item >> 4) & 1, rt = item & 15;
    const h16* QKV = (const h16*)(A.ws + WS_QKV); const h16* W1T = (const h16*)(A.ws + WS_W1T) + (size_t)kv * 128 * 4096;
    const h16* W2T = (const h16*)(A.ws + WS_W2T) + (size_t)kv * 128 * 128; const float* posb = (const float*)(A.ws + WS_POSB) + kv * 128;
    h16* OUT = (h16*)(A.ws + WS_KC) + ((size_t)((kv * 2 + b) * 2 + g) * 256) * 128;
    const int colbase = (kv ? C_VCMP : C_KCMP) + g * 128;
    const int i16 = lane & 15, kq = lane >> 4;
    int n = 16 * rt + i16; const int nc = n > 254 ? 254 : n;
    f32x4 acc[8];
#pragma unroll
    for (int nt = 0; nt < 8; ++nt) acc[nt] = (f32x4){0.f, 0.f, 0.f, 0.f};
#pragma unroll 8
    for (int ks = 0; ks < 16; ++ks) {
        const int l = 4 * wave + (ks >> 2), d = ((ks & 3) * 32 + 8 * kq);
        const h16x8 af = *(const h16x8*)(QKV + (size_t)(b * SEQ + 16 * nc + l) * NQKV + colbase + d);
        const int k = 512 * wave + 32 * ks + 8 * kq;
#pragma unroll
        for (int nt = 0; nt < 8; ++nt) { const h16x8 bf = *(const h16x8*)(W1T + (size_t)(16 * nt + i16) * 4096 + k);
            acc[nt] = __builtin_amdgcn_mfma_f32_16x16x32_f16(af, bf, acc[nt], 0, 0, 0); }
    }
    LAS float* red = (LAS float*)lds;
    LAS h16* hid = (LAS h16*)(lds + 65536);
#pragma unroll
    for (int nt = 0; nt < 8; ++nt)
#pragma unroll
        for (int rg = 0; rg < 4; ++rg) red[(wave * 16 + 4 * kq + rg) * 128 + 16 * nt + i16] = acc[nt][rg];
    __syncthreads();
    { const int tid = wave * 64 + lane;
#pragma unroll
      for (int q = 0; q < 4; ++q) { const int e = tid + 512 * q; const int j = e & 127; float s = posb[j];
#pragma unroll
          for (int w = 0; w < 8; ++w) s += red[w * 2048 + e];
          hid[e] = (h16)silu_f(s); } }
    __syncthreads();
    f32x4 o = {0.f, 0.f, 0.f, 0.f};
#pragma unroll
    for (int ks = 0; ks < 4; ++ks) { const h16x8 af = *(const LAS h16x8*)(hid + i16 * 128 + 32 * ks + 8 * kq);
        const h16x8 bf = *(const h16x8*)(W2T + (size_t)(16 * wave + i16) * 128 + 32 * ks + 8 * kq);
        o = __builtin_amdgcn_mfma_f32_16x16x32_f16(af, bf, o, 0, 0, 0); }
#pragma unroll
    for (int rg = 0; rg < 4; ++rg) { const int nn = 16 * rt + 4 * kq + rg; OUT[(size_t)nn * 128 + 16 * wave + i16] = nn > 254 ? (h16)0.f : (h16)o[rg]; }
    __syncthreads();
}
__device__ __forceinline__ void p3_compress_splitk(const Args& A, LAS unsigned char* lds, unsigned* ctl, int it, int wave, int lane) {
    const int kv = it >> 7, mt = (it >> 3) & 15, ks8 = it & 7, b = mt >> 3, g = (mt >> 2) & 1, mq = mt & 3;
    const h16* QKV = (const h16*)(A.ws + WS_QKV); const h16* W1T = (const h16*)(A.ws + WS_W1T) + (size_t)kv * 128 * 4096;
    const h16* W2T = (const h16*)(A.ws + WS_W2T) + (size_t)kv * 128 * 128; const float* posb = (const float*)(A.ws + WS_POSB) + kv * 128;
    h16* OUT = (h16*)(A.ws + WS_KC) + ((size_t)((kv * 2 + b) * 2 + g) * 256) * 128;
    float* PART = (float*)(A.ws + WS_F) + (size_t)((kv * 16 + mt) * 8) * 8192;
    unsigned* cntw = ctl + CW_XCH + 6144 + 64 * (kv * 16 + mt);
    const int colbase = (kv ? C_VCMP : C_KCMP) + g * 128;
    const int i16 = lane & 15, kq = lane >> 4, wr = wave >> 1, wk = wave & 1;
    const int n = 64 * mq + 16 * wr + i16; const int nc = n > 254 ? 254 : n;
    f32x4 acc[8];
#pragma unroll
    for (int nt = 0; nt < 8; ++nt) acc[nt] = (f32x4){0.f, 0.f, 0.f, 0.f};
#pragma unroll
    for (int s_ = 0; s_ < 8; ++s_) {
        const int l = 4 * ks8 + 2 * wk + (s_ >> 2), d = (s_ & 3) * 32 + 8 * kq;
        const h16x8 af = *(const h16x8*)(QKV + (size_t)(b * SEQ + 16 * nc + l) * NQKV + colbase + d);
        const int k = 512 * ks8 + 256 * wk + 32 * s_ + 8 * kq;
#pragma unroll
        for (int nt = 0; nt < 8; ++nt) { const h16x8 bf = *(const h16x8*)(W1T + (size_t)(16 * nt + i16) * 4096 + k);
            acc[nt] = __builtin_amdgcn_mfma_f32_16x16x32_f16(af, bf, acc[nt], 0, 0, 0); }
    }
    LAS float* red = (LAS float*)lds;
    LAS h16* hid = (LAS h16*)(lds + 65536);
#pragma unroll
    for (int nt = 0; nt < 8; ++nt)
#pragma unroll
        for (int rg = 0; rg < 4; ++rg) red[(wave * 16 + 4 * kq + rg) * 128 + 16 * nt + i16] = acc[nt][rg];
    __syncthreads();
    { const int tid = wave * 64 + lane;
#pragma unroll
      for (int q = 0; q < 4; ++q) { const int f = (tid + 512 * q) * 4; const int w2 = f >> 11, rest = f & 2047;
          const f32x4 v = *(const LAS f32x4*)(red + (2 * w2) * 2048 + rest) + *(const LAS f32x4*)(red + (2 * w2 + 1) * 2048 + rest);
          const float* dp = PART + (size_t)ks8 * 8192 + f;
          asm volatile("global_store_dwordx4 %0, %1, off sc0 sc1\n\ts_nop 2" :: "v"(dp), "v"(v) : "memory"); } }
    asm volatile("s_waitcnt vmcnt(0)" ::: "memory");
    if (lane == 0) __hip_atomic_fetch_add(cntw, 1u, __ATOMIC_RELAXED, __HIP_MEMORY_SCOPE_AGENT);
    if (ks8 < 4) {
        if (wave == 0) { unsigned sp = 0u;
            while ((unsigned)__builtin_amdgcn_readfirstlane((int)__hip_atomic_load(cntw, __ATOMIC_RELAXED, __HIP_MEMORY_SCOPE_AGENT)) < 64u) { __builtin_amdgcn_s_sleep(1); if (++sp > (1u << 22)) break; }
            __builtin_amdgcn_fence(__ATOMIC_ACQUIRE, "agent"); }
        __syncthreads();
        { const int tid = wave * 64 + lane; const int e4 = tid * 4; const float* p = PART + (size_t)ks8 * 2048 + e4; f32x4 q0, q1, q2, q3, q4, q5, q6, q7;
          asm volatile("global_load_dwordx4 %0, %8, off sc1\n\tglobal_load_dwordx4 %1, %9, off sc1\n\tglobal_load_dwordx4 %2, %10, off sc1\n\tglobal_load_dwordx4 %3, %11, off sc1\n\t"
                       "global_load_dwordx4 %4, %12, off sc1\n\tglobal_load_dwordx4 %5, %13, off sc1\n\tglobal_load_dwordx4 %6, %14, off sc1\n\tglobal_load_dwordx4 %7, %15, off sc1\n\ts_waitcnt vmcnt(0)"
                       : "=&v"(q0), "=&v"(q1), "=&v"(q2), "=&v"(q3), "=&v"(q4), "=&v"(q5), "=&v"(q6), "=&v"(q7)
                       : "v"(p), "v"(p + 8192), "v"(p + 2 * 8192), "v"(p + 3 * 8192), "v"(p + 4 * 8192), "v"(p + 5 * 8192), "v"(p + 6 * 8192), "v"(p + 7 * 8192) : "memory");
          const f32x4 t = (((q0 + q1) + (q2 + q3)) + ((q4 + q5) + (q6 + q7))) + *(const f32x4*)(posb + (e4 & 127));
          h16* hp = (h16*)nullptr; (void)hp;
          u32x2 hw; hw.x = pk2h(silu_f(t[0]), silu_f(t[1])); hw.y = pk2h(silu_f(t[2]), silu_f(t[3]));
          *(LAS u32x2*)(hid + e4) = hw; }
        __syncthreads();
        f32x4 o = {0.f, 0.f, 0.f, 0.f};
#pragma unroll
        for (int ks = 0; ks < 4; ++ks) { const h16x8 af = *(const LAS h16x8*)(hid + i16 * 128 + 32 * ks + 8 * kq);
            const h16x8 bf = *(const h16x8*)(W2T + (size_t)(16 * wave + i16) * 128 + 32 * ks + 8 * kq);
            o = __builtin_amdgcn_mfma_f32_16x16x32_f16(af, bf, o, 0, 0, 0); }
#pragma unroll
        for (int rg = 0; rg < 4; ++rg) { const int nn = 64 * mq + 16 * ks8 + 4 * kq + rg; const h16 ov = nn > 254 ? (h16)0.f : (h16)o[rg]; h16* op_ = OUT + (size_t)nn * 128 + 16 * wave + i16;
            const unsigned ob = (unsigned)__builtin_bit_cast(unsigned short, ov); asm volatile("global_store_short %0, %1, off sc0 sc1" :: "v"(op_), "v"(ob) : "memory"); }
        asm volatile("s_waitcnt vmcnt(0)" ::: "memory");
    }
    __syncthreads();
    if (ks8 < 4 && wave == 0 && lane == 0) __hip_atomic_fetch_add(ctl + CW_P34 + 64 * (b * 2 + g), 1u, __ATOMIC_RELAXED, __HIP_MEMORY_SCOPE_AGENT);
}
__device__ __forceinline__ void p3_kmean_item(const Args& A, LAS unsigned char* lds, int item, int wave, int lane, unsigned* ctl = nullptr) {
    const int b = item >> 6, nb = (item >> 2) & 15, cq = item & 3;
    const h16* QKV = (const h16*)(A.ws + WS_QKV); h16* KM = (h16*)(A.ws + WS_KMEAN);
    const int tid = wave * 64 + lane, cc = tid & 31, rg = tid >> 5;
    const h16* src = QKV + (size_t)(b * SEQ + nb * 256 + rg * 16) * NQKV + C_KM + cq * 256 + cc * 8;
    h16x8 v[16];
#pragma unroll
    for (int r = 0; r < 16; ++r) v[r] = *(const h16x8*)(src + (size_t)r * NQKV);
    float s8[8];
#pragma unroll
    for (int e = 0; e < 8; ++e) s8[e] = 0.f;
#pragma unroll
    for (int r = 0; r < 16; ++r)
#pragma unroll
        for (int e = 0; e < 8; ++e) s8[e] += (float)v[r][e];
    LAS float* red = (LAS float*)lds;
    *(LAS f32x4*)(red + rg * 256 + cc * 8) = (f32x4){s8[0], s8[1], s8[2], s8[3]}; *(LAS f32x4*)(red + rg * 256 + cc * 8 + 4) = (f32x4){s8[4], s8[5], s8[6], s8[7]};
    __syncthreads();
    if (tid < 256) { float t = 0.f;
#pragma unroll
        for (int g_ = 0; g_ < 16; ++g_) t += red[g_ * 256 + tid];
        const int h = cq * 2 + (tid >> 7), d = tid & 127;
        h16* kp_ = KM + ((size_t)(b * 8 + h) * 32 + nb) * 128 + d; const unsigned kb_ = (unsigned)__builtin_bit_cast(unsigned short, (h16)(t * (1.f / 256.f)));
        asm volatile("global_store_short %0, %1, off sc0 sc1\n\ts_waitcnt vmcnt(0)" :: "v"(kp_), "v"(kb_) : "memory"); }
    __syncthreads();
    if (ctl && tid == 0) __hip_atomic_fetch_add(ctl + CW_P34 + 64 * (4 + b * 4 + cq), 1u, __ATOMIC_RELAXED, __HIP_MEMORY_SCOPE_AGENT);
}

namespace att {
constexpr int SHM_K = 16384, SHM_V = 16384;
constexpr int L_V = 0, L_K = 3 * SHM_V, L_WS = L_K + 3 * SHM_K, L_IMP = L_WS + NWAVES * 256, L_SEL = L_IMP + 64 * 64 * 4, L_END = L_SEL + 64 * 8;
#define KSWZ(row, colB) ((row) * 256 + ((colB) ^ (((row) & 7) << 4)))
#define SBAR() __builtin_amdgcn_sched_barrier(0)
__device__ __forceinline__ int v_st(int k, int c) { const int kk = (k & ~0xC) | ((k & 4) << 1) | ((k & 8) >> 1); return ((kk >> 3) * 4 + (c >> 5)) * 512 + ((kk & 7) * 32 + (c & 31)) * 2; }
__device__ __forceinline__ int v_rd_base(int lane) { return ((lane & 3) << 3) | (((lane >> 2) & 3) << 6) | (((lane >> 4) & 1) << 5) | (((lane >> 5) & 1) << 8); }
constexpr int v_rd_off(int d0, int ks, int half) { return d0 * 512 + ks * 4096 + half * 2048; }
__device__ __forceinline__ int crow(int r, int hi) { return (r & 3) + 8 * (r >> 2) + 4 * hi; }

struct Ctx {
    int tid, wid, lane, r32, hi, sr, sc, kws, vst0, vst1, vb0;
    LAS char* lds; LAS char* V_lds; LAS char* K_lds; LAS float* wsc;
};
struct Stage { h16x8 k0, k1, v0, v1; };

__device__ __forceinline__ void stage_load(Stage& S, const Ctx& c, const h16* Kp, const h16* Vp, int rs, int key0) {
    const char* kb = (const char*)Kp + (size_t)key0 * rs * 2; const char* vb = (const char*)Vp + (size_t)key0 * rs * 2;
    const unsigned lo = (unsigned)(c.sr * rs + c.sc) * 2u, lo2 = lo + (unsigned)(32 * rs) * 2u;
    S.v0 = *(const h16x8*)(vb + lo); S.v1 = *(const h16x8*)(vb + lo2);
    S.k0 = *(const h16x8*)(kb + lo); S.k1 = *(const h16x8*)(kb + lo2);
}
__device__ __forceinline__ void stage_load_k(Stage& S, const Ctx& c, const h16* Kp, int rs, int key0) {
    const char* kb = (const char*)Kp + (size_t)key0 * rs * 2;
    const unsigned lo = (unsigned)(c.sr * rs + c.sc) * 2u, lo2 = lo + (unsigned)(32 * rs) * 2u;
    S.k0 = *(const h16x8*)(kb + lo); S.k1 = *(const h16x8*)(kb + lo2);
}
template <int BUF> __device__ __forceinline__ void stage_write_k(const Stage& S, const Ctx& c) {
    *(LAS h16x8*)(c.K_lds + BUF * SHM_K + c.kws) = S.k0; *(LAS h16x8*)(c.K_lds + BUF * SHM_K + c.kws + 32 * 256) = S.k1;
}
template <int BUF> __device__ __forceinline__ void stage_write(const Stage& S, const Ctx& c) {
    *(LAS h16x8*)(c.V_lds + BUF * SHM_V + c.vst0) = S.v0; *(LAS h16x8*)(c.V_lds + BUF * SHM_V + c.vst1) = S.v1;
    stage_write_k<BUF>(S, c);
}
template <int KB, bool HALF_ONLY>
__device__ __forceinline__ void qkt(f32x16& p0, f32x16& p1, const Ctx& c, const h16x8* qr) {
    p0 = f32x16{}; p1 = f32x16{};
    const LAS char* kb[4];
#pragma unroll
    for (int dd = 0; dd < 4; ++dd) kb[dd] = c.K_lds + KB * SHM_K + KSWZ(c.r32, (dd * 16 + c.hi * 8) * 2);
#pragma unroll
    for (int d0 = 0; d0 < 8; ++d0) { const LAS char* a = kb[d0 & 3] + (d0 >> 2) * 128;
        const h16x8 b0 = *(const LAS h16x8*)(a);
        p0 = __builtin_amdgcn_mfma_f32_32x32x16_f16(b0, qr[d0], p0, 0, 0, 0);
        if (!HALF_ONLY) { const h16x8 b1 = *(const LAS h16x8*)(a + 32 * 256);
            p1 = __builtin_amdgcn_mfma_f32_32x32x16_f16(b1, qr[d0], p1, 0, 0, 0); } }
}
template <int VB>
__device__ __forceinline__ void pv_tile(f32x16* o, int vb0, h16x8 pa0, h16x8 pa1, h16x8 pa2, h16x8 pa3) {
#define TRRD(dst, off) asm volatile("ds_read_b64_tr_b16 %0, %1 offset:%2" : "=&v"(dst) : "v"(vb0), "i"(off) : "memory")
#define MKB(l, h) __builtin_bit_cast(h16x8, (s16x8){l[0], l[1], l[2], l[3], h[0], h[1], h[2], h[3]})
#define PV_D0(d0) do { s16x4 l0, l1, l2, l3, h0, h1, h2, h3; constexpr int b_ = VB * SHM_V + v_rd_off(d0, 0, 0); \
        TRRD(l0, b_); TRRD(h0, b_ + 2048); TRRD(l1, b_ + 4096); TRRD(h1, b_ + 6144); TRRD(l2, b_ + 8192); TRRD(h2, b_ + 10240); TRRD(l3, b_ + 12288); TRRD(h3, b_ + 14336); \
        asm volatile("s_waitcnt lgkmcnt(0)" ::: "memory"); SBAR(); \
        o[d0] = __builtin_amdgcn_mfma_f32_32x32x16_f16(pa0, MKB(l0, h0), o[d0], 0, 0, 0); \
        o[d0] = __builtin_amdgcn_mfma_f32_32x32x16_f16(pa1, MKB(l1, h1), o[d0], 0, 0, 0); \
        o[d0] = __builtin_amdgcn_mfma_f32_32x32x16_f16(pa2, MKB(l2, h2), o[d0], 0, 0, 0); \
        o[d0] = __builtin_amdgcn_mfma_f32_32x32x16_f16(pa3, MKB(l3, h3), o[d0], 0, 0, 0); } while (0)
    PV_D0(0); PV_D0(1); PV_D0(2); PV_D0(3);
#undef PV_D0
#undef MKB
#undef TRRD
}
__device__ __forceinline__ void mask_tile(f32x16& p0, f32x16& p1, int dq, unsigned W, bool rowon) {
    const float NEG = -__builtin_inff();
#pragma unroll
    for (int r = 0; r < 16; ++r) {
        const int c = (r & 3) + 8 * (r >> 2);
        if (!rowon || (unsigned)(dq - c) >= W) p0[r] = NEG;
        if (!rowon || (unsigned)(dq - c - 32) >= W) p1[r] = NEG;
    }
}
__device__ __forceinline__ float rowmax32(const f32x16& p0, const f32x16& p1) {
    float pmax = p0[0];
#pragma unroll
    for (int r = 1; r < 16; ++r) pmax = fmaxf(pmax, p0[r]);
#pragma unroll
    for (int r = 0; r < 16; ++r) pmax = fmaxf(pmax, p1[r]);
    auto rr = __builtin_amdgcn_permlane32_swap(__float_as_uint(pmax), __float_as_uint(pmax), false, false);
    return fmaxf(__uint_as_float(rr[0]), __uint_as_float(rr[1]));
}
__device__ __forceinline__ float rowsum32(const f32x16& p0, const f32x16& p1) {
    float ps = 0.f;
#pragma unroll
    for (int r = 0; r < 16; ++r) ps += p0[r];
#pragma unroll
    for (int r = 0; r < 16; ++r) ps += p1[r];
    auto rr = __builtin_amdgcn_permlane32_swap(__float_as_uint(ps), __float_as_uint(ps), false, false);
    return __uint_as_float(rr[0]) + __uint_as_float(rr[1]);
}
__device__ __forceinline__ void pack_p(const f32x16& p0, const f32x16& p1, h16x8& pa0, h16x8& pa1, h16x8& pa2, h16x8& pa3) {
#define PK4(P, B_, OUT) do { unsigned a0 = pk2h(P[B_+0], P[B_+1]), a1 = pk2h(P[B_+2], P[B_+3]); \
        unsigned b0 = pk2h(P[B_+4], P[B_+5]), b1 = pk2h(P[B_+6], P[B_+7]); \
        auto r0 = __builtin_amdgcn_permlane32_swap(a0, b0, false, false); auto r1 = __builtin_amdgcn_permlane32_swap(a1, b1, false, false); \
        u32x4 w = {r0[0], r1[0], r0[1], r1[1]}; OUT = __builtin_bit_cast(h16x8, w); } while (0)
    PK4(p0, 0, pa0); PK4(p0, 8, pa1); PK4(p1, 0, pa2); PK4(p1, 8, pa3);
#undef PK4
}
constexpr float THR = 8.f;
struct SM { float m, l; };

template <int BUF>
__device__ __forceinline__ void tile_step(const Ctx& c, const h16x8* qr, f32x16* o, SM& sm, int j, int pos, unsigned W, unsigned long long rowmask, int qlo, int qhi) {
    const int kb = 64 * j;
    const bool rowon = (rowmask >> j) & 1ull;
    const bool act = __any(rowon) && (kb <= qhi) && (kb + 63 >= qlo - (int)W + 1);
    if (!act) return;
    f32x16 p0, p1;
    qkt<BUF, false>(p0, p1, c, qr);
    const bool need = (kb + 63 > qlo) || (kb <= qhi - (int)W) || !__all(rowon);
    if (need) mask_tile(p0, p1, pos - kb - 4 * c.hi, W, rowon);
    const float pmax = rowmax32(p0, p1);
    float mn, alpha;
    if (__builtin_expect(__all((pmax - sm.m) <= THR), 1)) { mn = sm.m; alpha = 1.f; }
    else { mn = fmaxf(sm.m, pmax); alpha = __builtin_amdgcn_exp2f((sm.m - mn) * LOG2E); sm.m = mn; }
    const float mnL = -mn * LOG2E;
#pragma unroll
    for (int r = 0; r < 16; ++r) { p0[r] = __builtin_amdgcn_exp2f(fmaf(p0[r], LOG2E, mnL)); p1[r] = __builtin_amdgcn_exp2f(fmaf(p1[r], LOG2E, mnL)); }
    sm.l = sm.l * alpha + rowsum32(p0, p1);
    h16x8 pa0, pa1, pa2, pa3; pack_p(p0, p1, pa0, pa1, pa2, pa3);
    if (__any(alpha < 1.f)) { LAS float* al = c.wsc + 32; if (c.hi == 0) al[c.r32] = alpha; asm volatile("s_waitcnt lgkmcnt(0)" ::: "memory");
#pragma unroll
        for (int d_ = 0; d_ < 4; ++d_)
#pragma unroll
            for (int r = 0; r < 16; ++r) o[d_][r] *= al[crow(r, c.hi)]; }
    SBAR();
    pv_tile<BUF>(o, c.vb0, pa0, pa1, pa2, pa3);
}
__device__ __forceinline__ int next_tile(unsigned long long tiles, int j) {
    const unsigned long long rest = (j >= 63) ? 0ull : (tiles >> (j + 1)) << (j + 1);
    return rest ? (int)__builtin_ctzll(rest) : -1;
}
template <int VAR>
__device__ __forceinline__ void run_attn(const Ctx& c, const h16x8* qr, f32x16* o, SM& sm, const h16* Kp, const h16* Vp, int rs,
                                         unsigned long long tiles, int pos, unsigned W, unsigned long long rowmask, int qlo, int qhi) {
    Stage S;
    int j = (int)__builtin_ctzll(tiles);
#define SLOAD(jj) do { if (VAR == 0) stage_load(S, c, Kp, Vp, rs, 64 * (jj)); } while (0)
#define SWRITE(B) do { if (VAR == 0) stage_write<B>(S, c); } while (0)
#define TSYNC() do { if (VAR != 2) __syncthreads(); } while (0)
    SLOAD(j); SWRITE(0); __syncthreads();
    for (;;) {
        int jn = next_tile(tiles, j);
        if (jn >= 0) SLOAD(jn);
        tile_step<0>(c, qr, o, sm, j, pos, W, rowmask, qlo, qhi);
        if (jn < 0) break;
        SWRITE(1); TSYNC();
        j = jn; jn = next_tile(tiles, j);
        if (jn >= 0) SLOAD(jn);
        tile_step<1>(c, qr, o, sm, j, pos, W, rowmask, qlo, qhi);
        if (jn < 0) break;
        SWRITE(0); TSYNC();
        j = jn;
    }
    __syncthreads();
#undef SLOAD
#undef SWRITE
#undef TSYNC
}

template <int KB, bool HALF_ONLY>
__device__ __forceinline__ void qkt_sk(f32x16& p0, f32x16& p1, const Ctx& c, const h16x8* qr, bool act) {
    if (!act) { const float NEG = -__builtin_inff();
#pragma unroll
        for (int r = 0; r < 16; ++r) { p0[r] = NEG; p1[r] = NEG; } return; }
    qkt<KB, HALF_ONLY>(p0, p1, c, qr);
}
__device__ __forceinline__ void partialSM(f32x16& p0, f32x16& p1, float& m_reg, float& alpha) {
    const float pmax = rowmax32(p0, p1); float mn;
    if (__builtin_expect(__all((pmax - m_reg) <= THR), 1)) { mn = m_reg; alpha = 1.f; }
    else { mn = fmaxf(m_reg, pmax); alpha = __builtin_amdgcn_exp2f((m_reg - mn) * LOG2E); m_reg = mn; }
    const float mnL = -mn * LOG2E;
#pragma unroll
    for (int r = 0; r < 16; ++r) { p0[r] = fmaf(p0[r], LOG2E, mnL); p1[r] = fmaf(p1[r], LOG2E, mnL); }
#pragma unroll
    for (int r = 0; r < 16; ++r) p0[r] = __builtin_amdgcn_exp2f(p0[r]);
}
__device__ __forceinline__ void finishSM(f32x16& p0, f32x16& p1, float alpha, float& l_reg, h16x8& pa0, h16x8& pa1, h16x8& pa2, h16x8& pa3) {
#pragma unroll
    for (int r = 0; r < 16; ++r) p1[r] = __builtin_amdgcn_exp2f(p1[r]);
    l_reg = l_reg * alpha + rowsum32(p0, p1);
    pack_p(p0, p1, pa0, pa1, pa2, pa3);
}
__device__ __forceinline__ void run_attn2(const Ctx& c, const h16x8* qr, f32x16* o, SM& sm, const h16* Kp, const h16* Vp, int rs,
                                          int j_lo, int j_hi, int pos, unsigned W, unsigned long long rowmask, int qlo, int qhi) {
    const int NT = j_hi - j_lo;
    Stage S;
    f32x16 pA0, pA1, pB0, pB1; float alA, alB; h16x8 pa0, pa1, pa2, pa3;
#define KBASE(t) ((j_lo + (t)) * 64)
#define ROWON(t) (((rowmask >> (j_lo + (t))) & 1ull) != 0ull)
#define ACT(t) (__any(ROWON(t)) && KBASE(t) <= qhi && KBASE(t) + 63 >= qlo - (int)W + 1)
#define MASKT(P0_, P1_, t) do { const int kb_ = KBASE(t); const bool ron_ = ROWON(t); \
        if (ACT(t) && ((kb_ + 63 > qlo) || (kb_ <= qhi - (int)W) || !__all(ron_))) mask_tile(P0_, P1_, pos - kb_ - 4 * c.hi, W, ron_); } while (0)
#define RESC(a) do { if (__any((a) < 1.f)) { LAS float* al = c.wsc + 32; if (c.hi == 0) al[c.r32] = (a); asm volatile("s_waitcnt lgkmcnt(0)" ::: "memory"); \
        _Pragma("unroll") for (int d_ = 0; d_ < 4; ++d_) _Pragma("unroll") for (int r = 0; r < 16; ++r) o[d_][r] *= al[crow(r, c.hi)]; } } while (0)
    stage_load(S, c, Kp, Vp, rs, KBASE(0)); stage_write<0>(S, c);
    if (NT > 1) stage_load(S, c, Kp, Vp, rs, KBASE(1));
    __syncthreads();
    SBAR(); qkt_sk<0, false>(pA0, pA1, c, qr, ACT(0));
    MASKT(pA0, pA1, 0); partialSM(pA0, pA1, sm.m, alA);
    if (NT > 1) stage_write<1>(S, c);
    __syncthreads();
#define HALF_STEP(PX0, PX1, alX, PY0, PY1, alY, t, KB, VB, SB) do { \
        SBAR(); qkt_sk<KB, false>(PX0, PX1, c, qr, ACT(t)); \
        finishSM(PY0, PY1, alY, sm.l, pa0, pa1, pa2, pa3); SBAR(); \
        if ((t) + 1 < NT) { stage_load(S, c, Kp, Vp, rs, KBASE((t) + 1)); SBAR(); } \
        if (ACT((t) - 1)) pv_tile<VB>(o, c.vb0, pa0, pa1, pa2, pa3); \
        MASKT(PX0, PX1, (t)); partialSM(PX0, PX1, sm.m, alX); \
        __syncthreads(); \
        if ((t) + 1 < NT) { stage_write<SB>(S, c); } \
        RESC(alX); __syncthreads(); } while (0)
    for (int t = 1; t + 1 < NT; t += 2) {
        HALF_STEP(pB0, pB1, alB, pA0, pA1, alA, t, 1, 0, 0);
        HALF_STEP(pA0, pA1, alA, pB0, pB1, alB, t + 1, 0, 1, 1);
    }
    const bool even = (NT & 1) == 0;
    if (even) { SBAR(); qkt_sk<1, false>(pB0, pB1, c, qr, ACT(NT - 1)); SBAR(); }
    finishSM(pA0, pA1, alA, sm.l, pa0, pa1, pa2, pa3); SBAR();
    if (ACT(even ? NT - 2 : NT - 1)) pv_tile<0>(o, c.vb0, pa0, pa1, pa2, pa3);
    if (even) { MASKT(pB0, pB1, NT - 1); partialSM(pB0, pB1, sm.m, alB); RESC(alB);
        finishSM(pB0, pB1, alB, sm.l, pa0, pa1, pa2, pa3); SBAR(); if (ACT(NT - 1)) pv_tile<1>(o, c.vb0, pa0, pa1, pa2, pa3); }
    __syncthreads();
#undef HALF_STEP
#undef RESC
#undef MASKT
#undef ACT
#undef ROWON
#undef KBASE
}

__device__ __forceinline__ void qkt_rt(f32x16& p0, f32x16& p1, const Ctx& c, const h16x8* qr, int kbo  , float bias = 0.f) {
#pragma unroll
    for (int r = 0; r < 16; ++r) { p0[r] = bias; p1[r] = bias; }
    const LAS char* kb[4];
#pragma unroll
    for (int dd = 0; dd < 4; ++dd) kb[dd] = c.K_lds + kbo + KSWZ(c.r32, (dd * 16 + c.hi * 8) * 2);
#define KFRAG(d0, half) (*(const LAS h16x8*)(kb[(d0) & 3] + ((d0) >> 2) * 128 + (half) * 32 * 256))
#define QK4(A0, A1, A2, A3, g) do { p0 = __builtin_amdgcn_mfma_f32_32x32x16_f16(A0, qr[2 * (g)], p0, 0, 0, 0); p1 = __builtin_amdgcn_mfma_f32_32x32x16_f16(A1, qr[2 * (g)], p1, 0, 0, 0); \
        p0 = __builtin_amdgcn_mfma_f32_32x32x16_f16(A2, qr[2 * (g) + 1], p0, 0, 0, 0); p1 = __builtin_amdgcn_mfma_f32_32x32x16_f16(A3, qr[2 * (g) + 1], p1, 0, 0, 0); } while (0)
    h16x8 a0 = KFRAG(0, 0), a1 = KFRAG(0, 1), a2 = KFRAG(1, 0), a3 = KFRAG(1, 1);
    h16x8 b0 = KFRAG(2, 0), b1 = KFRAG(2, 1), b2 = KFRAG(3, 0), b3 = KFRAG(3, 1);
    SBAR(); QK4(a0, a1, a2, a3, 0); SBAR();
    a0 = KFRAG(4, 0); a1 = KFRAG(4, 1); a2 = KFRAG(5, 0); a3 = KFRAG(5, 1);
    SBAR(); QK4(b0, b1, b2, b3, 1); SBAR();
    b0 = KFRAG(6, 0); b1 = KFRAG(6, 1); b2 = KFRAG(7, 0); b3 = KFRAG(7, 1);
    SBAR(); QK4(a0, a1, a2, a3, 2); SBAR();
    QK4(b0, b1, b2, b3, 3);
#undef QK4
#undef KFRAG
}
__device__ __forceinline__ void stage_write_rt(const Stage& S, const Ctx& c, int kbo, int vbo) {
    *(LAS h16x8*)(c.V_lds + vbo + c.vst0) = S.v0; *(LAS h16x8*)(c.V_lds + vbo + c.vst1) = S.v1;
    *(LAS h16x8*)(c.K_lds + kbo + c.kws) = S.k0; *(LAS h16x8*)(c.K_lds + kbo + c.kws + 32 * 256) = S.k1;
}
template <bool LAG>
__device__ __forceinline__ void run_attn4_impl(const Ctx& c, const h16x8* qr, f32x16* o, SM& sm, const h16* Kp, const h16* Vp, int rs,
                                          int j_lo, int j_hi, int pos, unsigned W, unsigned long long rowmask, int qlo, int qhi) {
    const int NT = j_hi - j_lo;
    constexpr bool lag = LAG;
    Stage S;
    f32x16 p0, p1;
#define KBASE(t) ((j_lo + (t)) * 64)
#define ROWON(t) (((rowmask >> (j_lo + (t))) & 1ull) != 0ull)
#define ACT(t) (__any(ROWON(t)) && KBASE(t) <= qhi && KBASE(t) + 63 >= qlo - (int)W + 1)
#define QK_STEP(t, kbo_) do { if (ACT(t)) { qkt_rt(p0, p1, c, qr, (kbo_)); const int kb_ = KBASE(t); const bool ron_ = ROWON(t); \
            if ((kb_ + 63 > qlo) || (kb_ <= qhi - (int)W) || !__all(ron_)) mask_tile(p0, p1, pos - kb_ - 4 * c.hi, W, ron_); } } while (0)
#define SMPV_STEP(t, vbo_) do { if (ACT(t)) { \
        const float pmax = rowmax32(p0, p1); float mn, alpha; \
        if (__builtin_expect(__all((pmax - sm.m) <= THR), 1)) { mn = sm.m; alpha = 1.f; } \
        else { mn = fmaxf(sm.m, pmax); alpha = __builtin_amdgcn_exp2f((sm.m - mn) * LOG2E); sm.m = mn; } \
        const float mnL = -mn * LOG2E; \
        _Pragma("unroll") for (int r = 0; r < 16; ++r) { p0[r] = __builtin_amdgcn_exp2f(fmaf(p0[r], LOG2E, mnL)); p1[r] = __builtin_amdgcn_exp2f(fmaf(p1[r], LOG2E, mnL)); } \
        sm.l = sm.l * alpha + rowsum32(p0, p1); \
        h16x8 pa0, pa1, pa2, pa3; pack_p(p0, p1, pa0, pa1, pa2, pa3); \
        if (__any(alpha < 1.f)) { LAS float* al = c.wsc + 32; if (c.hi == 0) al[c.r32] = alpha; asm volatile("s_waitcnt lgkmcnt(0)" ::: "memory"); \
            _Pragma("unroll") for (int d_ = 0; d_ < 4; ++d_) _Pragma("unroll") for (int r = 0; r < 16; ++r) o[d_][r] *= al[crow(r, c.hi)]; } \
        SBAR(); pv_tile<0>(o, c.vb0 + (vbo_), pa0, pa1, pa2, pa3); } } while (0)
    stage_load(S, c, Kp, Vp, rs, KBASE(0)); stage_write_rt(S, c, 0, 0);
    __syncthreads();
    int kbo = 0, vbo = 0;
    for (int t = 0; t < NT; ++t) {
        const int kbn = kbo ^ SHM_K, vbn = (vbo == 2 * SHM_V) ? 0 : vbo + SHM_V, vbp = (vbo == 0) ? 2 * SHM_V : vbo - SHM_V;
        if (t + 1 < NT) stage_load(S, c, Kp, Vp, rs, KBASE(t + 1));
        if (!lag) { QK_STEP(t, kbo); SMPV_STEP(t, vbo); }
        else { if (t > 0) SMPV_STEP(t - 1, vbp); QK_STEP(t, kbo); }
        if (t + 1 < NT) stage_write_rt(S, c, kbn, vbn);
        __syncthreads();
        kbo = kbn; vbo = vbn;
    }
    if (lag) { const int vlast = (vbo == 0) ? 2 * SHM_V : vbo - SHM_V; SMPV_STEP(NT - 1, vlast); }
    __syncthreads();
#undef SMPV_STEP
#undef QK_STEP
#undef ACT
#undef ROWON
#undef KBASE
}
__device__ __forceinline__ void run_attn4(const Ctx& c, const h16x8* qr, f32x16* o, SM& sm, const h16* Kp, const h16* Vp, int rs,
                                          int j_lo, int j_hi, int pos, unsigned W, unsigned long long rowmask, int qlo, int qhi) {
    if (c.wid >= 4) run_attn4_impl<true>(c, qr, o, sm, Kp, Vp, rs, j_lo, j_hi, pos, W, rowmask, qlo, qhi);
    else run_attn4_impl<false>(c, qr, o, sm, Kp, Vp, rs, j_lo, j_hi, pos, W, rowmask, qlo, qhi);
}

#define ABAR() do { asm volatile("s_waitcnt lgkmcnt(0)" ::: "memory"); __builtin_amdgcn_s_barrier(); asm volatile("" ::: "memory"); } while (0)
__device__ __forceinline__ void run_attn5(const Ctx& c, const h16x8* qr, f32x16* o, SM& sm, const h16* Kp, const h16* Vp, int rs,
                                          int j_lo, int j_hi, int pos, unsigned W, unsigned long long rowmask, int qlo, int qhi) {
    const int NT = j_hi - j_lo;
    const bool lagw = (c.wid & 1) != 0;
    Stage S;
    f32x16 p0, p1;
#define KBASE(t) ((j_lo + (t)) * 64)
#define ROWON(t) (((rowmask >> (j_lo + (t))) & 1ull) != 0ull)
#define ACT(t) (__any(ROWON(t)) && KBASE(t) <= qhi && KBASE(t) + 63 >= qlo - (int)W + 1)
    stage_load(S, c, Kp, Vp, rs, KBASE(0)); stage_write_rt(S, c, 0, 0);
    if (NT > 1) { stage_load(S, c, Kp, Vp, rs, KBASE(1)); stage_write_rt(S, c, SHM_K, SHM_V); }
    __syncthreads();
    if (lagw) ABAR();
    int bo = 0;
    for (int t = 0; t < NT; ++t) {
        const int bo2 = (bo == 0) ? 2 * SHM_K : bo - SHM_K;
        const bool act = ACT(t);
        if (t + 2 < NT) stage_load(S, c, Kp, Vp, rs, KBASE(t + 2));
        float alpha = 1.f;
        if (act) { qkt_rt(p0, p1, c, qr, bo); const int kb_ = KBASE(t); const bool ron_ = ROWON(t);
            if ((kb_ + 63 > qlo) || (kb_ <= qhi - (int)W) || !__all(ron_)) mask_tile(p0, p1, pos - kb_ - 4 * c.hi, W, ron_);
            const float pmax = rowmax32(p0, p1); float mn;
            if (__builtin_expect(__all((pmax - sm.m) <= THR), 1)) { mn = sm.m; }
            else { mn = fmaxf(sm.m, pmax); alpha = __builtin_amdgcn_exp2f((sm.m - mn) * LOG2E); sm.m = mn; }
            const float mnL = -mn * LOG2E;
#pragma unroll
            for (int r = 0; r < 16; ++r) { p0[r] = __builtin_amdgcn_exp2f(fmaf(p0[r], LOG2E, mnL)); p1[r] = fmaf(p1[r], LOG2E, mnL); } }
        ABAR();
        if (act) {
#pragma unroll
            for (int r = 0; r < 16; ++r) p1[r] = __builtin_amdgcn_exp2f(p1[r]);
            sm.l = sm.l * alpha + rowsum32(p0, p1);
            h16x8 pa0, pa1, pa2, pa3; pack_p(p0, p1, pa0, pa1, pa2, pa3);
            if (__any(alpha < 1.f)) { LAS float* al = c.wsc + 32; if (c.hi == 0) al[c.r32] = alpha; asm volatile("s_waitcnt lgkmcnt(0)" ::: "memory");
#pragma unroll
                for (int d_ = 0; d_ < 4; ++d_)
#pragma unroll
                    for (int r = 0; r < 16; ++r) o[d_][r] *= al[crow(r, c.hi)]; }
            SBAR(); pv_tile<0>(o, c.vb0 + bo, pa0, pa1, pa2, pa3);
        }
        if (t + 2 < NT) stage_write_rt(S, c, bo2, bo2);
        ABAR();
        bo = (bo == 2 * SHM_K) ? 0 : bo + SHM_K;
    }
    if (!lagw) ABAR();
    __syncthreads();
#undef ACT
#undef ROWON
#undef KBASE
}

__device__ __forceinline__ void mask_tile2(f32x16& p0, f32x16& p1, int dq, unsigned W, bool rowon) {
    const float NEG = -__builtin_inff();
    const int dqe = rowon ? dq : -1;
    if (W >= (1u << 30)) {
#pragma unroll
        for (int r = 0; r < 16; ++r) { const int c = (r & 3) + 8 * (r >> 2); if (c > dqe) p0[r] = NEG; if (c + 32 > dqe) p1[r] = NEG; }
    } else {
#pragma unroll
        for (int r = 0; r < 16; ++r) { const int c = (r & 3) + 8 * (r >> 2); if ((unsigned)(dqe - c) >= W) p0[r] = NEG; if ((unsigned)(dqe - c - 32) >= W) p1[r] = NEG; }
    }
}
__device__ __forceinline__ void pv_rt(f32x16* o, int vb, h16x8 pa0, h16x8 pa1, h16x8 pa2, h16x8 pa3) {
#define TRRD(dst, off) asm volatile("ds_read_b64_tr_b16 %0, %1 offset:%2" : "=&v"(dst) : "v"(vb), "i"(off) : "memory")
#define MKB(l, h) __builtin_bit_cast(h16x8, (s16x8){l[0], l[1], l[2], l[3], h[0], h[1], h[2], h[3]})
#define RD8(L0, H0, L1, H1, L2, H2, L3, H3, d0) do { constexpr int b_ = v_rd_off(d0, 0, 0); \
        TRRD(L0, b_); TRRD(H0, b_ + 2048); TRRD(L1, b_ + 4096); TRRD(H1, b_ + 6144); TRRD(L2, b_ + 8192); TRRD(H2, b_ + 10240); TRRD(L3, b_ + 12288); TRRD(H3, b_ + 14336); } while (0)
#define MM4(L0, H0, L1, H1, L2, H2, L3, H3, d0) do { \
        o[d0] = __builtin_amdgcn_mfma_f32_32x32x16_f16(pa0, MKB(L0, H0), o[d0], 0, 0, 0); o[d0] = __builtin_amdgcn_mfma_f32_32x32x16_f16(pa1, MKB(L1, H1), o[d0], 0, 0, 0); \
        o[d0] = __builtin_amdgcn_mfma_f32_32x32x16_f16(pa2, MKB(L2, H2), o[d0], 0, 0, 0); o[d0] = __builtin_amdgcn_mfma_f32_32x32x16_f16(pa3, MKB(L3, H3), o[d0], 0, 0, 0); } while (0)
    s16x4 al0, ah0, al1, ah1, al2, ah2, al3, ah3, bl0, bh0, bl1, bh1, bl2, bh2, bl3, bh3;
    RD8(al0, ah0, al1, ah1, al2, ah2, al3, ah3, 0);
    RD8(bl0, bh0, bl1, bh1, bl2, bh2, bl3, bh3, 1);
    asm volatile("s_waitcnt lgkmcnt(8)" ::: "memory"); SBAR();
    MM4(al0, ah0, al1, ah1, al2, ah2, al3, ah3, 0); SBAR();
    RD8(al0, ah0, al1, ah1, al2, ah2, al3, ah3, 2);
    asm volatile("s_waitcnt lgkmcnt(8)" ::: "memory"); SBAR();
    MM4(bl0, bh0, bl1, bh1, bl2, bh2, bl3, bh3, 1); SBAR();
    RD8(bl0, bh0, bl1, bh1, bl2, bh2, bl3, bh3, 3);
    asm volatile("s_waitcnt lgkmcnt(8)" ::: "memory"); SBAR();
    MM4(al0, ah0, al1, ah1, al2, ah2, al3, ah3, 2); SBAR();
    asm volatile("s_waitcnt lgkmcnt(0)" ::: "memory"); SBAR();
    MM4(bl0, bh0, bl1, bh1, bl2, bh2, bl3, bh3, 3);
#undef MM4
#undef RD8
#undef MKB
#undef TRRD
}
__device__ __forceinline__ void run_attn6(const Ctx& c, const h16x8* qr, f32x16* o, SM& sm, const h16* Kp, const h16* Vp, int rs,
                                          int j_lo, int j_hi, int pos, unsigned W, unsigned long long rowmask, int qlo, int qhi) {
    const int NT = j_hi - j_lo;
    Stage S;
#define KBASE(t) ((j_lo + (t)) * 64)
#define ROWON(t) (((rowmask >> (j_lo + (t))) & 1ull) != 0ull)
#define ACT(t) (__any(ROWON(t)) && KBASE(t) <= qhi && KBASE(t) + 63 >= qlo - (int)W + 1)
    stage_load(S, c, Kp, Vp, rs, KBASE(0)); stage_write_rt(S, c, 0, 0);
    __syncthreads();
    int bo = 0;
    for (int t = 0; t < NT; ++t) {
        if (t + 1 < NT) stage_load(S, c, Kp, Vp, rs, KBASE(t + 1));
        if (ACT(t)) {
            const bool ron_ = ROWON(t);
            f32x16 p0, p1; qkt_rt(p0, p1, c, qr, bo, ron_ ? 0.f : -__builtin_inff());
            { const int kb_ = KBASE(t);
              if ((kb_ + 63 > qlo) || (kb_ <= qhi - (int)W)) mask_tile2(p0, p1, pos - kb_ - 4 * c.hi, W, ron_); }
            const float pmax = rowmax32(p0, p1); float mn, alpha;
            if (__builtin_expect(__all((pmax - sm.m) <= THR), 1)) { mn = sm.m; alpha = 1.f; }
            else { mn = fmaxf(sm.m, pmax); alpha = __builtin_amdgcn_exp2f((sm.m - mn) * LOG2E); sm.m = mn; }
            const float mnL = -mn * LOG2E;
#pragma unroll
            for (int r = 0; r < 16; ++r) { p0[r] = __builtin_amdgcn_exp2f(fmaf(p0[r], LOG2E, mnL)); p1[r] = __builtin_amdgcn_exp2f(fmaf(p1[r], LOG2E, mnL)); }
            sm.l = sm.l * alpha + rowsum32(p0, p1);
            h16x8 pa0, pa1, pa2, pa3; pack_p(p0, p1, pa0, pa1, pa2, pa3);
            if (__any(alpha < 1.f)) { LAS float* al = c.wsc + 32; if (c.hi == 0) al[c.r32] = alpha; asm volatile("s_waitcnt lgkmcnt(0)" ::: "memory");
#pragma unroll
                for (int d_ = 0; d_ < 4; ++d_)
#pragma unroll
                    for (int r = 0; r < 16; ++r) o[d_][r] *= al[crow(r, c.hi)]; }
            SBAR(); pv_rt(o, c.vb0 + bo, pa0, pa1, pa2, pa3);
        }
        if (t + 1 < NT) stage_write_rt(S, c, bo ^ SHM_K, bo ^ SHM_V);
        __syncthreads();
        bo ^= SHM_K;
    }
#undef ACT
#undef ROWON
#undef KBASE
}


struct DmaOff { unsigned k0, k1, v0, v1; };
__device__ __forceinline__ DmaOff dma_offsets(const Ctx& c, int rs) {
    DmaOff d;
#pragma unroll
    for (int i = 0; i < 2; ++i) { const int o = (2 * c.wid + i) * 1024 + 16 * c.lane;
        const int row = o >> 8, phys = (o & 255) >> 4, logical = phys ^ (row & 7);
        const unsigned ko = (unsigned)(row * rs + logical * 8);
        const int st = o >> 9, kh = st >> 2, cq = st & 3, kk = kh * 8 + ((o & 511) >> 6), c8 = ((o & 63) >> 4) * 8;
        const int k = (kk & ~0xC) | ((kk & 4) << 1) | ((kk & 8) >> 1);
        const unsigned vo = (unsigned)(k * rs + cq * 32 + c8);
        if (i == 0) { d.k0 = ko; d.v0 = vo; } else { d.k1 = ko; d.v1 = vo; } }
    return d;
}
__device__ __forceinline__ void stage_dma(const Ctx& c, const DmaOff& d, const h16* Kp, const h16* Vp, int rs, int key0, int slot) {
    const h16* kb = Kp + (size_t)key0 * rs; const h16* vb = Vp + (size_t)key0 * rs;
    LAS char* kd = (LAS char*)c.K_lds + slot + c.wid * 2048; LAS char* vd = (LAS char*)c.V_lds + slot + c.wid * 2048;
    __builtin_amdgcn_global_load_lds((const unsigned*)(kb + d.k0), (LAS unsigned*)(kd), 16, 0, 0);
    __builtin_amdgcn_global_load_lds((const unsigned*)(kb + d.k1), (LAS unsigned*)(kd + 1024), 16, 0, 0);
    __builtin_amdgcn_global_load_lds((const unsigned*)(vb + d.v0), (LAS unsigned*)(vd), 16, 0, 0);
    __builtin_amdgcn_global_load_lds((const unsigned*)(vb + d.v1), (LAS unsigned*)(vd + 1024), 16, 0, 0);
}
typedef short v4i16_t __attribute__((ext_vector_type(4)));
__device__ __forceinline__ s16x4 vtr(const LAS char* p) { return __builtin_bit_cast(s16x4, __builtin_amdgcn_ds_read_tr16_b64_v4i16((LAS v4i16_t*)p)); }
__device__ __forceinline__ void run_attn9(const Ctx& c, const h16x8* qr, f32x16* o, SM& sm, const h16* Kp, const h16* Vp, int rs,
                                          int j_lo, int j_hi, int pos, unsigned W, unsigned long long rowmask, int qlo, int qhi) {
    const int NT = j_hi - j_lo;
    const DmaOff dmo = dma_offsets(c, rs);
    f32x16 X0, X1;
    u32x4 pwA0, pwA1, pwA2, pwA3, pwB0, pwB1, pwB2, pwB3;
    float l_reg = 0.f, m_reg = -1e30f;
#define KBASE(t) ((j_lo + (t)) * 64)
#define ROWON(t) (((rowmask >> (j_lo + (t))) & 1ull) != 0ull)
    const LAS char* kq[4];
#pragma unroll
    for (int dd = 0; dd < 4; ++dd) kq[dd] = c.K_lds + KSWZ(c.r32, (dd * 16 + c.hi * 8) * 2);
    const LAS char* vq = c.V_lds + v_rd_base(c.lane);
#define KFR(kbo, i) (*(const LAS h16x8*)(kq[((i) >> 1) & 3] + (kbo) + ((i) >> 3) * 128 + ((i) & 1) * 32 * 256))
#define VLO(vbo, j) vtr(vq + (vbo) + v_rd_off((j) >> 2, (j) & 3, 0))
#define VHI(vbo, j) vtr(vq + (vbo) + v_rd_off((j) >> 2, (j) & 3, 1))
#define MKB(l, h) __builtin_bit_cast(h16x8, (s16x8){l[0], l[1], l[2], l[3], h[0], h[1], h[2], h[3]})
    const f32x16 zero16 = {};
#define GA(i, kbo) do { \
        if ((i) & 1) X1 = __builtin_amdgcn_mfma_f32_32x32x16_f16(kf[(i) & 3], qr[(i) >> 1], (i) == 1 ? zero16 : X1, 0, 0, 0); \
        else X0 = __builtin_amdgcn_mfma_f32_32x32x16_f16(kf[(i) & 3], qr[(i) >> 1], (i) == 0 ? zero16 : X0, 0, 0, 0); \
        if ((i) + 4 < 16) kf[(i) & 3] = KFR(kbo, (i) + 4); \
        SBAR(); } while (0)
#define GB(j, HP, vbo, mnL_, PP0, PP1, PP2, PP3, PN0, PN1, PN2, PN3) do { \
        if (HP) { const u32x4 pwj_ = ((j) & 3) == 0 ? PP0 : ((j) & 3) == 1 ? PP1 : ((j) & 3) == 2 ? PP2 : PP3; \
            o[(j) >> 2] = __builtin_amdgcn_mfma_f32_32x32x16_f16(__builtin_bit_cast(h16x8, pwj_), MKB(vl[(j) & 3], vh[(j) & 3]), o[(j) >> 2], 0, 0, 0); \
            if ((j) + 4 < 16) { vl[(j) & 3] = VLO(vbo, (j) + 4); vh[(j) & 3] = VHI(vbo, (j) + 4); } } \
        { const float e0_ = __builtin_amdgcn_exp2f(fmaf((j) < 8 ? X0[(2 * (j)) & 15] : X1[(2 * (j)) & 15], LOG2E, mnL_)); \
          const float e1_ = __builtin_amdgcn_exp2f(fmaf((j) < 8 ? X0[(2 * (j) + 1) & 15] : X1[(2 * (j) + 1) & 15], LOG2E, mnL_)); \
          sacc += e0_; sacc += e1_; const unsigned cv_ = pk2h(e0_, e1_); \
          constexpr int jj_ = (j) >> 2, sub_ = (j) & 3; \
          if (sub_ == 0) ca0 = cv_; else if (sub_ == 1) ca1 = cv_; else if (sub_ == 2) cb0 = cv_; else { \
              auto r0_ = __builtin_amdgcn_permlane32_swap(ca0, cb0, false, false); auto r1_ = __builtin_amdgcn_permlane32_swap(ca1, cv_, false, false); \
              const u32x4 w_ = {r0_[0], r1_[0], r0_[1], r1_[1]}; if (jj_ == 0) PN0 = w_; else if (jj_ == 1) PN1 = w_; else if (jj_ == 2) PN2 = w_; else PN3 = w_; } } \
        SBAR(); } while (0)
#define STEP(t, HP, PP0, PP1, PP2, PP3, PN0, PN1, PN2, PN3) do { \
        const int kbo_ = bo, vbo_ = bop; \
        if ((t) + 1 < NT) stage_dma(c, dmo, Kp, Vp, rs, KBASE((t) + 1), bon); \
        h16x8 kf[4]; kf[0] = KFR(kbo_, 0); kf[1] = KFR(kbo_, 1); kf[2] = KFR(kbo_, 2); kf[3] = KFR(kbo_, 3); \
        SBAR(); \
        GA(0, kbo_); GA(1, kbo_); GA(2, kbo_); GA(3, kbo_); GA(4, kbo_); GA(5, kbo_); GA(6, kbo_); GA(7, kbo_); \
        GA(8, kbo_); GA(9, kbo_); GA(10, kbo_); GA(11, kbo_); GA(12, kbo_); GA(13, kbo_); GA(14, kbo_); GA(15, kbo_); \
        s16x4 vl[4], vh[4]; \
        if (HP) { vl[0] = VLO(vbo_, 0); vh[0] = VHI(vbo_, 0); vl[1] = VLO(vbo_, 1); vh[1] = VHI(vbo_, 1); vl[2] = VLO(vbo_, 2); vh[2] = VHI(vbo_, 2); vl[3] = VLO(vbo_, 3); vh[3] = VHI(vbo_, 3); } \
        const bool ron_ = ROWON(t); \
        { const int kb_ = KBASE(t); if ((kb_ + 63 > qlo) || (kb_ <= qhi - (int)W)) mask_tile2(X0, X1, pos - kb_ - 4 * c.hi, W, true); } \
        const float pmax_ = ron_ ? rowmax32(X0, X1) : -__builtin_inff(); float mn_, alpha; \
        if (__builtin_expect(__all((pmax_ - m_reg) <= THR), 1)) { mn_ = m_reg; alpha = 1.f; } \
        else { mn_ = fmaxf(m_reg, pmax_); alpha = __builtin_amdgcn_exp2f((m_reg - mn_) * LOG2E); m_reg = mn_; } \
        const float mnL_ = ron_ ? -mn_ * LOG2E : -__builtin_inff(); \
        float sacc = 0.f; unsigned ca0 = 0u, ca1 = 0u, cb0 = 0u; \
        SBAR(); \
        GB(0, HP, vbo_, mnL_, PP0, PP1, PP2, PP3, PN0, PN1, PN2, PN3); GB(1, HP, vbo_, mnL_, PP0, PP1, PP2, PP3, PN0, PN1, PN2, PN3); \
        GB(2, HP, vbo_, mnL_, PP0, PP1, PP2, PP3, PN0, PN1, PN2, PN3); GB(3, HP, vbo_, mnL_, PP0, PP1, PP2, PP3, PN0, PN1, PN2, PN3); \
        GB(4, HP, vbo_, mnL_, PP0, PP1, PP2, PP3, PN0, PN1, PN2, PN3); GB(5, HP, vbo_, mnL_, PP0, PP1, PP2, PP3, PN0, PN1, PN2, PN3); \
        GB(6, HP, vbo_, mnL_, PP0, PP1, PP2, PP3, PN0, PN1, PN2, PN3); GB(7, HP, vbo_, mnL_, PP0, PP1, PP2, PP3, PN0, PN1, PN2, PN3); \
        GB(8, HP, vbo_, mnL_, PP0, PP1, PP2, PP3, PN0, PN1, PN2, PN3); GB(9, HP, vbo_, mnL_, PP0, PP1, PP2, PP3, PN0, PN1, PN2, PN3); \
        GB(10, HP, vbo_, mnL_, PP0, PP1, PP2, PP3, PN0, PN1, PN2, PN3); GB(11, HP, vbo_, mnL_, PP0, PP1, PP2, PP3, PN0, PN1, PN2, PN3); \
        GB(12, HP, vbo_, mnL_, PP0, PP1, PP2, PP3, PN0, PN1, PN2, PN3); GB(13, HP, vbo_, mnL_, PP0, PP1, PP2, PP3, PN0, PN1, PN2, PN3); \
        GB(14, HP, vbo_, mnL_, PP0, PP1, PP2, PP3, PN0, PN1, PN2, PN3); GB(15, HP, vbo_, mnL_, PP0, PP1, PP2, PP3, PN0, PN1, PN2, PN3); \
        { auto rr_ = __builtin_amdgcn_permlane32_swap(__float_as_uint(sacc), __float_as_uint(sacc), false, false); l_reg = l_reg * alpha + (__uint_as_float(rr_[0]) + __uint_as_float(rr_[1])); } \
        if (__any(alpha < 1.f)) { LAS float* al = c.wsc + 32; if (c.hi == 0) al[c.r32] = alpha; asm volatile("s_waitcnt lgkmcnt(0)" ::: "memory"); \
            _Pragma("unroll") for (int d_ = 0; d_ < 4; ++d_) _Pragma("unroll") for (int r = 0; r < 16; ++r) o[d_][r] *= al[crow(r, c.hi)]; } \
        asm volatile("s_waitcnt vmcnt(0)" ::: "memory"); __syncthreads(); \
        bop = bo; bo = bon; bon = (bon == 2 * SHM_K) ? 0 : bon + SHM_K; } while (0)
    __syncthreads();
    stage_dma(c, dmo, Kp, Vp, rs, KBASE(0), 0);
    asm volatile("s_waitcnt vmcnt(0)" ::: "memory"); __syncthreads();
    int bo = 0, bop = 0, bon = SHM_K;
    STEP(0, 0, pwB0, pwB1, pwB2, pwB3, pwA0, pwA1, pwA2, pwA3);
    int t = 1;
    for (; t + 1 < NT; t += 2) { STEP(t, 1, pwA0, pwA1, pwA2, pwA3, pwB0, pwB1, pwB2, pwB3); STEP(t + 1, 1, pwB0, pwB1, pwB2, pwB3, pwA0, pwA1, pwA2, pwA3); }
    if (t < NT) { STEP(t, 1, pwA0, pwA1, pwA2, pwA3, pwB0, pwB1, pwB2, pwB3);
        SBAR(); pv_rt(o, c.vb0 + bop, __builtin_bit_cast(h16x8, pwB0), __builtin_bit_cast(h16x8, pwB1), __builtin_bit_cast(h16x8, pwB2), __builtin_bit_cast(h16x8, pwB3)); }
    else { SBAR(); pv_rt(o, c.vb0 + bop, __builtin_bit_cast(h16x8, pwA0), __builtin_bit_cast(h16x8, pwA1), __builtin_bit_cast(h16x8, pwA2), __builtin_bit_cast(h16x8, pwA3)); }
    sm.m = m_reg; sm.l = l_reg;
    __syncthreads();
#undef STEP
#undef GB
#undef GA
#undef MKB
#undef VHI
#undef VLO
#undef KFR
#undef ROWON
#undef KBASE
}
__device__ __forceinline__ void finish(const Ctx& c, f32x16* o, SM& sm, float gate) {
    LAS float* li = c.wsc;
    const float s = sm.l > 0.f ? gate / sm.l : 0.f;
    if (c.hi == 0) li[c.r32] = s;
    asm volatile("s_waitcnt lgkmcnt(0)" ::: "memory");
#pragma unroll
    for (int r = 0; r < 16; ++r) { const float sr_ = li[crow(r, c.hi)];
#pragma unroll
        for (int d0 = 0; d0 < 4; ++d0) o[d0][r] *= sr_; }
    asm volatile("s_waitcnt lgkmcnt(0)" ::: "memory");
    sm.m = -1e30f; sm.l = 0.f;
}
__device__ __forceinline__ void store_o(const Ctx& c, f32x16* o, h16* Ow  , int ldo, bool acc) {
    LAS h16* stg = (LAS h16*)(c.lds + c.wid * 8192);
#pragma unroll
    for (int r = 0; r < 16; ++r) { const int orow = crow(r, c.hi);
#pragma unroll
        for (int d0 = 0; d0 < 4; ++d0) { stg[orow * 128 + d0 * 32 + c.r32] = (h16)o[d0][r]; o[d0][r] = 0.f; } }
    asm volatile("s_waitcnt lgkmcnt(0)" ::: "memory");
    const int rq = c.lane >> 4, ch = c.lane & 15;
    u32x4 own[8];
#pragma unroll
    for (int it = 0; it < 8; ++it) own[it] = *(const LAS u32x4*)(stg + (it * 4 + rq) * 128 + ch * 8);
    if (acc) {
        u32x4 old[8];
        const h16* p0 = Ow + (size_t)rq * ldo + ch * 8;
#define LD16(k) "global_load_dwordx4 %" #k ", %8, off sc1\n\t"
        const h16* a0 = p0, * a1 = p0 + (size_t)4 * ldo, * a2 = p0 + (size_t)8 * ldo, * a3 = p0 + (size_t)12 * ldo, * a4 = p0 + (size_t)16 * ldo, * a5 = p0 + (size_t)20 * ldo, * a6 = p0 + (size_t)24 * ldo, * a7 = p0 + (size_t)28 * ldo;
        asm volatile("global_load_dwordx4 %0, %8, off sc1\n\tglobal_load_dwordx4 %1, %9, off sc1\n\tglobal_load_dwordx4 %2, %10, off sc1\n\tglobal_load_dwordx4 %3, %11, off sc1\n\t"
                     "global_load_dwordx4 %4, %12, off sc1\n\tglobal_load_dwordx4 %5, %13, off sc1\n\tglobal_load_dwordx4 %6, %14, off sc1\n\tglobal_load_dwordx4 %7, %15, off sc1\n\ts_waitcnt vmcnt(0)"
                     : "=&v"(old[0]), "=&v"(old[1]), "=&v"(old[2]), "=&v"(old[3]), "=&v"(old[4]), "=&v"(old[5]), "=&v"(old[6]), "=&v"(old[7])
                     : "v"(a0), "v"(a1), "v"(a2), "v"(a3), "v"(a4), "v"(a5), "v"(a6), "v"(a7) : "memory");
#undef LD16
#pragma unroll
        for (int it = 0; it < 8; ++it) {
#pragma unroll
            for (int e = 0; e < 4; ++e) { const unsigned wa = own[it][e], wb = old[it][e]; const h16x2 ha = __builtin_bit_cast(h16x2, wa), hb = __builtin_bit_cast(h16x2, wb);
                own[it][e] = pk2h((float)ha.x + (float)hb.x, (float)ha.y + (float)hb.y); } }
    }
#pragma unroll
    for (int it = 0; it < 8; ++it) *(u32x4*)(Ow + (size_t)(it * 4 + rq) * ldo + ch * 8) = own[it];
}

__device__ __forceinline__ void nsa_prepare(const Args& A, const Ctx& c, int b, int g, int ci, h16x8* qr, f32x16* o, unsigned long long& rowmask, h16* O) {
    const h16* QKV = (const h16*)(A.ws + WS_QKV); const float* G = (const float*)(A.ws + WS_GATE);
    const h16* KC = (const h16*)(A.ws + WS_KC) + ((size_t)((0 * 2 + b) * 2 + g) * 256) * 128;
    const h16* VC = (const h16*)(A.ws + WS_KC) + ((size_t)((1 * 2 + b) * 2 + g) * 256) * 128;
    const int hh = c.wid >> 1, head = g * 4 + hh, sub = (c.wid & 1) * 32, t0 = 64 * ci;
    const int qidx = sub + c.r32, t = t0 + qidx; const size_t tokrow = (size_t)(b * SEQ + t);
#pragma unroll
    for (int d0 = 0; d0 < 8; ++d0) qr[d0] = *(const h16x8*)(QKV + tokrow * NQKV + C_QN + head * 128 + d0 * 16 + c.hi * 8);
    const float g0 = G[tokrow * 24 + head * 3];
    LAS float* impH = (LAS float*)((hh < 2 ? c.K_lds : c.V_lds) + SHM_K * (1 + (hh & 1)));
#define IMPP(s_) impH[qidx * 64 + (((s_) + 2 * qidx) & 63)]
    LAS float* rlH = (LAS float*)(c.lds + L_IMP);
    LAS unsigned long long* selm = (LAS unsigned long long*)(c.lds + L_SEL);
    h16* Ow = O + (size_t)(b * SEQ + t0 + sub) * DM + head * 128;
    __syncthreads();
    { LAS f32x4* z = (LAS f32x4*)(impH + qidx * 64 + 32 * c.hi);
#pragma unroll
      for (int e = 0; e < 8; ++e) z[e] = (f32x4){0.f, 0.f, 0.f, 0.f}; }
    const int posc = (t - 31) >> 4;
    const int ntc = ((4 * ci + 2) >> 6) + 1;
    const unsigned WC = 1u << 30;
    float m = -1e30f, l = 0.f;
    Stage S; stage_load(S, c, KC, VC, 128, 0);
    for (int j = 0; j < ntc; ++j) {
        __syncthreads();
        stage_write<0>(S, c); __syncthreads();
        if (j + 1 < ntc) stage_load(S, c, KC, VC, 128, 64 * (j + 1));
        f32x16 p0, p1; qkt<0, false>(p0, p1, c, qr);
        mask_tile2(p0, p1, posc - 64 * j - 4 * c.hi, WC, true);
        const float pmax = rowmax32(p0, p1); const float mn = fmaxf(m, pmax); const float alpha = __builtin_amdgcn_exp2f((m - mn) * LOG2E); m = mn;
        if (__any(alpha < 1.f)) {
            LAS float* al = c.wsc + 32; if (c.hi == 0) al[c.r32] = alpha; asm volatile("s_waitcnt lgkmcnt(0)" ::: "memory");
#pragma unroll
            for (int d_ = 0; d_ < 4; ++d_)
#pragma unroll
                for (int r = 0; r < 16; ++r) o[d_][r] *= al[crow(r, c.hi)];
            for (int k = 0; k < 8 * j + 1; ++k) IMPP(2 * k + c.hi) *= alpha; }
        const float mL = -mn * LOG2E;
#pragma unroll
        for (int r = 0; r < 16; ++r) { p0[r] = __builtin_amdgcn_exp2f(fmaf(p0[r], LOG2E, mL)); p1[r] = __builtin_amdgcn_exp2f(fmaf(p1[r], LOG2E, mL)); }
        l = l * alpha + rowsum32(p0, p1);
        {
            const int sb = 16 * j + c.hi;
#pragma unroll
            for (int gq = 0; gq < 4; ++gq) { IMPP(sb + 2 * gq) += p0[4 * gq] + p0[4 * gq + 1] + p0[4 * gq + 2] + 0.5f * p0[4 * gq + 3];
                IMPP(sb + 8 + 2 * gq) += p1[4 * gq] + p1[4 * gq + 1] + p1[4 * gq + 2] + 0.5f * p1[4 * gq + 3]; }
            asm volatile("s_waitcnt lgkmcnt(0)" ::: "memory");
#pragma unroll
            for (int gq = 0; gq < 4; ++gq) { IMPP(sb + 2 * gq + 1) += 0.5f * p0[4 * gq + 3];
                if (sb + 8 + 2 * gq + 1 < 64) IMPP(sb + 8 + 2 * gq + 1) += 0.5f * p1[4 * gq + 3]; }
        }
        h16x8 pa0, pa1, pa2, pa3; pack_p(p0, p1, pa0, pa1, pa2, pa3);
        SBAR();
        pv_tile<0>(o, c.vb0, pa0, pa1, pa2, pa3);
    }
    {
        LAS float* li = c.wsc; const float rli = l > 0.f ? 1.f / l : 0.f;
        if (c.hi == 0) { li[c.r32] = rli * g0; rlH[hh * 64 + qidx] = rli; }
        asm volatile("s_waitcnt lgkmcnt(0)" ::: "memory");
#pragma unroll
        for (int r = 0; r < 16; ++r) { const float sr_ = li[crow(r, c.hi)];
#pragma unroll
            for (int d0 = 0; d0 < 4; ++d0) o[d0][r] *= sr_; }
    }
    __syncthreads();
    {
        const int s = c.lane;
        const LAS float* i0 = (const LAS float*)(c.K_lds + SHM_K), * i1 = (const LAS float*)(c.K_lds + 2 * SHM_K), * i2 = (const LAS float*)(c.V_lds + SHM_V), * i3 = (const LAS float*)(c.V_lds + 2 * SHM_V);
        for (int qq = 0; qq < 8; ++qq) { const int q = c.wid * 8 + qq; const int ps = q * 64 + ((s + 2 * q) & 63);
            const float my = ((i0[ps] * rlH[q] + i1[ps] * rlH[64 + q]) + i2[ps] * rlH[128 + q]) + i3[ps] * rlH[192 + q];
            const bool valid = (s >= 1 && s <= ci - 2);
            bool pick = valid;
            if (ci - 2 > 13) {
                const unsigned key = valid ? __float_as_uint(my) + 1u : 0u; unsigned T = 0u;
                for (int bit = 31; bit >= 0; --bit) { const unsigned trial = T | (1u << bit); if (__popcll(__ballot(key >= trial)) >= 13) T = trial; }
                const unsigned long long gt = __ballot(key > T), eq = __ballot(key == T);
                const int need = 13 - __popcll(gt); const int rk = __popcll(eq & ((1ull << s) - 1ull));
                pick = (key > T) || (key == T && rk < need);
            }
            const bool sel = (s == 0) || (s == ci) || (s == ci - 1) || pick;
            const unsigned long long bm = __ballot(sel && s <= ci);
            if (c.lane == 0) selm[q] = bm; }
        __syncthreads();
    }
    rowmask = selm[qidx];
#undef IMPP
    store_o(c, o, Ow, DM, false);
}
__device__ __forceinline__ void moba_prepare(const Args& A, const Ctx& c, int b, int h, int cj, h16x8* qr, unsigned long long& rowmask) {
    const h16* QKV = (const h16*)(A.ws + WS_QKV);
    const h16* KMT = (const h16*)(A.ws + WS_KMEAN) + (size_t)(b * 8 + h) * 32 * 128;
    const int wq0 = 256 * cj + 32 * c.wid, t = wq0 + c.r32; const size_t tokrow = (size_t)(b * SEQ + t);
#pragma unroll
    for (int d0 = 0; d0 < 8; ++d0) qr[d0] = *(const h16x8*)(QKV + tokrow * NQKV + C_QM + h * 128 + d0 * 16 + c.hi * 8);
    rowmask = 0xFull << (4 * cj);
    if (cj > 0) {
        __syncthreads();
        { const h16x8 kk = *(const h16x8*)(KMT + (size_t)c.sr * 128 + c.sc); *(LAS h16x8*)(c.K_lds + c.kws) = kk; }
        __syncthreads();
        f32x16 p0, p1; qkt<0, true>(p0, p1, c, qr);
        float S[16];
#pragma unroll
        for (int r = 0; r < 8; ++r) { auto rr = __builtin_amdgcn_permlane32_swap(__float_as_uint(p0[r]), __float_as_uint(p0[r]), false, false);
            const int n = (r & 3) + 8 * (r >> 2); S[n] = __uint_as_float(rr[0]); S[n + 4] = __uint_as_float(rr[1]); }
#pragma unroll
        for (int n = 0; n < 16; ++n) S[n] = (n < cj) ? S[n] : -__builtin_inff();
#pragma unroll
        for (int n = 0; n < 16; ++n) { int cnt = 0;
#pragma unroll
            for (int mm = 0; mm < 16; ++mm) { if (mm < n) cnt += (S[mm] >= S[n]) ? 1 : 0; else if (mm > n) cnt += (S[mm] > S[n]) ? 1 : 0; }
            const unsigned long long bits = (n < cj && cnt < 3) ? (0xFull << (4 * n)) : 0ull; rowmask |= bits; }
        __syncthreads();
    }
}
#undef SBAR
}


#if DIAG
constexpr int CW_DIAG = 96;
#ifndef DIAG_FIELD
#define DIAG_FIELD 4
#endif
__device__ __forceinline__ void diag_max(unsigned* ctl, float v, int lane, unsigned payload = 0u) { if (lane == 0 && fabsf(v) > 2.0f) atomicAdd(ctl + CW_DIAG + 4, 1u); if (lane == 0) atomicMax((unsigned long long*)(ctl + CW_DIAG), ((unsigned long long)__float_as_uint(fabsf(v)) << 32) | payload); }
__device__ __forceinline__ float diag_dot_h(const h16* a, const float* W, int ldw, int col, int K, int lane) {
    float s = 0.f; for (int k = lane; k < K; k += 64) s += (float)a[k] * W[(size_t)k * ldw + col]; return wave_sum(s); }
__device__ __forceinline__ unsigned diag_hash(unsigned x) { x ^= x >> 16; x *= 0x7feb352du; x ^= x >> 15; x *= 0x846ca68bu; x ^= x >> 16; return x; }
__device__ __forceinline__ void diag_qkv(const Args& A, unsigned* ctl, int gw, int NGW, int lane) {
    const h16* H = (const h16*)(A.ws + WS_H); const h16* QKV = (const h16*)(A.ws + WS_QKV); const float* G = (const float*)(A.ws + WS_GATE);
    const float* COS = (const float*)(A.ws + WS_COS); const float* SIN = (const float*)(A.ws + WS_SIN); const float* W = A.in[6];
    for (int sidx = gw; sidx < 8192; sidx += NGW) {
        const unsigned hsh = diag_hash(sidx * 2 + 1); const int row = hsh % M; const int cs = (hsh >> 13) % INCOLS; const int t = row & (SEQ - 1);
        const h16* hr = H + (size_t)row * DM;
        if (cs >= 2560 && cs < 2584) { const float raw = diag_dot_h(hr, W, INCOLS, cs, DM, lane); diag_max(ctl, G[(size_t)row * 24 + cs - 2560] - 1.f / (1.f + expf(-raw)), lane); continue; }
        const int n = cs < 2560 ? cs : cs - 24; const int pn = n >> 8; const int add = cs < 2560 ? 0 : 24;
        const float got = (float)QKV[(size_t)row * NQKV + n];
        float want;
        if (pg8::is_rope_tile(pn)) { const int d = n & 127, hb = n & ~127; const float rd = diag_dot_h(hr, W, INCOLS, cs, DM, lane), rp = diag_dot_h(hr, W, INCOLS, hb + (d ^ 64) + add, DM, lane);
            const int i = d & 63; const float c = COS[t * 64 + i], s_ = SIN[t * 64 + i];
            want = d < 64 ? rd * c - rp * s_ : rd * c + rp * s_; if (pg8::is_q_tile(pn)) want *= QSCALE; }
        else want = diag_dot_h(hr, W, INCOLS, cs, DM, lane);
        diag_max(ctl, got - want, lane);
    }
}
__device__ __forceinline__ void diag_kc(const Args& A, unsigned* ctl, int gw, int NGW, int lane) {
    const h16* QKV = (const h16*)(A.ws + WS_QKV); const h16* KC = (const h16*)(A.ws + WS_KC);
    for (int sidx = gw; sidx < 256; sidx += NGW) {
        const unsigned hsh = diag_hash(sidx * 2 + 77); const int kv = hsh & 1, b = (hsh >> 1) & 1, g = (hsh >> 2) & 1, n = (hsh >> 3) % 255, c = (hsh >> 12) & 127;
        const float* pos = A.in[kv ? 10 : 7]; const float* w1 = A.in[kv ? 11 : 8]; const float* w2 = A.in[kv ? 12 : 9];
        const int colbase = (kv ? C_VCMP : C_KCMP) + g * 128;
        float h0 = 0.f, h1 = 0.f;
        for (int k = 0; k < 4096; ++k) { const int l = k >> 7, d = k & 127; const float a = (float)QKV[(size_t)(b * SEQ + 16 * n + l) * NQKV + colbase + d] + pos[k];
            h0 += a * w1[(size_t)k * 128 + lane]; h1 += a * w1[(size_t)k * 128 + 64 + lane]; }
        h0 = h0 / (1.f + expf(-h0)); h1 = h1 / (1.f + expf(-h1));
        const float want = wave_sum(h0 * w2[lane * 128 + c] + h1 * w2[(64 + lane) * 128 + c]);
        const float got = (float)KC[((size_t)((kv * 2 + b) * 2 + g) * 256 + n) * 128 + c];
        diag_max(ctl, (got - want) * 2.f, lane);
    }
}
template <int MODE  >
__device__ __forceinline__ void diag_gemm(unsigned* ctl, const h16* Abuf, int K, const float* W, int N, const void* Cbuf, float scale, int gw, int NGW, int lane, unsigned salt) {
    for (int sidx = gw; sidx < 8192; sidx += NGW) {
        const unsigned hsh = diag_hash(sidx * 2 + salt); const int row = hsh % M; const int col = (hsh >> 13) % N;
        float want = diag_dot_h(Abuf + (size_t)row * K, W, N, col, K, lane); float got;
        if (MODE == 1) { want = fmaxf(want, 0.f); want *= want; got = (float)((const h16*)Cbuf)[(size_t)row * N + col]; } else got = ((const float*)Cbuf)[(size_t)row * N + col];
        diag_max(ctl, (got - want) * scale, lane);
    }
}

#ifndef DIAG_TMAX
#define DIAG_TMAX 4096
#endif
#ifndef DIAG_TMIN
#define DIAG_TMIN 0
#endif

__device__ __forceinline__ void diag_kmean(const Args& A, unsigned* ctl, int gw, int NGW, int lane) {
    const h16* QKV = (const h16*)(A.ws + WS_QKV); const h16* KM = (const h16*)(A.ws + WS_KMEAN);
    for (int sidx = gw; sidx < 256; sidx += NGW) {
        const int b = sidx >> 7, h = (sidx >> 4) & 7, nb = sidx & 15;
        const h16* Kh = QKV + (size_t)(b * SEQ) * NQKV + C_KM + h * 128;
        float m0 = 0.f, m1 = 0.f; for (int j = 0; j < 256; ++j) { const h16* kr = Kh + (size_t)(nb * 256 + j) * NQKV; m0 += (float)kr[lane]; m1 += (float)kr[64 + lane]; }
        const h16* kp = KM + ((size_t)(b * 8 + h) * 32 + nb) * 128;
        float d = fmaxf(fabsf((float)kp[lane] - m0 * (1.f / 256.f)), fabsf((float)kp[64 + lane] - m1 * (1.f / 256.f)));
#pragma unroll
        for (int o_ = 1; o_ < 64; o_ <<= 1) d = fmaxf(d, __shfl_xor(d, o_));
        diag_max(ctl, d * 100.f, lane, ((unsigned)nb << 8) | (b << 7) | (h << 4));
    }
}
struct OnlineSM { float m, Z, a0, a1; };
__device__ __forceinline__ void osm_key(OnlineSM& st, float qa, float qb, const h16* Krow, const h16* Vrow, int lane) {
    const float sc = wave_sum(qa * (float)Krow[lane] + qb * (float)Krow[64 + lane]);
    const float mn = fmaxf(st.m, sc), corr = expf(st.m - mn), w = expf(sc - mn);
    st.Z = st.Z * corr + w; st.a0 = st.a0 * corr + w * (float)Vrow[lane]; st.a1 = st.a1 * corr + w * (float)Vrow[64 + lane]; st.m = mn;
}
__device__ __forceinline__ void diag_nsa(const Args& A, unsigned* ctl, LAS unsigned char* lds, int gw, int NGW, int wave, int lane) {
    const h16* QKV = (const h16*)(A.ws + WS_QKV); const float* G = (const float*)(A.ws + WS_GATE); const h16* O = (const h16*)(A.ws + WS_O);
    LAS float* pl = (LAS float*)(lds + wave * 4096);
    LAS float* impl = pl + 256;
    for (int sidx = gw; sidx < 16384; sidx += NGW) {
        const unsigned hsh = diag_hash(sidx * 2 + 101); const int b = hsh & 1, g = (hsh >> 1) & 1, hh = (hsh >> 2) & 3;
        int t = DIAG_TMIN + (int)((hsh >> 4) % (unsigned)(DIAG_TMAX - DIAG_TMIN)); if (sidx < 256) t = DIAG_TMIN + (sidx % (DIAG_TMAX - DIAG_TMIN));
        const int cb = t >> 6; const int nvis = t >= 31 ? ((t - 31) >> 4) + 1 : 0;
        const h16* KC = (const h16*)(A.ws + WS_KC) + ((size_t)((0 * 2 + b) * 2 + g) * 256) * 128;
        const h16* VC = (const h16*)(A.ws + WS_KC) + ((size_t)((1 * 2 + b) * 2 + g) * 256) * 128;
        const size_t tokrow = (size_t)(b * SEQ + t);
        if (lane < 64) impl[lane] = 0.f;
        float oc0 = 0.f, oc1 = 0.f, myqa = 0.f, myqb = 0.f;
        for (int h4 = 0; h4 < 4; ++h4) {
            const h16* qp = QKV + tokrow * NQKV + C_QN + (g * 4 + h4) * 128; const float qa = (float)qp[lane], qb = (float)qp[64 + lane];
            if (h4 == hh) { myqa = qa; myqb = qb; }
            float mx = -__builtin_inff();
            for (int n = 0; n < nvis; ++n) { const float sc = wave_sum(qa * (float)KC[n * 128 + lane] + qb * (float)KC[n * 128 + 64 + lane]); if (lane == 0) pl[n] = sc; mx = fmaxf(mx, sc); }
            float Z = 0.f; for (int n = 0; n < nvis; ++n) Z += expf(pl[n] - mx);
            for (int n = lane; n < 256; n += 64) pl[n] = n < nvis ? expf(pl[n] - mx) / Z : 0.f;
            { const int s_ = lane; float v = pl[4 * s_] + pl[4 * s_ + 1] + pl[4 * s_ + 2] + 0.5f * pl[4 * s_ + 3] + (s_ > 0 ? 0.5f * pl[4 * s_ - 1] : 0.f); impl[s_] += v; }
            if (h4 == hh) for (int n = 0; n < nvis; ++n) { const float p = pl[n]; oc0 += p * (float)VC[n * 128 + lane]; oc1 += p * (float)VC[n * 128 + 64 + lane]; }
        }
        const int s_ = lane; const bool causal = s_ <= cb, forced = (s_ == 0) || (s_ == cb) || (s_ == cb - 1);
        const float key = causal ? (forced ? __builtin_inff() : impl[s_]) : -__builtin_inff();
        int rank = 0; for (int j = 0; j < 64; ++j) { const float kj = __shfl(key, j); rank += (kj > key || (kj == key && j < s_)) ? 1 : 0; }
        const unsigned long long selmask = __ballot(rank < 16 && causal);
        OnlineSM ss; ss.m = -__builtin_inff(); ss.Z = 0.f; ss.a0 = 0.f; ss.a1 = 0.f;
        const h16* Ks = QKV + (size_t)(b * SEQ) * NQKV + C_KSEL + g * 128; const h16* Vs = QKV + (size_t)(b * SEQ) * NQKV + C_VSEL + g * 128;
        for (int blk = 0; blk <= cb; ++blk) if ((selmask >> blk) & 1ull) for (int l = 0; l < 64; ++l) { const int kp = 64 * blk + l; if (kp <= t) osm_key(ss, myqa, myqb, Ks + (size_t)kp * NQKV, Vs + (size_t)kp * NQKV, lane); }
        OnlineSM sw; sw.m = -__builtin_inff(); sw.Z = 0.f; sw.a0 = 0.f; sw.a1 = 0.f;
        const h16* Kw = QKV + (size_t)(b * SEQ) * NQKV + C_KWIN + g * 128; const h16* Vw = QKV + (size_t)(b * SEQ) * NQKV + C_VWIN + g * 128;
        for (int kp = (t - 511 > 0 ? t - 511 : 0); kp <= t; ++kp) osm_key(sw, myqa, myqb, Kw + (size_t)kp * NQKV, Vw + (size_t)kp * NQKV, lane);
        const float* gp = G + tokrow * 24 + (g * 4 + hh) * 3;
        const float w0 = gp[0] * oc0 + gp[1] * ss.a0 / ss.Z + gp[2] * sw.a0 / sw.Z, w1 = gp[0] * oc1 + gp[1] * ss.a1 / ss.Z + gp[2] * sw.a1 / sw.Z;
        const h16* op = O + tokrow * DM + (g * 4 + hh) * 128;
        float d = fmaxf(fabsf((float)op[lane] - w0), fabsf((float)op[64 + lane] - w1));
#pragma unroll
        for (int o_ = 1; o_ < 64; o_ <<= 1) d = fmaxf(d, __shfl_xor(d, o_));
        diag_max(ctl, d * 10.f, lane, ((unsigned)t << 8) | (b << 7) | (g << 6) | (hh << 4));
    }
}
__device__ __forceinline__ void diag_moba(const Args& A, unsigned* ctl, int gw, int NGW, int lane) {
    const h16* QKV = (const h16*)(A.ws + WS_QKV); const h16* O = (const h16*)(A.ws + WS_O);
    for (int sidx = gw; sidx < 2048; sidx += NGW) {
        const unsigned hsh = diag_hash(sidx * 2 + 203); const int b = hsh & 1, h = (hsh >> 1) & 7;
        int t = DIAG_TMIN + (int)((hsh >> 4) % (unsigned)(DIAG_TMAX - DIAG_TMIN)); if (sidx < 256) t = DIAG_TMIN + ((sidx * 37) % (DIAG_TMAX - DIAG_TMIN));
        const int cur = t >> 8; const size_t tokrow = (size_t)(b * SEQ + t);
        const h16* qp = QKV + tokrow * NQKV + C_QM + h * 128; const float qa = (float)qp[lane], qb = (float)qp[64 + lane];
        const h16* Kh = QKV + (size_t)(b * SEQ) * NQKV + C_KM + h * 128; const h16* Vh = QKV + (size_t)(b * SEQ) * NQKV + C_VM + h * 128;
        float key = -__builtin_inff();
        for (int n = 0; n < cur; ++n) { float m0 = 0.f, m1 = 0.f; for (int j = 0; j < 256; ++j) { const h16* kr = Kh + (size_t)(n * 256 + j) * NQKV; m0 += (float)kr[lane]; m1 += (float)kr[64 + lane]; }
            const float sc = wave_sum(qa * (m0 * (1.f / 256.f)) + qb * (m1 * (1.f / 256.f))); if (lane == n) key = sc; }
        int rank = 0; for (int j = 0; j < 16; ++j) { const float kj = __shfl(key, j); rank += (kj > key || (kj == key && j < lane)) ? 1 : 0; }
        const unsigned long long selmask = __ballot(lane < cur && rank < 3);
        if (DIAG_SELCMP) { const unsigned long long km = ((const unsigned long long*)(A.ws + 329 * MiB))[(size_t)(b * 8 + h) * SEQ + t];
            unsigned long long want = 0xFull << (4 * cur); for (int n = 0; n < cur; ++n) if ((selmask >> n) & 1ull) want |= 0xFull << (4 * n);
            diag_max(ctl, km == want ? 0.f : 10.f, lane, ((unsigned)t << 8) | (b << 7) | (h << 4)); continue; }
        OnlineSM ss; ss.m = -__builtin_inff(); ss.Z = 0.f; ss.a0 = 0.f; ss.a1 = 0.f;
        for (int n = 0; n < cur; ++n) if ((selmask >> n) & 1ull) for (int j = 0; j < 256; ++j) { const int kp = n * 256 + j; osm_key(ss, qa, qb, Kh + (size_t)kp * NQKV, Vh + (size_t)kp * NQKV, lane); }
        for (int kp = cur * 256; kp <= t; ++kp) osm_key(ss, qa, qb, Kh + (size_t)kp * NQKV, Vh + (size_t)kp * NQKV, lane);
        const h16* op = O + tokrow * DM + 1024 + h * 128;
        float d = fmaxf(fabsf((float)op[lane] - ss.a0 / ss.Z), fabsf((float)op[64 + lane] - ss.a1 / ss.Z));
#pragma unroll
        for (int o_ = 1; o_ < 64; o_ <<= 1) d = fmaxf(d, __shfl_xor(d, o_));
        diag_max(ctl, d * 10.f, lane, ((unsigned)t << 8) | (b << 7) | (h << 4));
    }
}
#endif

__device__ __forceinline__ void run_t_item(const float* c_in, const float* w_ada, const float* b_ada, const float* w_dn, const float* w_up, const float* w_o, unsigned char* ws, LAS unsigned char* L, unsigned t) {
    int tl = threadIdx.x; asm volatile("" : "+v"(tl));
    const int ln = tl & 63, wv = __builtin_amdgcn_readfirstlane(tl >> 6), q16 = ln & 15;
    if (t < (unsigned)NT_GV) { const int r_ = (int)t * 8 + wv; gemv_half(c_in, w_ada, b_ada, (float*)(ws + WS_MOD), 16 + (r_ & 31), r_ >> 5, ln); return; }
    t -= (unsigned)NT_GV;
    LAS float* scr = (LAS float*)(L + wv * 16640);
    int r = (int)t * 8 + wv; const float* W; int ldw, K, sh; h16* WT;
    if (r < 2048) { W = w_dn; ldw = DM; K = DFF; WT = (h16*)(ws + WS_WDN); sh = 5; }
    else if (r < 4096) { r -= 2048; W = w_up; ldw = DFF; K = DM; WT = (h16*)(ws + WS_WUP); sh = 7; }
    else { r -= 4096; W = w_o; ldw = DM; K = DM; WT = (h16*)(ws + WS_WO); sh = 5; }
    const int kb = r >> sh, nb = r & ((1 << sh) - 1);
    transpose_item128<true>(W, ldw, K, WT, 128 * kb, 64 * nb, 64 * nb + 4 * q16, 4 * q16, scr, ln);
}

__global__ void __launch_bounds__(NWAVES * 64, 2) hymba_fwd(Args args) {
    extern __shared__ __attribute__((aligned(16))) unsigned char lds[];
    LAS unsigned char* L = (LAS unsigned char*)lds;
    volatile LAS unsigned* LCTL = (volatile LAS unsigned*)(L + LDSCTL_OFF);
    const int tid = threadIdx.x, lane = tid & 63, wave = __builtin_amdgcn_readfirstlane(tid >> 6);
    const int G = gridDim.x; const int bx = blockIdx.x; const int vcu = (G % 8 == 0) ? (bx % 8) * (G / 8) + bx / 8 : bx;
    const int NGW = G * NWAVES; (void)lane; (void)wave;
    unsigned* ctl = (unsigned*)(args.ws + WS_CTL);
    for (int u = tid; u < (LDS_BYTES - LDSCTL_OFF) / 4; u += NWAVES * 64) ((LAS unsigned*)(L + LDSCTL_OFF))[u] = 0u;
    __syncthreads();
    XcdBarrier bar; bar.bar = ctl + CW_BAR; bar.x = 0; bar.st = nullptr;
    if (MK_N_LAUNCHES == 1) bar = xcd_barrier_post(ctl + CW_BAR, LCTL);
    const int lo = args.ph_lo, hi = args.ph_hi;
#ifndef PH_MASK
#define PH_MASK 0x3ff
#endif
#define IN(k) (((PH_MASK >> (k)) & 1) && lo <= (k) && (k) < hi)
#define SEAM(k) do { if (IN(k) && IN((k) + 1)) xcd_barrier(bar); } while (0)
#define NREP(k) ((REPEAT_PH == (k)) ? 2 : 1)
#define FRESH() int tid_ = threadIdx.x; asm volatile("" : "+v"(tid_)); const int lane_ = tid_ & 63, wave_ = __builtin_amdgcn_readfirstlane(tid_ >> 6); const int gw_ = vcu * NWAVES + wave_; (void)lane_; (void)gw_

    if (IN(0)) { FRESH(); for (int rep = 0; rep < NREP(0); ++rep) p0_prologue(args, L, gw_, NGW, wave_, lane_, rep); }
    SEAM(0);
    if (IN(1)) { FRESH(); for (int rep = 0; rep < NREP(1); ++rep) p1_rows(args, gw_, NGW, lane_); }
    SEAM(1);
    if (IN(2)) {
        pg8::Gemm g{(const h16*)(args.ws + WS_H), (const h16*)(args.ws + WS_WIN), M, NPAD, DM}; pg8::StaticOrder S; S.init(M, NPAD, G, bx, WGM_P2);
        pg8::EpiQKV E{(h16*)(args.ws + WS_QKV), (float*)(args.ws + WS_GATE), (const float*)(args.ws + WS_COS), (const float*)(args.ws + WS_SIN)};
        for (int rep = 0; rep < NREP(2); ++rep) pg8::gemm_phase<pg8::EpiQKV, pg8::StaticOrder, true, true>(L, g, S, E);
        if (T_IN_P4 && T_P2_ITEMS > 0 && IN(4) && (S.nwg % G) != 0 && bx >= (S.nwg % G)) { FRESH();
#pragma unroll 1
            for (int k = 0; k < T_P2_ITEMS; ++k) { __syncthreads(); if (tid_ == 0) LCTL[2] = __hip_atomic_fetch_add(ctl + CW_QUEUE + 8, 1u, __ATOMIC_RELAXED, __HIP_MEMORY_SCOPE_AGENT); __syncthreads();
                const unsigned t = (unsigned)__builtin_amdgcn_readfirstlane((int)LCTL[2]); if (t >= (unsigned)NT_ITEMS) break; run_t_item(args.in[1], args.in[2], args.in[3], args.in[17], args.in[16], args.in[13], args.ws, L, t); } }
    }
    SEAM(2);
#if DIAG
    if (DIAG & 1) { FRESH(); diag_qkv(args, ctl, gw_, NGW, lane_); }
#endif
    if (IN(3)) {
        FRESH();
        for (int rep = 0; rep < NREP(3); ++rep)
        if (P3_SPLITK && G == 256 && NREP(3) == 1) { p3_compress_splitk(args, L, ctl, bx, wave_, lane_); if ((bx & 7) >= 4) p3_kmean_item(args, L, (bx >> 3) * 4 + (bx & 7) - 4, wave_, lane_, ctl); }
        else
        for (int it = bx; it < 256; it += G) { if (it < 128) p3_compress_item(args, L, it, wave_, lane_); else p3_kmean_item(args, L, it - 128, wave_, lane_); }
    }
    const bool p34 = P34_HANDOFF && P3_SPLITK && G == 256 && IN(3) && IN(4) && NREP(3) == 1 && NREP(4) == 1;
    if (!p34) SEAM(3);
#if DIAG
    if (DIAG & 2) { FRESH(); diag_kc(args, ctl, gw_, NGW, lane_); }
#endif
    if (IN(4)) {
        FRESH();
#ifndef Q_DED
#define Q_DED 16
#endif
#ifndef Q_RES
#define Q_RES 200
#endif
#define Q_FETCH(qv) do { __syncthreads(); if (tid_ == 0) { unsigned mode = LCTL[3], item = 0xffffu; \
            if (mode == 0u) { const unsigned t = __hip_atomic_fetch_add(ctl + CW_QUEUE + 8 + rep4, 1u, __ATOMIC_RELAXED, __HIP_MEMORY_SCOPE_AGENT); if (t + Q_RES + 1 >= (unsigned)NT_ITEMS) mode = 1u; if (t < (unsigned)NT_ITEMS) item = 0x4000u | t; } \
            if (item == 0xffffu && mode == 1u) { const unsigned a_ = __hip_atomic_fetch_add(ctl + CW_QUEUE + rep4, 1u, __ATOMIC_RELAXED, __HIP_MEMORY_SCOPE_AGENT); if (a_ < 512u) item = args.order[a_]; else mode = 2u; } \
            if (item == 0xffffu && mode == 2u) { const unsigned t = __hip_atomic_fetch_add(ctl + CW_QUEUE + 8 + rep4, 1u, __ATOMIC_RELAXED, __HIP_MEMORY_SCOPE_AGENT); if (t < (unsigned)NT_ITEMS) item = 0x4000u | t; } \
            LCTL[3] = mode; LCTL[2] = item; } __syncthreads(); qv = (unsigned)__builtin_amdgcn_readfirstlane((int)LCTL[2]); } while (0)
        const h16* QKVp = (const h16*)(args.ws + WS_QKV);
        for (int rep4 = 0; rep4 < NREP(4); ++rep4) {
        if (rep4) xcd_barrier(bar);
        if (tid_ == 0) LCTL[3] = (T_IN_P4 && bx < Q_DED) ? 0u : 1u;
        for (;;) {
            unsigned v; Q_FETCH(v);
            if (v == 0xffffu) break;
            if (T_IN_P4 && (v & 0x4000u)) { run_t_item(args.in[1], args.in[2], args.in[3], args.in[17], args.in[16], args.in[13], args.ws, L, v & 0x3fffu); continue; }
#define MAKE_CTX(cn) int tl_##cn = threadIdx.x; asm volatile("" : "+v"(tl_##cn)); \
            att::Ctx cn; cn.tid = tl_##cn; cn.wid = __builtin_amdgcn_readfirstlane(tl_##cn >> 6); cn.lane = tl_##cn & 63; cn.r32 = cn.lane & 31; cn.hi = cn.lane >> 5; cn.sr = tl_##cn >> 4; cn.sc = (tl_##cn & 15) * 8; \
            cn.kws = KSWZ(cn.sr, cn.sc * 2); cn.vst0 = att::v_st(cn.sr, cn.sc); cn.vst1 = att::v_st(32 + cn.sr, cn.sc); \
            cn.lds = (LAS char*)L; cn.V_lds = cn.lds + att::L_V; cn.K_lds = cn.lds + att::L_K; cn.wsc = (LAS float*)(cn.lds + att::L_WS) + cn.wid * 64; \
            cn.vb0 = (int)(unsigned)(uintptr_t)cn.V_lds + att::v_rd_base(cn.lane)
            MAKE_CTX(c0);
            const bool moba = (v & 0x8000u) != 0u; const int b = (v >> 7) & 1;
            h16x8 qr[8]; f32x16 o[4] = {}; unsigned long long rowmask;
            if (p34 && tid_ == 0) { const int slot = moba ? 4 + b * 4 + (int)((v >> 5) & 3) : b * 2 + (int)((v >> 6) & 1); const unsigned bit = 1u << slot, want = moba ? 16u : 32u;
                if (!(LCTL[5] & bit)) { unsigned sp = 0u; while (__hip_atomic_load(ctl + CW_P34 + 64 * slot, __ATOMIC_RELAXED, __HIP_MEMORY_SCOPE_AGENT) < want) { __builtin_amdgcn_s_sleep(1); if (++sp > (1u << 22)) break; }
                    __builtin_amdgcn_fence(__ATOMIC_ACQUIRE, "agent"); LCTL[5] |= bit; } }
            if (moba) att::moba_prepare(args, c0, b, (v >> 4) & 7, v & 15, qr, rowmask);
            else att::nsa_prepare(args, c0, b, (v >> 6) & 1, v & 63, qr, o, rowmask, (h16*)(args.ws + WS_O));
            const int nbr = moba ? 1 : 2;
#pragma unroll 1
            for (int br = 0; br < nbr; ++br) {
                MAKE_CTX(c);
                int koff, voff, j_lo, j_hi, wq0, ocol; unsigned W; unsigned long long rm;
                if (moba) { const int h = (v >> 4) & 7, cj = v & 15; koff = C_KM + h * 128; voff = C_VM + h * 128; j_lo = 0; j_hi = 4 * cj + 4; W = 1u << 30; rm = rowmask; wq0 = 256 * cj + 32 * c.wid; ocol = 1024 + h * 128; }
                else { const int g = (v >> 6) & 1, ci = v & 63; wq0 = 64 * ci + (c.wid & 1) * 32; ocol = (g * 4 + (c.wid >> 1)) * 128; j_hi = ci + 1;
                    if (br == 0) { koff = C_KSEL + g * 128; voff = C_VSEL + g * 128; j_lo = 0; W = 1u << 30; rm = rowmask; }
                    else { koff = C_KWIN + g * 128; voff = C_VWIN + g * 128; j_lo = ci - 8 < 0 ? 0 : ci - 8; W = 512u; rm = ~0ull; } }
                const h16* Kp_ = QKVp + (size_t)(b * SEQ) * NQKV + koff; const h16* Vp_ = QKVp + (size_t)(b * SEQ) * NQKV + voff;
                h16* Ow_ = (h16*)(args.ws + WS_O) + (size_t)(b * SEQ + wq0) * DM + ocol;
                const float gate = moba ? 1.f : ((const float*)(args.ws + WS_GATE))[(size_t)(b * SEQ + wq0 + c.r32) * 24 + (ocol >> 7) * 3 + 1 + br];
                { att::SM sm; sm.m = -1e30f; sm.l = 0.f;
                att::run_attn9(c, qr, o, sm, Kp_, Vp_, NQKV, j_lo, j_hi, wq0 + c.r32, W, rm, wq0, wq0 + 31);
                att::finish(c, o, sm, gate); att::store_o(c, o, Ow_, DM, !moba); }
            }
        }
        }
#undef Q_FETCH
    }
    SEAM(4);
#if DIAG
    if (DIAG & 32) { FRESH(); diag_nsa(args, ctl, L, gw_, NGW, wave_, lane_); }
    if (DIAG & 64) { FRESH(); diag_moba(args, ctl, gw_, NGW, lane_); }
    if (DIAG & 128) { FRESH(); diag_kmean(args, ctl, gw_, NGW, lane_); }
#endif
    const bool fuse6 = FUSE_P6 && G == (M / 256) * (DM / 256) && IN(5) && IN(6);
    if (IN(5)) {
        pg8::Gemm g{(const h16*)(args.ws + WS_O), (const h16*)(args.ws + WS_WO), M, DM, DM}; pg8::StaticOrder S; S.init(M, DM, G, bx);
        if (fuse6) { pg8::EpiNormResNorm E{args.in[0], (h16*)(args.ws + WS_X1), (h16*)(args.ws + WS_H), (float*)(args.ws + WS_SSQ + 1 * MiB), (float*)(args.ws + WS_SSQ + 1 * MiB + 512 * 1024),
                                           ctl + CW_XCH + 2048, ctl + CW_XCH + 4096, args.in[5], args.in[14], (const float*)(args.ws + WS_MOD)};
            pg8::gemm_phase<pg8::EpiNormResNorm, pg8::StaticOrder, true, true>(L, g, S, E); }
        else { pg8::EpiF16SS E{(h16*)(args.ws + WS_OP), DM, (float*)(args.ws + WS_SSQ)};
        for (int rep = 0; rep < NREP(5); ++rep) pg8::gemm_phase<pg8::EpiF16SS, pg8::StaticOrder, true, true>(L, g, S, E); }
    }
    if (!fuse6) SEAM(5);
#if DIAG
    if (DIAG & 4) { FRESH(); diag_gemm<0>(ctl, (const h16*)(args.ws + WS_O), DM, args.in[13], DM, args.ws + WS_OP, 10.f, gw_, NGW, lane_, 5u); }
#endif
    if (IN(6) && !fuse6) { FRESH(); for (int rep = 0; rep < NREP(6); ++rep) p6_rows(args, gw_, NGW, lane_); }
    SEAM(6);
    const bool p78 = P78_HANDOFF && G == (M / 256) * (DM / 256) && IN(7) && IN(8) && NREP(7) == 1 && NREP(8) == 1;
    if (IN(7)) {
        pg8::Gemm g{(const h16*)(args.ws + WS_H), (const h16*)(args.ws + WS_WUP), M, DFF, DM}; pg8::StaticOrder S; S.init(M, DFF, G, bx, WGM_P7);
        pg8::EpiRelu2 E{(h16*)(args.ws + WS_U), DFF};
        for (int rep = 0; rep < NREP(7); ++rep) pg8::gemm_phase<pg8::EpiRelu2, pg8::StaticOrder, true, true>(L, g, S, E);
        if (p78 && threadIdx.x == 0) { pg8::Unit u_; for (int i = 0; S.next(i, u_); ++i) __hip_atomic_fetch_add(ctl + CW_P78 + 64 * u_.pm, 1u, __ATOMIC_RELAXED, __HIP_MEMORY_SCOPE_AGENT); }
    }
    if (!p78) SEAM(7);
#if DIAG
    if (DIAG & 8) { FRESH(); diag_gemm<1>(ctl, (const h16*)(args.ws + WS_H), DM, args.in[16], DFF, args.ws + WS_U, 1.f, gw_, NGW, lane_, 9u); }
#endif
    const bool fuse9 = FUSE_P9 && G == (M / 256) * (DM / 256) && IN(8) && IN(9);
    if (IN(8)) {
        pg8::Gemm g{(const h16*)(args.ws + WS_U), (const h16*)(args.ws + WS_WDN), M, DM, DFF}; pg8::StaticOrder S; S.init(M, DM, G, bx);
        if (p78) { pg8::Unit u_; if (S.next(0, u_) && threadIdx.x == 0) { unsigned sp = 0u;
                while (__hip_atomic_load(ctl + CW_P78 + 64 * u_.pm, __ATOMIC_RELAXED, __HIP_MEMORY_SCOPE_AGENT) < (unsigned)(DFF / 256)) { __builtin_amdgcn_s_sleep(1); if (++sp > (1u << 22)) break; }
                __builtin_amdgcn_fence(__ATOMIC_ACQUIRE, "agent"); }
            __syncthreads(); }
        if (fuse9) { pg8::EpiNormOut E{(const h16*)(args.ws + WS_X1), args.out, (float*)(args.ws + WS_SSQ + 2 * MiB), ctl + CW_XCH, args.in[15], (const float*)(args.ws + WS_MOD) + 5 * DM};
            pg8::gemm_phase<pg8::EpiNormOut, pg8::StaticOrder, true, true>(L, g, S, E); }
        else { pg8::EpiF16SS E{(h16*)(args.ws + WS_F), DM, (float*)(args.ws + WS_SSQ)};
        for (int rep = 0; rep < NREP(8); ++rep) pg8::gemm_phase<pg8::EpiF16SS, pg8::StaticOrder, true, true>(L, g, S, E); }
    }
    if (!fuse9) SEAM(8);
#if DIAG
    if (DIAG & 16) { FRESH(); diag_gemm<0>(ctl, (const h16*)(args.ws + WS_U), DFF, args.in[17], DM, args.ws + WS_F, 1.f, gw_, NGW, lane_, 13u); }
#endif
    if (IN(9) && !fuse9) { FRESH(); p9_rows(args, gw_, NGW, lane_); }
#if DIAG
    { xcd_barrier(bar); FRESH(); const unsigned long long dv = __hip_atomic_load((unsigned long long*)(ctl + CW_DIAG), __ATOMIC_RELAXED, __HIP_MEMORY_SCOPE_AGENT);
      const float mval = __uint_as_float((unsigned)(dv >> 32)); const unsigned pay = (unsigned)dv; const int pt = pay >> 8;
      float Cval = 1000.f * exp2f(ceilf(log2f(fmaxf(mval, 1e-12f))));
      if (DIAG_FIELD == 4) Cval = 10.f * (float)(1u + __hip_atomic_load(ctl + CW_DIAG + 4, __ATOMIC_RELAXED, __HIP_MEMORY_SCOPE_AGENT));
      if (DIAG_FIELD == 1) Cval = 10.f * (float)((pt >> 6) + 1);
      if (DIAG_FIELD == 2) Cval = 10.f * (float)((pt & 63) + 1);
      if (DIAG_FIELD == 3) Cval = 10.f * (float)(((pay >> 4) & 15) + 1);
      for (size_t e = (size_t)gw_ * 64 + lane_; e < (size_t)M * DM; e += (size_t)NGW * 64) args.out[e] = Cval; }
#endif
#undef IN
#undef SEAM
}

static void build_order(unsigned short* order) {
    struct It { int cost; unsigned short v; };
    It items[512]; int n = 0;
    for (int b = 0; b < 2; ++b) for (int g = 0; g < 2; ++g) for (int i = 0; i < 64; ++i) {
        const int ntc = ((4 * i + 2) >> 6) + 1; const int cost = 6 * ntc + 2 * (i + 1) + 2 * (i + 1 < 9 ? i + 1 : 9) + 40;
        items[n].cost = cost; items[n].v = (unsigned short)((b << 7) | (g << 6) | i); ++n; }
    for (int b = 0; b < 2; ++b) for (int h = 0; h < 8; ++h) for (int j = 0; j < 16; ++j) {
        items[n].cost = 2 * 4 * (j + 1) + 18; items[n].v = (unsigned short)(0x8000 | (b << 7) | (h << 4) | j); ++n; }
    for (int i = 1; i < 512; ++i) { It k = items[i]; int j = i - 1; while (j >= 0 && items[j].cost < k.cost) { items[j + 1] = items[j]; --j; } items[j + 1] = k; }
    if (1) { for (int i = 0; i < 512; ++i) order[i] = items[i].v; return; }
    const int NT = NT_ITEMS, TC = 7; long tot = (long)NT * TC; for (int i = 0; i < 512; ++i) tot += items[i].cost;
    const double tend = 0.8 * (double)tot / 256.0; int fr[256]; for (int w = 0; w < 256; ++w) fr[w] = 0;
    int nA = 0, nT = 0; n = 0;
    while (nA < 512 || nT < NT) {
        int w = 0; for (int u = 1; u < 256; ++u) if (fr[u] < fr[w]) w = u;
        const double tgt = 24.0 + (NT - 24) * (double)fr[w] / tend;
        if (nT < NT && (nA >= 512 || (double)nT < tgt)) { order[n++] = (unsigned short)(0x4000 | nT); ++nT; fr[w] += TC; }
        else { order[n++] = items[nA].v; fr[w] += items[nA].cost; ++nA; }
    }
}

extern "C" void kernel_launch(void* const* d_in, const int* in_sizes, int n_in, void* d_out, int out_size, void* d_ws, size_t ws_size, hipStream_t stream) {
    static int grid = 0; static Args a;
    if (grid == 0) {
        if (n_in != 18 || in_sizes[0] != M * DM || out_size != M * DM || ws_size < WS_END) { fprintf(stderr, "kernel_launch: unexpected shapes (n_in %d, in0 %d, out %d, ws %zu)\n", n_in, n_in > 0 ? in_sizes[0] : -1, out_size, ws_size); grid = -1; return; }
        int dev = 0, cus = 0, per_cu = 0;
        if (hipGetDevice(&dev) != hipSuccess || hipDeviceGetAttribute(&cus, hipDeviceAttributeMultiprocessorCount, dev) != hipSuccess) { grid = -1; return; }
        if (hipFuncSetAttribute((const void*)hymba_fwd, hipFuncAttributeMaxDynamicSharedMemorySize, LDS_BYTES) != hipSuccess) { fprintf(stderr, "kernel_launch: hipFuncSetAttribute failed\n"); grid = -1; return; }
        if (hipOccupancyMaxActiveBlocksPerMultiprocessor(&per_cu, (const void*)hymba_fwd, NWAVES * 64, LDS_BYTES) != hipSuccess || per_cu < 1) { fprintf(stderr, "kernel_launch: occupancy query says %d\n", per_cu); }
        (void)hipGetLastError();
        grid = cus;
        memset(&a, 0, sizeof(a));
        build_order(a.order);
    }
    if (grid < 0) return;
    (void)hipMemsetAsync((char*)d_ws + WS_CTL, 0, CTL_ZERO_BYTES, stream);
    for (int i = 0; i < 18; ++i) a.in[i] = (const float*)d_in[i];
    a.out = (float*)d_out; a.ws = (unsigned char*)d_ws;
    if (MK_N_LAUNCHES == 1) {
        a.ph_lo = 0; a.ph_hi = 10;
        void* params[] = {&a};
        hipError_t e = hipLaunchCooperativeKernel((const void*)hymba_fwd, dim3(grid), dim3(NWAVES * 64), params, LDS_BYTES, stream);
        if (e != hipSuccess) fprintf(stderr, "kernel_launch: cooperative launch failed: %s (grid %d)\n", hipGetErrorString(e), grid);
    } else {
        for (int p = 0; p < 10; ++p) { a.ph_lo = p; a.ph_hi = p + 1; hipLaunchKernelGGL(hymba_fwd, dim3(grid), dim3(NWAVES * 64), LDS_BYTES, stream, a); }
    }
}
```
